# Optimizing an MI355X kernel written in HIP

```python
import math
import jax, jax.numpy as jnp
from jax import lax
import numpy as np

D_MODEL = 1024
BATCH = 4
SEQ = 4096
DEPTH = 2
DEC_BATCH = 32
DEC_SEQ = 2048
PAST_LEN = 128

GRID_W = 64
N_BRANCH = 3
BRANCH_WIDTH = D_MODEL // 2
ROPE_THETA = 10000.0
EPS = 1e-6
NEG = -1e30
A_QK_DIM = 64
A_V_DIM = 2 * A_QK_DIM
A_HEADS = BRANCH_WIDTH // A_V_DIM
A_QK_WIDTH = 2 * A_HEADS * A_QK_DIM
Q_BLOCK = 128
B_HEAD_DIM = 64
B_HEADS = BRANCH_WIDTH // B_HEAD_DIM
NA_KH = 8
NA_KW = 16
C_GROUPS = ((128, 1), (512, 4), (2048, 16))
C_HEAD_DIM = 128
C_HEADS_PER_GROUP = BRANCH_WIDTH // C_HEAD_DIM
C_HEADS = len(C_GROUPS) * C_HEADS_PER_GROUP
C_QKV_WIDTH = C_HEADS * C_HEAD_DIM
C_QBLOCK = 64
COL_A_Q = 0
COL_A_K = COL_A_Q + A_QK_WIDTH
COL_A_V = COL_A_K + A_QK_WIDTH
COL_B_Q = COL_A_V + BRANCH_WIDTH
COL_B_K = COL_B_Q + BRANCH_WIDTH
COL_B_V = COL_B_K + BRANCH_WIDTH
COL_C_Q = COL_B_V + BRANCH_WIDTH
COL_C_K = COL_C_Q + C_QKV_WIDTH
COL_C_V = COL_C_K + C_QKV_WIDTH
COL_Z = COL_C_V + C_QKV_WIDTH
COL_G = COL_Z + N_BRANCH * BRANCH_WIDTH
IN_WIDTH = COL_G + N_BRANCH * D_MODEL

kernel_name = 'hybrid_gated_encoder'


def rms_norm(x, g):
    xf = x.astype(jnp.float32)
    y = xf * lax.rsqrt(jnp.mean(xf * xf, axis=-1, keepdims=True) + EPS) * g.astype(jnp.float32)
    return y.astype(x.dtype)


def rope_tables(S, d):
    inv = ROPE_THETA ** (-jnp.arange(0, d, 2, dtype=jnp.float32) / d)
    ang = jnp.arange(S, dtype=jnp.float32)[:, None] * inv[None, :]
    return jnp.cos(ang), jnp.sin(ang)


def apply_rope(x, cos, sin):
    half = x.shape[-1] // 2
    xf = x.astype(jnp.float32)
    x1, x2 = xf[..., :half], xf[..., half:]
    return jnp.concatenate([x1 * cos - x2 * sin, x2 * cos + x1 * sin], axis=-1).astype(x.dtype)


def split_heads(t, n, d):
    B, S, _ = t.shape
    return t.reshape(B, S, n, d).transpose(0, 2, 1, 3)


def merge_heads(t):
    B, H, S, d = t.shape
    return t.transpose(0, 2, 1, 3).reshape(B, S, H * d)


def diff_attention(q, k, v, lam):
    B, H, _, S, dq = q.shape
    nblk = S // Q_BLOCK
    scale = dq ** -0.5
    q_blocks = q.reshape(B, H, 2, nblk, Q_BLOCK, dq).transpose(3, 0, 1, 2, 4, 5)

    def block(qb):
        s = jnp.einsum('bhmqd,bhmkd->bhmqk', qb, k).astype(jnp.float32) * scale
        p = jax.nn.softmax(s, axis=-1)
        w = p[:, :, 0] - lam * p[:, :, 1]
        return jnp.einsum('bhqk,bhkd->bhqd', w.astype(v.dtype), v)

    o = lax.map(block, q_blocks)
    return o.transpose(1, 2, 0, 3, 4).reshape(B, H, S, v.shape[-1])


def neighborhood_attention(q, k, v, rpb):
    B, H, S, d = q.shape
    rows = S // GRID_W
    kh = min(NA_KH, rows)
    scale = d ** -0.5
    q = q.reshape(B, H, rows, GRID_W, d)
    k = k.reshape(B, H, rows, GRID_W, d)
    v = v.reshape(B, H, rows, GRID_W, d)
    qc = jnp.arange(GRID_W)
    kc = jnp.arange(GRID_W)
    cs = jnp.clip(qc - NA_KW // 2, 0, GRID_W - NA_KW)
    col_ok = (kc[None, :] >= cs[:, None]) & (kc[None, :] < cs[:, None] + NA_KW)
    col_off = jnp.clip(kc[None, :] - qc[:, None], -(NA_KW - 1), NA_KW - 1) + NA_KW - 1
    rpb_cols = rpb.astype(jnp.float32)[:, :, col_off]

    def row(r):
        rs = jnp.clip(r - kh // 2, 0, rows - kh)
        qr = lax.dynamic_index_in_dim(q, r, axis=2, keepdims=False)
        kr = lax.dynamic_slice_in_dim(k, rs, kh, axis=2)
        vr = lax.dynamic_slice_in_dim(v, rs, kh, axis=2)
        row_off = rs + jnp.arange(kh) - r + NA_KH - 1
        bias = rpb_cols[:, row_off].transpose(0, 2, 1, 3)
        s = jnp.einsum('bhqd,bhrkd->bhqrk', qr, kr).astype(jnp.float32) * scale + bias[None]
        s = jnp.where(col_ok[:, None, :], s, NEG)
        p = jax.nn.softmax(s, axis=(-2, -1))
        return jnp.einsum('bhqrk,bhrkd->bhqd', p.astype(v.dtype), vr)

    o = lax.map(row, jnp.arange(rows))
    return o.transpose(1, 2, 0, 3, 4).reshape(B, H, S, d)


def dilated_group(q, k, v, window, dil):
    B, H, S, d = q.shape
    L = S // dil
    hw = window // (2 * dil)
    scale = d ** -0.5

    def sub(t):
        return t.reshape(B, H, L, dil, d).transpose(0, 1, 3, 2, 4)

    qs, ks, vs = sub(q), sub(k), sub(v)
    nb = -(-L // C_QBLOCK)
    Lp = nb * C_QBLOCK
    span = C_QBLOCK + 2 * hw
    qs = jnp.pad(qs, ((0, 0), (0, 0), (0, 0), (0, Lp - L), (0, 0)))
    kv_pad = ((0, 0), (0, 0), (0, 0), (hw, Lp - L + hw), (0, 0))
    ks = jnp.pad(ks, kv_pad)
    vs = jnp.pad(vs, kv_pad)
    qi = jnp.arange(C_QBLOCK)
    kj = jnp.arange(span)
    band = jnp.abs(kj[None, :] - hw - qi[:, None]) <= hw

    def blk(b):
        start = b * C_QBLOCK
        q_b = lax.dynamic_slice_in_dim(qs, start, C_QBLOCK, axis=3)
        k_b = lax.dynamic_slice_in_dim(ks, start, span, axis=3)
        v_b = lax.dynamic_slice_in_dim(vs, start, span, axis=3)
        key_idx = start + kj - hw
        ok = band & ((key_idx >= 0) & (key_idx < L))[None, :]
        s = jnp.einsum('bhrqd,bhrkd->bhrqk', q_b, k_b).astype(jnp.float32) * scale
        s = jnp.where(ok, s, NEG)
        m = jnp.max(s, axis=-1, keepdims=True)
        e = jnp.exp(s - m)
        den = jnp.sum(e, axis=-1, keepdims=True)
        o = jnp.einsum('bhrqk,bhrkd->bhrqd', (e / den).astype(v_b.dtype), v_b)
        return o, (m + jnp.log(den))[..., 0]

    o, lse = lax.map(blk, jnp.arange(nb))
    o = o.transpose(1, 2, 3, 0, 4, 5).reshape(B, H, dil, Lp, d)[:, :, :, :L]
    lse = lse.transpose(1, 2, 3, 0, 4).reshape(B, H, dil, Lp)[:, :, :, :L]
    o = o.transpose(0, 1, 3, 2, 4).reshape(B, H, S, d)
    lse = lse.transpose(0, 1, 3, 2).reshape(B, H, S)
    return o, lse


def dilated_mixture(q, k, v):
    outs, lses = [], []
    for g, (window, dil) in enumerate(C_GROUPS):
        sl = slice(g * C_HEADS_PER_GROUP, (g + 1) * C_HEADS_PER_GROUP)
        o, lse = dilated_group(q[:, sl], k[:, sl], v[:, sl], window, dil)
        outs.append(o)
        lses.append(lse)
    alpha = jax.nn.softmax(jnp.stack(lses, axis=0), axis=0)
    y = jnp.einsum('gbhs,gbhsd->bhsd', alpha, jnp.stack(outs, axis=0).astype(jnp.float32))
    return y.astype(q.dtype)


def encoder_layer(x, c, layer_idx, cos_a, sin_a, cos_c, sin_c, ln_g, w_ada, b_ada, w_in,
                  qn_a, kn_a, lam_q1, lam_k1, lam_q2, lam_k2, subln_a, qn_b, kn_b, rpb_b,
                  qn_c, kn_c, w_br, w_out):
    B, S, _ = x.shape
    mod = jax.nn.silu(c) @ w_ada + b_ada
    shift, scale, gate = jnp.split(mod, 3, axis=-1)
    h = rms_norm(x, ln_g) * (1.0 + scale[:, None, :]) + shift[:, None, :]

    def cols(lo, width):
        return h @ w_in[:, lo:lo + width]

    qa = cols(COL_A_Q, A_QK_WIDTH).reshape(B, S, A_HEADS, 2, A_QK_DIM).transpose(0, 2, 3, 1, 4)
    ka = cols(COL_A_K, A_QK_WIDTH).reshape(B, S, A_HEADS, 2, A_QK_DIM).transpose(0, 2, 3, 1, 4)
    va = split_heads(cols(COL_A_V, BRANCH_WIDTH), A_HEADS, A_V_DIM)
    qa = apply_rope(rms_norm(qa, qn_a), cos_a, sin_a)
    ka = apply_rope(rms_norm(ka, kn_a), cos_a, sin_a)
    lam_init = 0.8 - 0.6 * math.exp(-0.3 * layer_idx)
    f32 = jnp.float32
    lam = (jnp.exp(jnp.sum(lam_q1.astype(f32) * lam_k1.astype(f32)))
           - jnp.exp(jnp.sum(lam_q2.astype(f32) * lam_k2.astype(f32))) + lam_init)
    ya = diff_attention(qa, ka, va, lam)
    ya = merge_heads(rms_norm(ya, subln_a) * (1.0 - lam_init))

    qb = rms_norm(split_heads(cols(COL_B_Q, BRANCH_WIDTH), B_HEADS, B_HEAD_DIM), qn_b)
    kb = rms_norm(split_heads(cols(COL_B_K, BRANCH_WIDTH), B_HEADS, B_HEAD_DIM), kn_b)
    vb = split_heads(cols(COL_B_V, BRANCH_WIDTH), B_HEADS, B_HEAD_DIM)
    yb = merge_heads(neighborhood_attention(qb, kb, vb, rpb_b))

    qc = apply_rope(rms_norm(split_heads(cols(COL_C_Q, C_QKV_WIDTH), C_HEADS, C_HEAD_DIM), qn_c), cos_c, sin_c)
    kc = apply_rope(rms_norm(split_heads(cols(COL_C_K, C_QKV_WIDTH), C_HEADS, C_HEAD_DIM), kn_c), cos_c, sin_c)
    vc = split_heads(cols(COL_C_V, C_QKV_WIDTH), C_HEADS, C_HEAD_DIM)
    yc = merge_heads(dilated_mixture(qc, kc, vc))

    merged = None
    for i, y_i in enumerate((ya, yb, yc)):
        z = cols(COL_Z + i * BRANCH_WIDTH, BRANCH_WIDTH)
        g = cols(COL_G + i * D_MODEL, D_MODEL)
        u = jax.nn.sigmoid(g) * ((y_i * jax.nn.silu(z)) @ w_br[i])
        merged = u if merged is None else merged + u
    out = merged @ w_out
    return x + gate[:, None, :] * out


def setup_inputs(seed: int = 0) -> dict:
    key = jax.random.key(seed)
    ks = jax.random.split(key, 22)
    f32 = jnp.float32

    def nrm(k, shape, s):
        return jax.random.normal(k, shape, f32) * s

    def gain(k, shape):
        return 1.0 + 0.02 * jax.random.normal(k, shape, f32)

    return {
        'x_prompt': nrm(ks[0], (BATCH, SEQ, D_MODEL), 1.0),
        'x_sample': nrm(ks[1], (DEC_BATCH, DEC_SEQ, D_MODEL), 1.0),
        'c_prompt': nrm(ks[2], (BATCH, D_MODEL), 1.0),
        'c_sample': nrm(ks[3], (DEC_BATCH, D_MODEL), 1.0),
        'ln_g': gain(ks[4], (DEPTH, D_MODEL)),
        'w_ada': nrm(ks[5], (DEPTH, D_MODEL, 3 * D_MODEL), D_MODEL ** -0.5),
        'b_ada': nrm(ks[6], (DEPTH, 3 * D_MODEL), 0.02),
        'w_in': nrm(ks[7], (DEPTH, D_MODEL, IN_WIDTH), D_MODEL ** -0.5),
        'qn_a': gain(ks[8], (DEPTH, A_QK_DIM)),
        'kn_a': gain(ks[9], (DEPTH, A_QK_DIM)),
        'lam_q1': nrm(ks[10], (DEPTH, A_QK_DIM), 0.1),
        'lam_k1': nrm(ks[11], (DEPTH, A_QK_DIM), 0.1),
        'lam_q2': nrm(ks[12], (DEPTH, A_QK_DIM), 0.1),
        'lam_k2': nrm(ks[13], (DEPTH, A_QK_DIM), 0.1),
        'subln_a': gain(ks[14], (DEPTH, A_V_DIM)),
        'qn_b': gain(ks[15], (DEPTH, B_HEAD_DIM)),
        'kn_b': gain(ks[16], (DEPTH, B_HEAD_DIM)),
        'rpb_b': nrm(ks[17], (DEPTH, B_HEADS, 2 * NA_KH - 1, 2 * NA_KW - 1), 0.1),
        'qn_c': gain(ks[18], (DEPTH, C_HEAD_DIM)),
        'kn_c': gain(ks[19], (DEPTH, C_HEAD_DIM)),
        'w_br': nrm(ks[20], (DEPTH, N_BRANCH, BRANCH_WIDTH, D_MODEL), BRANCH_WIDTH ** -0.5),
        'w_out': nrm(ks[21], (DEPTH, D_MODEL, D_MODEL), D_MODEL ** -0.5),
    }


def reference(x_prompt, x_sample, c_prompt, c_sample, ln_g, w_ada, b_ada, w_in, qn_a, kn_a,
              lam_q1, lam_k1, lam_q2, lam_k2, subln_a, qn_b, kn_b, rpb_b, qn_c, kn_c, w_br, w_out):
    def run(x, c):
        S = x.shape[1]
        cos_a, sin_a = rope_tables(S, A_QK_DIM)
        cos_c, sin_c = rope_tables(S, C_HEAD_DIM)
        for l in range(DEPTH):
            x = encoder_layer(x, c, l, cos_a, sin_a, cos_c, sin_c, ln_g[l], w_ada[l], b_ada[l], w_in[l],
                              qn_a[l], kn_a[l], lam_q1[l], lam_k1[l], lam_q2[l], lam_k2[l], subln_a[l],
                              qn_b[l], kn_b[l], rpb_b[l], qn_c[l], kn_c[l], w_br[l], w_out[l])
        return x

    y_prompt = run(x_prompt, c_prompt)
    y_sample = run(x_sample, c_sample)
    return (y_prompt, y_sample)
```

```cpp
#include <hip/hip_runtime.h>
#include <hip/hip_cooperative_groups.h>
#include <cstdio>
#include <cstdint>
namespace cg = cooperative_groups;
__device__ __forceinline__ int otid() { int t = threadIdx.x; asm volatile("" : "+v"(t)); return t; }
namespace pg8 {
#define PG8_LAS __attribute__((address_space(3)))
typedef unsigned short bf16_t;
typedef short bf16x8 __attribute__((ext_vector_type(8)));
typedef float f32x4 __attribute__((ext_vector_type(4)));
typedef unsigned u32x4 __attribute__((ext_vector_type(4)));
constexpr int BM = 256, BK = 64, HALF = 128, HTB = HALF * BK * 2  , STAGE_BYTES = 8 * HTB, NXCD = 8, WGM = 8;

__host__ __device__ __forceinline__ int lds_byte(int r, int c) { const int st = (r >> 4) * 2 + (c >> 5), rr = r & 15, cc = c & 31, ob = rr * 64 + cc * 2; return st * 1024 + (ob ^ (((ob >> 9) & 1) << 5)); }
__host__ __device__ __forceinline__ void stage_rc(int b, int& R, int& C) { const int st = b / 1024, sb = b % 1024, swz = sb ^ (((sb >> 9) & 1) << 5); R = (st >> 1) * 16 + swz / 64; C = (st & 1) * 32 + (swz % 64) / 2; }
__host__ __device__ __forceinline__ int perm32(int rho) { const int n = rho >> 4, i = rho & 15; return 8 * (i >> 2) + 4 * n + (i & 3); }

struct Unit { int pm, pn; };
struct Gemm { const bf16_t* A; const bf16_t* Bt; int M, N, K; };

struct StaticOrder {
    int nM, nN, nwg, G, c;
    __host__ __device__ void init(int M, int N, int G_, int c_) { nM = M / BM; nN = N / BM; nwg = nM * nN; G = G_; c = c_; }
    __host__ __device__ bool next(int i, Unit& u) const {
        const long L = (long)i * G + c; if (L >= nwg) return false;
        int wgid = (int)L; { const int q = nwg / NXCD, r = nwg % NXCD, xcd = wgid % NXCD, off = wgid / NXCD; wgid = (xcd < r ? xcd * (q + 1) : r * (q + 1) + (xcd - r) * q) + off; }
        const int nig = WGM * nN, gid = wgid / nig, fm = gid * WGM, gsz = (nM - fm) < WGM ? (nM - fm) : WGM;
        u.pm = fm + ((wgid % nig) % gsz); u.pn = (wgid % nig) / gsz; return true;
    }
    __device__ __forceinline__ void a_ready(const Unit&) const {}
    __device__ __forceinline__ void done(const Unit&) const {}
};

__device__ __forceinline__ unsigned cvt_pk_bf16(float lo, float hi) { unsigned r; asm volatile("v_cvt_pk_bf16_f32 %0, %1, %2" : "=v"(r) : "v"(lo), "v"(hi)); return r; }

template <class Epi, class Sched, bool ALIGN_EPI = false, bool SP2 = false>
__device__ __forceinline__ void gemm_phase(PG8_LAS unsigned char* lds, const Gemm g, const Sched& S, const Epi& E) {
    const int tid = otid(), wid = __builtin_amdgcn_readfirstlane(tid >> 6), lane = tid & 63, wr = wid >> 2, wc = wid & 3, fr = lane & 15, fq = lane >> 4;
    const int K = g.K, nt = K / BK;
    unsigned voffA[2], voffB[2];
#pragma unroll
    for (int i = 0; i < 2; ++i) { int R, C; stage_rc(tid * 16 + i * 8192, R, C); const int Rb = Epi::PERM ? ((R & ~31) + perm32(R & 31)) : R;
        voffA[i] = (unsigned)(R * K + C) * 2u; voffB[i] = (unsigned)(Rb * K + C) * 2u; }
    const size_t kstep = (size_t)(BK * 2);
    const size_t hstep = (size_t)HALF * K * 2;
    const size_t tstep = 2 * hstep;
    const unsigned ldsw = (unsigned)wid * 1024u;
    const int aoff = lds_byte(wr * 64 + fr, fq * 8), boff = lds_byte(wc * 32 + fr, fq * 8);
#define PG8_SA(b, h) (((b) * 2 + (h)) * HTB)
#define PG8_SB(b, h) ((4 + (b) * 2 + (h)) * HTB)
#define PG8_STAGE(bufoff, gbase, voff) do { _Pragma("unroll") for (int _i = 0; _i < 2; ++_i) \
        __builtin_amdgcn_global_load_lds((const unsigned*)((const char*)(gbase) + (voff)[_i]), (PG8_LAS unsigned*)(lds + (bufoff) + ldsw + _i * 8192), 16, 0, 0); } while (0)
#define PG8_LDA(dst, b, h) do { _Pragma("unroll") for (int m = 0; m < 4; ++m) _Pragma("unroll") for (int k = 0; k < 2; ++k) dst[m][k] = *(const PG8_LAS bf16x8*)(lds + PG8_SA(b, h) + aoff + m * 2048 + k * 1024); } while (0)
#define PG8_LDB(dst, b, h) do { _Pragma("unroll") for (int n = 0; n < 2; ++n) _Pragma("unroll") for (int k = 0; k < 2; ++k) dst[n][k] = *(const PG8_LAS bf16x8*)(lds + PG8_SB(b, h) + boff + n * 2048 + k * 1024); } while (0)
#define PG8_MMA(ai, bj, At, Bt) do { __builtin_amdgcn_s_setprio(1); _Pragma("unroll") for (int m = 0; m < 4; ++m) _Pragma("unroll") for (int n = 0; n < 2; ++n) _Pragma("unroll") for (int k = 0; k < 2; ++k) \
        acc[ai][bj][m][n] = __builtin_amdgcn_mfma_f32_16x16x32_bf16(Bt[n][k], At[m][k], acc[ai][bj][m][n], 0, 0, 0); __builtin_amdgcn_s_setprio(0); } while (0)
#define PG8_WAIT_V(n) asm volatile("s_waitcnt vmcnt(" #n ")" ::: "memory")
#define PG8_WAIT_L(n) asm volatile("s_waitcnt lgkmcnt(" #n ")" ::: "memory")
#define PG8_BAR __builtin_amdgcn_s_barrier()
#define PG8_SCHED __builtin_amdgcn_sched_barrier(0)
    Unit cur, nxt; int ui = 0;
    if (!S.next(0, cur)) return;
    f32x4 acc[2][2][4][2];
#pragma unroll
    for (int a = 0; a < 2; ++a)
#pragma unroll
        for (int b = 0; b < 2; ++b)
#pragma unroll
            for (int m = 0; m < 4; ++m)
#pragma unroll
                for (int n = 0; n < 2; ++n) acc[a][b][m][n] = (f32x4){0.f, 0.f, 0.f, 0.f};
    bf16x8 At[4][2], B0[2][2], B1[2][2];
    const char* cA = (const char*)g.A + (size_t)cur.pm * tstep; const char* cB = (const char*)g.Bt + (size_t)cur.pn * tstep;
    S.a_ready(cur);
    if constexpr (SP2) {
        PG8_STAGE(PG8_SB(0, 0), cB, voffB); PG8_STAGE(PG8_SB(0, 1), cB + hstep, voffB); PG8_STAGE(PG8_SA(0, 0), cA, voffA); PG8_STAGE(PG8_SA(0, 1), cA + hstep, voffA);
        if (wr == 1) PG8_BAR;
        PG8_WAIT_V(2); PG8_BAR;
        PG8_STAGE(PG8_SB(1, 0), cB + kstep, voffB); PG8_STAGE(PG8_SA(1, 0), cA + kstep, voffA); PG8_STAGE(PG8_SB(1, 1), cB + hstep + kstep, voffB);
        PG8_WAIT_V(6); PG8_BAR;
    } else {
        PG8_STAGE(PG8_SB(0, 0), cB, voffB); PG8_STAGE(PG8_SA(0, 0), cA, voffA); PG8_STAGE(PG8_SB(0, 1), cB + hstep, voffB); PG8_STAGE(PG8_SA(0, 1), cA + hstep, voffA);
        if (wr == 1) PG8_BAR;
        PG8_WAIT_V(4); PG8_BAR;
        PG8_STAGE(PG8_SB(1, 0), cB + kstep, voffB); PG8_STAGE(PG8_SA(1, 0), cA + kstep, voffA); PG8_STAGE(PG8_SB(1, 1), cB + hstep + kstep, voffB);
        PG8_WAIT_V(6); PG8_BAR;
    }
    for (;;) {
        const bool has_next = S.next(ui + 1, nxt);
        const char* nA = has_next ? (const char*)g.A + (size_t)nxt.pm * tstep : cA; const char* nB = has_next ? (const char*)g.Bt + (size_t)nxt.pn * tstep : cB;
        for (int t = 0; t < nt; t += 2) {
            const bool last = (t == nt - 2);
            const char* a1 = cA + (size_t)(t + 1) * kstep;
            const char* a2 = last ? nA : cA + (size_t)(t + 2) * kstep; const char* b2 = last ? nB : cB + (size_t)(t + 2) * kstep;
            const char* a3 = a2 + kstep; const char* b3 = b2 + kstep;
            if (last && has_next) S.a_ready(nxt);
            if constexpr (SP2) {
            PG8_LDB(B0, 0, 0); PG8_LDB(B1, 0, 1); PG8_SCHED; PG8_LDA(At, 0, 0); PG8_STAGE(PG8_SA(1, 1), a1 + hstep, voffA);
            PG8_WAIT_V(8); PG8_WAIT_L(0); PG8_BAR; PG8_MMA(0, 0, At, B0); PG8_MMA(0, 1, At, B1); PG8_BAR; PG8_SCHED;
            PG8_LDA(At, 0, 1); PG8_STAGE(PG8_SB(0, 0), b2, voffB); PG8_STAGE(PG8_SB(0, 1), b2 + hstep, voffB); PG8_STAGE(PG8_SA(0, 0), a2, voffA);
            PG8_WAIT_V(8); PG8_WAIT_L(0); PG8_BAR; PG8_MMA(1, 0, At, B0); PG8_MMA(1, 1, At, B1); PG8_BAR; PG8_SCHED;
            PG8_LDB(B0, 1, 0); PG8_LDB(B1, 1, 1); PG8_SCHED; PG8_LDA(At, 1, 0); PG8_STAGE(PG8_SA(0, 1), a2 + hstep, voffA);
            PG8_WAIT_V(8); PG8_WAIT_L(0); PG8_BAR; PG8_MMA(0, 0, At, B0); PG8_MMA(0, 1, At, B1); PG8_BAR; PG8_SCHED;
            PG8_LDA(At, 1, 1); PG8_STAGE(PG8_SB(1, 0), b3, voffB); PG8_STAGE(PG8_SB(1, 1), b3 + hstep, voffB); PG8_STAGE(PG8_SA(1, 0), a3, voffA);
            PG8_WAIT_V(8); PG8_WAIT_L(0); PG8_BAR; PG8_MMA(1, 0, At, B0); PG8_MMA(1, 1, At, B1); PG8_BAR; PG8_SCHED;
            } else {
            PG8_LDB(B0, 0, 0); PG8_SCHED; PG8_LDA(At, 0, 0); PG8_STAGE(PG8_SA(1, 1), a1 + hstep, voffA);
            PG8_WAIT_L(8); PG8_BAR; PG8_WAIT_L(0); PG8_MMA(0, 0, At, B0); PG8_BAR; PG8_SCHED;
            PG8_LDB(B1, 0, 1); PG8_STAGE(PG8_SB(0, 0), b2, voffB);
            PG8_BAR; PG8_WAIT_L(0); PG8_MMA(0, 1, At, B1); PG8_BAR;
            PG8_LDA(At, 0, 1); PG8_STAGE(PG8_SA(0, 0), a2, voffA);
            PG8_BAR; PG8_WAIT_L(0); PG8_MMA(1, 0, At, B0); PG8_BAR; PG8_SCHED;
            PG8_STAGE(PG8_SB(0, 1), b2 + hstep, voffB);
            PG8_WAIT_V(6); PG8_BAR; PG8_MMA(1, 1, At, B1); PG8_BAR;
            PG8_LDB(B0, 1, 0); PG8_SCHED; PG8_LDA(At, 1, 0); PG8_STAGE(PG8_SA(0, 1), a2 + hstep, voffA);
            PG8_WAIT_L(8); PG8_BAR; PG8_WAIT_L(0); PG8_MMA(0, 0, At, B0); PG8_BAR; PG8_SCHED;
            PG8_LDB(B1, 1, 1); PG8_STAGE(PG8_SB(1, 0), b3, voffB);
            PG8_BAR; PG8_WAIT_L(0); PG8_MMA(0, 1, At, B1); PG8_BAR;
            PG8_LDA(At, 1, 1); PG8_STAGE(PG8_SA(1, 0), a3, voffA);
            PG8_BAR; PG8_WAIT_L(0); PG8_MMA(1, 0, At, B0); PG8_BAR; PG8_SCHED;
            PG8_STAGE(PG8_SB(1, 1), b3 + hstep, voffB);
            PG8_WAIT_V(6); PG8_BAR; PG8_MMA(1, 1, At, B1); PG8_BAR;
            }
        }
        if constexpr (ALIGN_EPI) { if (wr == 0) PG8_BAR; }
        if constexpr (!Epi::AFTER_DRAIN) { E(acc, cur, wr, wc, fr, fq); S.done(cur); }
        if (!has_next) break;
#pragma unroll
        for (int a = 0; a < 2; ++a)
#pragma unroll
            for (int b = 0; b < 2; ++b)
#pragma unroll
                for (int m = 0; m < 4; ++m)
#pragma unroll
                    for (int n = 0; n < 2; ++n) acc[a][b][m][n] = (f32x4){0.f, 0.f, 0.f, 0.f};
        cur = nxt; cA = nA; cB = nB; ++ui;
        if constexpr (ALIGN_EPI) { if (wr == 1) PG8_BAR; }
    }
    PG8_WAIT_V(0);
    if constexpr (!ALIGN_EPI) { if (wr == 0) PG8_BAR; }
    PG8_BAR;
    if constexpr (Epi::AFTER_DRAIN) { E.fused(acc, cur, wr, wc, fr, fq, lds, wid, lane); S.done(cur); }
#undef PG8_SA
#undef PG8_SB
#undef PG8_STAGE
#undef PG8_LDA
#undef PG8_LDB
#undef PG8_MMA
#undef PG8_WAIT_V
#undef PG8_WAIT_L
#undef PG8_BAR
#undef PG8_SCHED
}
}

#define LAS __attribute__((address_space(3)))
#ifndef PH_MASK
#define PH_MASK 0xFFF
#endif
typedef unsigned short bf16_t;
typedef short bf16x8 __attribute__((ext_vector_type(8)));
typedef short s16x4 __attribute__((ext_vector_type(4)));
typedef short v4i16_t __attribute__((ext_vector_type(4)));
typedef float f32x2 __attribute__((ext_vector_type(2)));
typedef float f32x4 __attribute__((ext_vector_type(4)));
typedef float f32x16 __attribute__((ext_vector_type(16)));
typedef unsigned u32x2 __attribute__((ext_vector_type(2)));
typedef unsigned u32x4 __attribute__((ext_vector_type(4)));
typedef __bf16 bf16x2_t __attribute__((ext_vector_type(2)));

constexpr int DM = 1024, NIN = 12288, TC = 16384, NCHUNK = 5, NSEQ = 36, NTHR = 512;
constexpr int COL_A_Q = 0, COL_A_K = 512, COL_A_V = 1024, COL_B_Q = 1536, COL_B_K = 2048, COL_B_V = 2560, COL_C_Q = 3072, COL_C_K = 4608,
              COL_C_V = 6144, COL_Z = 7680, COL_G = 9216;
constexpr float EPS = 1e-6f, LOG2E = 1.4426950408889634f, NEGBIG = -1e30f;

constexpr size_t WS_WIN = 0;
constexpr size_t WS_WBR = WS_WIN + 2ull * NIN * DM * 2;
constexpr size_t WS_WOUT = WS_WBR + 2ull * 3072 * 512 * 2;
constexpr size_t WS_MOD = WS_WOUT + 2ull * DM * DM * 2;
constexpr size_t WS_COSA = WS_MOD + 2ull * NSEQ * 3072 * 4;
constexpr size_t WS_SINA = WS_COSA + 4096ull * 32 * 4;
constexpr size_t WS_COSC = WS_SINA + 4096ull * 32 * 4;
constexpr size_t WS_SINC = WS_COSC + 4096ull * 64 * 4;
constexpr size_t WS_LAM = WS_SINC + 4096ull * 64 * 4;
constexpr size_t WS_GAIN = WS_LAM + 256;
constexpr size_t WS_H = WS_GAIN + 2 * 6 * 128 * 4;
constexpr size_t WS_P = WS_H + (size_t)TC * DM * 2;
constexpr size_t WS_T = WS_P + (size_t)TC * NIN * 2;
constexpr size_t WS_OC = WS_T + 3ull * TC * 512 * 2;
constexpr size_t WS_LSE = WS_OC + (size_t)TC * 1536 * 2;
constexpr size_t WS_MT = WS_LSE + (size_t)TC * 12 * 4;
constexpr size_t WS_MB = WS_MT + (size_t)TC * DM * 4;
constexpr size_t WS_END = WS_MB + (size_t)TC * DM * 2;

constexpr int LDS_BYTES = 159744;
constexpr int XCH_OFF = 131072;
constexpr int NPHASE = 1 + NCHUNK * 2 * 6;

struct Params { const float* in[22]; float* out; unsigned char* ws; int ph_lo, ph_hi; };

__device__ __forceinline__ unsigned pk2(float lo, float hi) { f32x2 v = {lo, hi}; bf16x2_t b = __builtin_convertvector(v, bf16x2_t); return __builtin_bit_cast(unsigned, b); }
__device__ __forceinline__ float bflo(unsigned u) { return __uint_as_float(u << 16); }
__device__ __forceinline__ float bfhi(unsigned u) { return __uint_as_float(u & 0xffff0000u); }
__device__ __forceinline__ float wave_sum(float v) {
#pragma unroll
    for (int o = 32; o >= 1; o >>= 1) v += __shfl_xor(v, o);
    return v;
}
__device__ __forceinline__ float fast_exp2(float x) { return __builtin_amdgcn_exp2f(x); }
__device__ __forceinline__ float sigmoidf_(float x) { return 1.f / (1.f + __expf(-x)); }
__device__ __forceinline__ float siluf_(float x) { return x / (1.f + __expf(-x)); }

__host__ __device__ __forceinline__ int tile_type(int pn) {
    if (pn < 4) return 1; if (pn < 6) return 0; if (pn < 10) return 2; if (pn < 12) return 0; if (pn < 24) return 3; if (pn < 30) return 0; if (pn < 36) return 4; return 5;
}
__device__ __forceinline__ int phys_row(int col) {
    const int pn = col >> 8, lc = col & 255, ty = tile_type(pn);
    if (ty == 1 || ty == 2) { const int wc = (lc >> 6) & 3, bj = (lc >> 5) & 1, rest = lc & 31; return (pn << 8) + 128 * bj + 32 * wc + rest; }
    if (ty == 3) { const int hh = lc >> 7, bj = (lc >> 6) & 1, w0 = (lc >> 5) & 1, rest = lc & 31; return (pn << 8) + 128 * bj + 32 * (2 * hh + w0) + rest; }
    return col;
}

__device__ __forceinline__ void transpose_item(const float* __restrict__ W, int K, int N, bf16_t* Bt, int kt, int nt, bool perm, LAS float* tile) {
    const int t = otid(), k0 = kt * 64, n0 = nt * 64;
#pragma unroll
    for (int i = 0; i < 8; ++i) { const int k = i * 8 + (t >> 6), n = t & 63; tile[k * 65 + n] = W[(size_t)(k0 + k) * N + n0 + n]; }
    __syncthreads();
    const int n = t >> 3, kk = (t & 7) * 8;
    u32x4 w;
    w.x = pk2(tile[(kk + 0) * 65 + n], tile[(kk + 1) * 65 + n]); w.y = pk2(tile[(kk + 2) * 65 + n], tile[(kk + 3) * 65 + n]);
    w.z = pk2(tile[(kk + 4) * 65 + n], tile[(kk + 5) * 65 + n]); w.w = pk2(tile[(kk + 6) * 65 + n], tile[(kk + 7) * 65 + n]);
    const int col = n0 + n, row = perm ? phys_row(col) : col;
    *(u32x4*)(Bt + (size_t)row * K + k0 + kk) = w;
    __syncthreads();
}

__device__ __forceinline__ void mod_item(const Params& p, int item, LAS float* sc) {
    const int l = item / 48, cb = item % 48, t = otid();
    const float* cp = p.in[2]; const float* cs = p.in[3];
    for (int i = t; i < NSEQ * 1024; i += NTHR) { const int s = i >> 10, k = i & 1023; const float c = (s < 4) ? cp[s * 1024 + k] : cs[(s - 4) * 1024 + k]; sc[i] = siluf_(c); }
    __syncthreads();
    const int col = t & 63, ks = t >> 6;
    const float* w = p.in[5] + (size_t)l * 1024 * 3072 + cb * 64 + col;
    float acc[NSEQ];
#pragma unroll
    for (int s = 0; s < NSEQ; ++s) acc[s] = 0.f;
    for (int k = ks * 128; k < ks * 128 + 128; ++k) {
        const float wv = w[(size_t)k * 3072];
#pragma unroll
        for (int s = 0; s < NSEQ; ++s) acc[s] += sc[s * 1024 + k] * wv;
    }
    __syncthreads();
#pragma unroll
    for (int s = 0; s < NSEQ; ++s) sc[(ks * NSEQ + s) * 64 + col] = acc[s];
    __syncthreads();
    float* mod = (float*)(p.ws + WS_MOD) + (size_t)l * NSEQ * 3072;
    const float* b = p.in[6] + (size_t)l * 3072;
    for (int i = t; i < NSEQ * 64; i += NTHR) {
        const int s = i >> 6, c = i & 63; float v = 0.f;
#pragma unroll
        for (int q = 0; q < 8; ++q) v += sc[(q * NSEQ + s) * 64 + c];
        mod[s * 3072 + cb * 64 + c] = v + b[cb * 64 + c];
    }
    __syncthreads();
}

__device__ __forceinline__ void phase_pre(const Params& p, LAS unsigned char* lds) {
    LAS float* scr = (LAS float*)lds;
    const int G = gridDim.x, bid = blockIdx.x, t = otid();
    constexpr int N_MOD = 96, N_WIN = 16 * 192, N_WBR = 3 * 8 * 16, N_WOUT = 16 * 16, PER_L = N_WIN + N_WBR + N_WOUT;
    for (int item = bid; item < N_MOD + 2 * PER_L; item += G) {
        if (item < N_MOD) { mod_item(p, item, scr); continue; }
        int it = item - N_MOD; const int l = it / PER_L; it -= l * PER_L;
        if (it < N_WIN) { transpose_item(p.in[7] + (size_t)l * DM * NIN, DM, NIN, (bf16_t*)(p.ws + WS_WIN) + (size_t)l * NIN * DM, it & 15, it >> 4, true, scr); }
        else if (it < N_WIN + N_WBR) { it -= N_WIN; const int br = it >> 7, r = it & 127;
            transpose_item(p.in[20] + ((size_t)l * 3 + br) * 512 * 1024, 512, 1024, (bf16_t*)(p.ws + WS_WBR) + ((size_t)l * 3 + br) * 1024 * 512, r & 7, r >> 3, false, scr); }
        else { it -= N_WIN + N_WBR; transpose_item(p.in[21] + (size_t)l * DM * DM, DM, DM, (bf16_t*)(p.ws + WS_WOUT) + (size_t)l * DM * DM, it & 15, it >> 4, false, scr); }
    }
    const int gt = bid * NTHR + t, gn = G * NTHR;
    float* cosA = (float*)(p.ws + WS_COSA); float* sinA = (float*)(p.ws + WS_SINA); float* cosC = (float*)(p.ws + WS_COSC); float* sinC = (float*)(p.ws + WS_SINC);
    for (int i = gt; i < 4096 * 96; i += gn) {
        int pos, j; float inv; float* cd; float* sd;
        if (i < 4096 * 32) { pos = i >> 5; j = i & 31; inv = exp2f(-(float)j * (13.287712379549449f / 32.f)); cd = cosA + i; sd = sinA + i; }
        else { const int i2 = i - 4096 * 32; pos = i2 >> 6; j = i2 & 63; inv = exp2f(-(float)j * (13.287712379549449f / 64.f)); cd = cosC + i2; sd = sinC + i2; }
        double x = (double)pos * (double)inv * 0.15915494309189535;
        x -= floor(x);
        const float r = (float)(x * 6.283185307179586);
        *cd = __cosf(r); *sd = __sinf(r);
    }
    if (bid == 1) {
        float* gt = (float*)(p.ws + WS_GAIN);
        for (int i = t; i < 2 * 6 * 128; i += NTHR) {
            const int l = i / 768, w = (i % 768) >> 7, d = i & 127; float v = 0.f;
            if (w == 0) { if (d < 64) v = p.in[8][l * 64 + d]; } else if (w == 1) { if (d < 64) v = p.in[9][l * 64 + d]; }
            else if (w == 2) { if (d < 64) v = p.in[15][l * 64 + d]; } else if (w == 3) { if (d < 64) v = p.in[16][l * 64 + d]; }
            else if (w == 4) v = p.in[18][l * 128 + d]; else v = p.in[19][l * 128 + d];
            gt[i] = v;
        }
    }
    if (bid == 0 && t < 2) {
        const int l = t; float a = 0.f, b = 0.f;
        for (int i = 0; i < 64; ++i) { a += p.in[10][l * 64 + i] * p.in[11][l * 64 + i]; b += p.in[12][l * 64 + i] * p.in[13][l * 64 + i]; }
        const float lam_init = 0.8f - 0.6f * expf(-0.3f * (float)l);
        float* L = (float*)(p.ws + WS_LAM);
        L[l] = expf(a) - expf(b) + lam_init; L[2 + l] = 1.f - lam_init;
    }
}

__device__ __forceinline__ void phase_h(const float* __restrict__ xin, const float* __restrict__ lng, const float* __restrict__ mod_l, int seq0, int slog, bf16_t* H) {
    const int wave = otid() >> 6, lane = otid() & 63;
    for (int row = blockIdx.x * 8 + wave; row < TC; row += gridDim.x * 8) {
        const float* xr = xin + (size_t)row * DM;
        f32x4 v[4]; float ss = 0.f;
#pragma unroll
        for (int j = 0; j < 4; ++j) { v[j] = *(const f32x4*)(xr + j * 256 + lane * 4); ss += v[j][0] * v[j][0] + v[j][1] * v[j][1] + v[j][2] * v[j][2] + v[j][3] * v[j][3]; }
        ss = wave_sum(ss);
        const float rstd = rsqrtf(ss * (1.f / 1024.f) + EPS);
        const float* md = mod_l + (size_t)(seq0 + (row >> slog)) * 3072;
#pragma unroll
        for (int j = 0; j < 4; ++j) {
            const int col = j * 256 + lane * 4;
            const f32x4 g = *(const f32x4*)(lng + col), sh = *(const f32x4*)(md + col), sc = *(const f32x4*)(md + 1024 + col);
            const f32x4 h = v[j] * rstd * g * (sc + 1.0f) + sh;
            u32x2 o; o.x = pk2(h[0], h[1]); o.y = pk2(h[2], h[3]);
            *(u32x2*)(H + (size_t)row * DM + col) = o;
        }
    }
}

__device__ __forceinline__ u32x4 pack8(const f32x4& a, const f32x4& b) { u32x4 w; w.x = pk2(a[0], a[1]); w.y = pk2(a[2], a[3]); w.z = pk2(b[0], b[1]); w.w = pk2(b[2], b[3]); return w; }
__device__ __forceinline__ float dot4(const f32x4& a) { return a[0] * a[0] + a[1] * a[1] + a[2] * a[2] + a[3] * a[3]; }

struct EpiIn {
    static constexpr bool PERM = true, AFTER_DRAIN = false;
    bf16_t* P; const float* cosA; const float* sinA; const float* cosC; const float* sinC;
    const float* gtab; int smask; LAS float* xch;
    __device__ __forceinline__ static void piece(f32x4 a, f32x4 b, float rs, const float* glo, const float* ghi, const float* cp, const float* sp, bool rope, u32x2& pa, u32x2& pb) {
        a = a * rs * *(const f32x4*)glo; b = b * rs * *(const f32x4*)ghi;
        if (rope) { const f32x4 c = *(const f32x4*)cp, sn = *(const f32x4*)sp; const f32x4 na = a * c - b * sn, nb = b * c + a * sn; a = na; b = nb; }
        pa.x = pk2(a[0], a[1]); pa.y = pk2(a[2], a[3]); pb.x = pk2(b[0], b[1]); pb.y = pk2(b[2], b[3]);
    }
    __device__ __forceinline__ void operator()(const f32x4 (&acc)[2][2][4][2], const pg8::Unit& u, int wr, int wc, int fr, int fq) const {
        const int pn = u.pn, ty = tile_type(pn);
        const int rl0 = wr * 64 + fr;
        const size_t rowg0 = (size_t)u.pm * 256 + rl0;
        if (ty == 1 || ty == 2) {
            const bool isq = (ty == 1) ? (pn < 2) : (pn < 8);
            const float* g = gtab + ((ty == 1 ? 0 : 2) + (isq ? 0 : 1)) * 128 + 8 * fq;
            const float qs = isq ? 0.125f * LOG2E : 1.f;
            bf16_t* pb = P + rowg0 * NIN + pn * 256 + 64 * wc + 8 * fq;
#pragma unroll
            for (int ai = 0; ai < 2; ++ai)
#pragma unroll
                for (int m = 0; m < 4; ++m) {
                    float ss = dot4(acc[ai][0][m][0]) + dot4(acc[ai][0][m][1]) + dot4(acc[ai][1][m][0]) + dot4(acc[ai][1][m][1]);
                    ss += __shfl_xor(ss, 16); ss += __shfl_xor(ss, 32);
                    const float rs = rsqrtf(ss * (1.f / 64.f) + EPS) * qs;
                    const int roff = ai * 128 + m * 16;
                    const int pos = (int)((rowg0 + roff) & (size_t)smask);
                    const float* cp = cosA + pos * 32 + 8 * fq; const float* sp = sinA + pos * 32 + 8 * fq;
                    u32x2 pa0, pb0, pa1, pb1;
                    piece(acc[ai][0][m][0], acc[ai][1][m][0], rs, g, g + 32, cp, sp, ty == 1, pa0, pb0);
                    piece(acc[ai][0][m][1], acc[ai][1][m][1], rs, g + 4, g + 36, cp + 4, sp + 4, ty == 1, pa1, pb1);
                    *(u32x4*)(pb + (size_t)roff * NIN) = (u32x4){pa0.x, pa0.y, pa1.x, pa1.y};
                    *(u32x4*)(pb + (size_t)roff * NIN + 32) = (u32x4){pb0.x, pb0.y, pb1.x, pb1.y};
                    __builtin_amdgcn_sched_barrier(0);
                }
        } else if (ty == 3) {
            const bool isq = pn < 18;
            const float qs = isq ? 0.08838834764831845f * LOG2E : 1.f;
            const int hh = wc >> 1, w0 = wc & 1;
#pragma unroll
            for (int ai = 0; ai < 2; ++ai)
#pragma unroll
                for (int m = 0; m < 4; ++m) {
                    float ss = dot4(acc[ai][0][m][0]) + dot4(acc[ai][0][m][1]) + dot4(acc[ai][1][m][0]) + dot4(acc[ai][1][m][1]);
                    ss += __shfl_xor(ss, 16); ss += __shfl_xor(ss, 32);
                    if (fq == 0) xch[(ai * 128 + m * 16 + rl0) * 4 + wc] = ss;
                    __builtin_amdgcn_sched_barrier(0);
                }
            __syncthreads();
            const int dlo = 32 * w0 + 8 * fq;
            const float* g = gtab + (isq ? 4 : 5) * 128 + dlo;
            bf16_t* pb = P + rowg0 * NIN + pn * 256 + 128 * hh + dlo;
#pragma unroll
            for (int ai = 0; ai < 2; ++ai)
#pragma unroll
                for (int m = 0; m < 4; ++m) {
                    const int roff = ai * 128 + m * 16;
                    const f32x2 t2 = *(LAS const f32x2*)(xch + (roff + rl0) * 4 + 2 * hh);
                    const float rs = rsqrtf((t2[0] + t2[1]) * (1.f / 128.f) + EPS) * qs;
                    const int pos = (int)((rowg0 + roff) & (size_t)smask);
                    const float* cp = cosC + pos * 64 + dlo; const float* sp = sinC + pos * 64 + dlo;
                    u32x2 pa0, pb0, pa1, pb1;
                    piece(acc[ai][0][m][0], acc[ai][1][m][0], rs, g, g + 64, cp, sp, true, pa0, pb0);
                    piece(acc[ai][0][m][1], acc[ai][1][m][1], rs, g + 4, g + 68, cp + 4, sp + 4, true, pa1, pb1);
                    *(u32x4*)(pb + (size_t)roff * NIN) = (u32x4){pa0.x, pa0.y, pa1.x, pa1.y};
                    *(u32x4*)(pb + (size_t)roff * NIN + 64) = (u32x4){pb0.x, pb0.y, pb1.x, pb1.y};
                    __builtin_amdgcn_sched_barrier(0);
                }
        } else {
            bf16_t* pb = P + rowg0 * NIN + pn * 256 + 32 * wc + 8 * fq;
#pragma unroll
            for (int ai = 0; ai < 2; ++ai)
#pragma unroll
                for (int m = 0; m < 4; ++m)
#pragma unroll
                    for (int bj = 0; bj < 2; ++bj) {
                        f32x4 v0 = acc[ai][bj][m][0], v1 = acc[ai][bj][m][1];
                        if (ty == 4) {
#pragma unroll
                            for (int e = 0; e < 4; ++e) { v0[e] = siluf_(v0[e]); v1[e] = siluf_(v1[e]); }
                        } else if (ty == 5) {
#pragma unroll
                            for (int e = 0; e < 4; ++e) { v0[e] = sigmoidf_(v0[e]); v1[e] = sigmoidf_(v1[e]); }
                        }
                        *(u32x4*)(pb + (size_t)(ai * 128 + m * 16) * NIN + bj * 128) = pack8(v0, v1);
                        __builtin_amdgcn_sched_barrier(0);
                    }
        }
    }
};

struct BrOrder {
    int G, c;
    __device__ __forceinline__ bool next(int i, pg8::Unit& u) const {
        const int tk = i / 3, br = i - 3 * tk, tile = c + tk * G; if (tile >= 256) return false;
        u.pm = (tile >> 2) + br * 64; u.pn = (tile & 3) + br * 4; return true;
    }
    __device__ __forceinline__ void a_ready(const pg8::Unit&) const {}
    __device__ __forceinline__ void done(const pg8::Unit&) const {}
};

struct EpiBr {
    static constexpr bool PERM = true, AFTER_DRAIN = false;
    const bf16_t* P; float* MT; bf16_t* MB;
    __device__ __forceinline__ void operator()(const f32x4 (&acc)[2][2][4][2], const pg8::Unit& u, int wr, int wc, int fr, int fq) const {
        const int br = u.pm >> 6, pm = u.pm & 63, pn = u.pn & 3;
        const size_t row0 = (size_t)pm * 256 + wr * 64 + fr; const int col0 = pn * 256 + 32 * wc + 8 * fq;
#pragma unroll
        for (int ai = 0; ai < 2; ++ai)
#pragma unroll
            for (int m = 0; m < 4; ++m)
#pragma unroll
                for (int bj = 0; bj < 2; ++bj) {
                    const size_t row = row0 + ai * 128 + m * 16; const int col = col0 + bj * 128;
                    const u32x4 sg = *(const u32x4*)(P + row * NIN + COL_G + br * 1024 + col);
                    f32x4 v0 = acc[ai][bj][m][0], v1 = acc[ai][bj][m][1];
                    v0[0] *= bflo(sg.x); v0[1] *= bfhi(sg.x); v0[2] *= bflo(sg.y); v0[3] *= bfhi(sg.y);
                    v1[0] *= bflo(sg.z); v1[1] *= bfhi(sg.z); v1[2] *= bflo(sg.w); v1[3] *= bfhi(sg.w);
                    float* mt = MT + row * DM + col;
                    if (br > 0) { v0 += *(const f32x4*)mt; v1 += *(const f32x4*)(mt + 4); }
                    if (br < 2) { *(f32x4*)mt = v0; *(f32x4*)(mt + 4) = v1; }
                    else *(u32x4*)(MB + row * DM + col) = pack8(v0, v1);
                }
    }
};

struct EpiOut {
    static constexpr bool PERM = true, AFTER_DRAIN = false;
    const float* xin; float* xout; const float* mod_l; int seq0, slog;
    __device__ __forceinline__ void operator()(const f32x4 (&acc)[2][2][4][2], const pg8::Unit& u, int wr, int wc, int fr, int fq) const {
        const size_t row0 = (size_t)u.pm * 256 + wr * 64 + fr; const int col0 = u.pn * 256 + 32 * wc + 8 * fq;
#pragma unroll
        for (int ai = 0; ai < 2; ++ai)
#pragma unroll
            for (int m = 0; m < 4; ++m) {
                const size_t row = row0 + ai * 128 + m * 16;
                const float* gt = mod_l + (size_t)(seq0 + (int)(row >> slog)) * 3072 + 2048;
#pragma unroll
                for (int bj = 0; bj < 2; ++bj) {
                    const int col = col0 + bj * 128;
                    const f32x4 g0 = *(const f32x4*)(gt + col), g1 = *(const f32x4*)(gt + col + 4);
                    const f32x4 x0 = *(const f32x4*)(xin + row * DM + col), x1 = *(const f32x4*)(xin + row * DM + col + 4);
                    *(f32x4*)(xout + row * DM + col) = x0 + g0 * acc[ai][bj][m][0];
                    *(f32x4*)(xout + row * DM + col + 4) = x1 + g1 * acc[ai][bj][m][1];
                }
            }
    }
};

struct AttnCtx { const bf16_t* P; bf16_t* T; bf16_t* OC; float* LSE; const float* subln; const float* rpb; float lam, oml; int S, slog; };

__device__ __forceinline__ int crow(int i, int h) { return (i & 3) + 8 * (i >> 2) + 4 * h; }
__device__ __forceinline__ s16x4 vtr(LAS const unsigned char* p) { return __builtin_bit_cast(s16x4, __builtin_amdgcn_ds_read_tr16_b64_v4i16((LAS v4i16_t*)p)); }
#define MFMA32(a, b, c) __builtin_amdgcn_mfma_f32_32x32x16_bf16((a), (b), (c), 0, 0, 0)

template <int DQK, int DV, int MODE>
__device__ __forceinline__ void attn_item(LAS unsigned char* lds, int item, const AttnCtx& cx) {
    constexpr int KP = DQK * 2 + 16, VP = DV * 2 + 64, KBY = 64 * KP, VBY = 64 * VP, HB = KBY + VBY;
    constexpr int NQF = DQK / 16, NDV = DV / 32, NKP = DQK / 32, NVP = DV / 32, KPR = DQK / 8, VPR = DV / 8;
    static_assert(4 * HB + 4096 <= LDS_BYTES, "attention LDS");
    const int tid = otid(), lane = tid & 63, wave = __builtin_amdgcn_readfirstlane(tid >> 6), hf = wave >> 2, wq = wave & 3, r = lane & 31, h = lane >> 5, th = tid & 255;
    const int S = cx.S, slog = cx.slog;
    const bf16_t* __restrict__ P = cx.P;
    int head, tok0, seqbase, qcol, kcol, vcol, ntiles, qtok;
    int na_rows = 0, na_rs0 = 0, na_rq = 0, na_cq = 0, na_rsq = 0, na_csq = 0;
    int c_dlog = 0, c_rho = 0, c_l0 = 0, c_L = 0, c_lq = 0;
    if (MODE == 0) {
        head = item & 3; tok0 = (item >> 2) * 128; seqbase = tok0 & ~(S - 1);
        qcol = COL_A_Q + head * 128 + hf * 64; kcol = COL_A_K + head * 128 + hf * 64; vcol = COL_A_V + head * 128; ntiles = S >> 6;
        qtok = tok0 + 32 * wq + r;
    } else if (MODE == 1) {
        const int unit = item * 2 + hf; head = unit & 7; tok0 = (unit >> 3) * 128; seqbase = tok0 & ~(S - 1);
        qcol = COL_B_Q + head * 64; kcol = COL_B_K + head * 64; vcol = COL_B_V + head * 64; ntiles = 9;
        qtok = tok0 + 32 * wq + r;
        na_rows = S >> 6; const int r0 = (tok0 - seqbase) >> 6; na_rs0 = min(max(r0 - 4, 0), na_rows - 8);
        na_rq = r0 + (wq >> 1); na_cq = 32 * (wq & 1) + r; na_rsq = min(max(na_rq - 4, 0), na_rows - 8); na_csq = min(max(na_cq - 8, 0), 48);
    } else {
        const int unit = item * 2 + hf; head = unit % 12; const int blk = unit / 12; tok0 = blk * 128; seqbase = tok0 & ~(S - 1);
        qcol = COL_C_Q + head * 128; kcol = COL_C_K + head * 128; vcol = COL_C_V + head * 128; ntiles = 4;
        c_dlog = 2 * (head >> 2); const int b = (tok0 - seqbase) >> 7; c_rho = b & ((1 << c_dlog) - 1); c_l0 = (b >> c_dlog) * 128; c_L = S >> c_dlog;
        c_lq = c_l0 + 32 * wq + r; qtok = seqbase + (c_lq << c_dlog) + c_rho;
    }
    auto ktok = [&](int j, int kr) -> int {
        if (MODE == 0) return seqbase + 64 * j + kr;
        if (MODE == 1) return seqbase + min(na_rs0 + j, na_rows - 1) * 64 + kr;
        const int lk = min(max(c_l0 - 64 + 64 * j + kr, 0), c_L - 1); return seqbase + (lk << c_dlog) + c_rho;
    };
    const bool loadV = !(MODE == 0 && hf == 1);
    u32x4 kreg[NKP], vreg[NVP];
    auto gload = [&](int j) {
#pragma unroll
        for (int i = 0; i < NKP; ++i) { const int pid = th + 256 * i, row = pid / KPR, cp = pid % KPR; kreg[i] = *(const u32x4*)(P + (size_t)ktok(j, row) * NIN + kcol + cp * 8); }
        if (loadV) {
#pragma unroll
            for (int i = 0; i < NVP; ++i) { const int pid = th + 256 * i, row = pid / VPR, cp = pid % VPR; vreg[i] = *(const u32x4*)(P + (size_t)ktok(j, row) * NIN + vcol + cp * 8); }
        }
    };
    auto lstore = [&](int b) {
        LAS unsigned char* base = lds + (b * 2 + hf) * HB;
#pragma unroll
        for (int i = 0; i < NKP; ++i) { const int pid = th + 256 * i, row = pid / KPR, cp = pid % KPR; *(LAS u32x4*)(base + row * KP + cp * 16) = kreg[i]; }
        if (loadV) {
#pragma unroll
            for (int i = 0; i < NVP; ++i) { const int pid = th + 256 * i, row = pid / VPR, cp = pid % VPR; *(LAS u32x4*)(base + KBY + row * VP + cp * 16) = vreg[i]; }
        }
    };
    LAS float* biasL = (LAS float*)(lds + 4 * HB) + hf * 512;
    gload(0);
    bf16x8 qf[NQF];
#pragma unroll
    for (int ks = 0; ks < NQF; ++ks) qf[ks] = *(const bf16x8*)(P + (size_t)qtok * NIN + qcol + 16 * ks + 8 * h);
    if (MODE == 1) { for (int i = th; i < 465; i += 256) biasL[i] = cx.rpb[head * 465 + i] * LOG2E; }
    lstore(0);
    f32x16 O[NDV];
#pragma unroll
    for (int d = 0; d < NDV; ++d)
#pragma unroll
        for (int i = 0; i < 16; ++i) O[d][i] = 0.f;
    float mrun = NEGBIG, lrun = 0.f;
    __syncthreads();
    const int q4 = (lane & 15) >> 2, p4 = lane & 3, rblk = (lane >> 4) & 1;
    for (int j = 0; j < ntiles; ++j) {
        if (j + 1 < ntiles) gload(j + 1);
        bool active = true;
        if (MODE == 1) { const int rk = na_rs0 + j; active = (rk >= na_rsq) && (rk < na_rsq + 8); }
        if (MODE == 2) { const int lk0 = c_l0 - 64 + 64 * j; active = ((wq < 2) ? (j <= 2) : (j >= 1)) && (lk0 + 63 >= 0) && (lk0 < c_L); }
        if (active) {
            LAS const unsigned char* Kb = lds + ((j & 1) * 2 + hf) * HB;
            LAS const unsigned char* Vb = lds + ((j & 1) * 2 + (MODE == 0 ? 0 : hf)) * HB + KBY;
            f32x16 s0, s1;
#pragma unroll
            for (int i = 0; i < 16; ++i) { s0[i] = 0.f; s1[i] = 0.f; }
#pragma unroll
            for (int ks = 0; ks < NQF; ++ks) {
                const bf16x8 k0 = *(LAS const bf16x8*)(Kb + r * KP + (16 * ks + 8 * h) * 2);
                const bf16x8 k1 = *(LAS const bf16x8*)(Kb + (32 + r) * KP + (16 * ks + 8 * h) * 2);
                s0 = MFMA32(k0, qf[ks], s0); s1 = MFMA32(k1, qf[ks], s1);
            }
            if (MODE == 1) {
                const int rk = na_rs0 + j; const int bbase = (rk - na_rq + 7) * 31 + 15 - na_cq;
#pragma unroll
                for (int i = 0; i < 16; ++i) {
                    const int ck0 = crow(i, h), ck1 = ck0 + 32;
                    const bool v0 = (ck0 >= na_csq) && (ck0 < na_csq + 16), v1 = (ck1 >= na_csq) && (ck1 < na_csq + 16);
                    const float b0 = biasL[v0 ? bbase + ck0 : 0], b1 = biasL[v1 ? bbase + ck1 : 0];
                    s0[i] = v0 ? s0[i] + b0 : NEGBIG; s1[i] = v1 ? s1[i] + b1 : NEGBIG;
                }
            }
            if (MODE == 2) {
                const int lk0 = c_l0 - 64 + 64 * j;
#pragma unroll
                for (int i = 0; i < 16; ++i) {
                    const int lka = lk0 + crow(i, h), lkb = lka + 32;
                    const bool v0 = (lka >= 0) && (lka < c_L) && (abs(lka - c_lq) <= 64), v1 = (lkb >= 0) && (lkb < c_L) && (abs(lkb - c_lq) <= 64);
                    s0[i] = v0 ? s0[i] : NEGBIG; s1[i] = v1 ? s1[i] : NEGBIG;
                }
            }
            float mx = fmaxf(s0[0], s1[0]);
#pragma unroll
            for (int i = 1; i < 16; ++i) mx = fmaxf(mx, fmaxf(s0[i], s1[i]));
            mx = fmaxf(mx, __shfl_xor(mx, 32));
            const float mn = fmaxf(mrun, mx), alpha = fast_exp2(mrun - mn);
            mrun = mn;
            float ps = 0.f;
#pragma unroll
            for (int i = 0; i < 16; ++i) { s0[i] = fast_exp2(s0[i] - mn); s1[i] = fast_exp2(s1[i] - mn); ps += s0[i] + s1[i]; }
            lrun = lrun * alpha + ps;
#pragma unroll
            for (int d = 0; d < NDV; ++d)
#pragma unroll
                for (int i = 0; i < 16; ++i) O[d][i] *= alpha;
            bf16x8 pa[2][2];
            { u32x4 w;
              w.x = pk2(s0[0], s0[1]); w.y = pk2(s0[2], s0[3]); w.z = pk2(s0[4], s0[5]); w.w = pk2(s0[6], s0[7]); pa[0][0] = __builtin_bit_cast(bf16x8, w);
              w.x = pk2(s0[8], s0[9]); w.y = pk2(s0[10], s0[11]); w.z = pk2(s0[12], s0[13]); w.w = pk2(s0[14], s0[15]); pa[0][1] = __builtin_bit_cast(bf16x8, w);
              w.x = pk2(s1[0], s1[1]); w.y = pk2(s1[2], s1[3]); w.z = pk2(s1[4], s1[5]); w.w = pk2(s1[6], s1[7]); pa[1][0] = __builtin_bit_cast(bf16x8, w);
              w.x = pk2(s1[8], s1[9]); w.y = pk2(s1[10], s1[11]); w.z = pk2(s1[12], s1[13]); w.w = pk2(s1[14], s1[15]); pa[1][1] = __builtin_bit_cast(bf16x8, w); }
            LAS const unsigned char* vl = Vb + (4 * h + q4) * VP + (16 * rblk + 4 * p4) * 2;
#pragma unroll
            for (int d = 0; d < NDV; ++d)
#pragma unroll
                for (int t = 0; t < 2; ++t)
#pragma unroll
                    for (int sp = 0; sp < 2; ++sp) {
                        const s16x4 lo = vtr(vl + (32 * t + 16 * sp) * VP + d * 64);
                        const s16x4 hi = vtr(vl + (32 * t + 16 * sp + 8) * VP + d * 64);
                        const bf16x8 vf = __builtin_shufflevector(lo, hi, 0, 1, 2, 3, 4, 5, 6, 7);
                        O[d] = MFMA32(vf, pa[t][sp], O[d]);
                    }
        }
        if (j + 1 < ntiles) lstore((j + 1) & 1);
        __syncthreads();
    }
    const float lt = lrun + __shfl_xor(lrun, 32);
    const float inv = 1.f / lt;
    if (MODE == 0) {
        LAS float* X = (LAS float*)lds;
        if (hf == 1) {
#pragma unroll
            for (int d = 0; d < NDV; ++d)
#pragma unroll
                for (int g4 = 0; g4 < 4; ++g4) {
                    f32x4 v = {O[d][4 * g4] * inv, O[d][4 * g4 + 1] * inv, O[d][4 * g4 + 2] * inv, O[d][4 * g4 + 3] * inv};
                    *(LAS f32x4*)(X + (32 * wq + r) * 132 + 32 * d + 8 * g4 + 4 * h) = v;
                }
        }
        __syncthreads();
        if (hf == 0) {
            float ss = 0.f;
#pragma unroll
            for (int d = 0; d < NDV; ++d)
#pragma unroll
                for (int g4 = 0; g4 < 4; ++g4) {
                    const f32x4 o2 = *(LAS const f32x4*)(X + (32 * wq + r) * 132 + 32 * d + 8 * g4 + 4 * h);
#pragma unroll
                    for (int e = 0; e < 4; ++e) { const float o = O[d][4 * g4 + e] * inv - cx.lam * o2[e]; O[d][4 * g4 + e] = o; ss += o * o; }
                }
            ss += __shfl_xor(ss, 32);
            const float rstd = rsqrtf(ss * (1.f / 128.f) + EPS) * cx.oml;
#pragma unroll
            for (int d = 0; d < NDV; ++d)
#pragma unroll
                for (int g4 = 0; g4 < 4; ++g4) {
                    const int dv = 32 * d + 8 * g4 + 4 * h;
                    const f32x4 gn = *(const f32x4*)(cx.subln + dv);
                    const u32x2 sz = *(const u32x2*)(P + (size_t)qtok * NIN + COL_Z + head * 128 + dv);
                    u32x2 o;
                    o.x = pk2(O[d][4 * g4] * rstd * gn[0] * bflo(sz.x), O[d][4 * g4 + 1] * rstd * gn[1] * bfhi(sz.x));
                    o.y = pk2(O[d][4 * g4 + 2] * rstd * gn[2] * bflo(sz.y), O[d][4 * g4 + 3] * rstd * gn[3] * bfhi(sz.y));
                    *(u32x2*)(cx.T + (size_t)qtok * 512 + head * 128 + dv) = o;
                }
        }
        __syncthreads();
    } else if (MODE == 1) {
#pragma unroll
        for (int d = 0; d < NDV; ++d)
#pragma unroll
            for (int g4 = 0; g4 < 4; ++g4) {
                const int dv = 32 * d + 8 * g4 + 4 * h;
                const u32x2 sz = *(const u32x2*)(P + (size_t)qtok * NIN + COL_Z + 512 + head * 64 + dv);
                u32x2 o;
                o.x = pk2(O[d][4 * g4] * inv * bflo(sz.x), O[d][4 * g4 + 1] * inv * bfhi(sz.x));
                o.y = pk2(O[d][4 * g4 + 2] * inv * bflo(sz.y), O[d][4 * g4 + 3] * inv * bfhi(sz.y));
                *(u32x2*)(cx.T + (size_t)TC * 512 + (size_t)qtok * 512 + head * 64 + dv) = o;
            }
    } else {
#pragma unroll
        for (int d = 0; d < NDV; ++d)
#pragma unroll
            for (int g4 = 0; g4 < 4; ++g4) {
                const int dv = 32 * d + 8 * g4 + 4 * h;
                u32x2 o; o.x = pk2(O[d][4 * g4] * inv, O[d][4 * g4 + 1] * inv); o.y = pk2(O[d][4 * g4 + 2] * inv, O[d][4 * g4 + 3] * inv);
                *(u32x2*)(cx.OC + (size_t)qtok * 1536 + head * 128 + dv) = o;
            }
        if (h == 0) cx.LSE[(size_t)qtok * 12 + head] = mrun + __log2f(lt);
    }
}

constexpr int N_ITEM_A = (TC / 128) * 4, N_ITEM_B = (TC / 128) * 8 / 2, N_ITEM_C = (TC / 128) * 12 / 2;
__device__ __forceinline__ void phase_attn(LAS unsigned char* lds, const AttnCtx& cx) {
    const int G = gridDim.x, c = blockIdx.x;
    if (PH_MASK & 8) for (int it = c; it < N_ITEM_A; it += G) attn_item<64, 128, 0>(lds, it, cx);
    if (PH_MASK & 16) for (int it = c; it < N_ITEM_C; it += G) attn_item<128, 128, 2>(lds, it, cx);
    if (PH_MASK & 32) for (int it = c; it < N_ITEM_B; it += G) attn_item<64, 64, 1>(lds, it, cx);
}

__device__ __forceinline__ void phase_cmix(const bf16_t* __restrict__ P, const bf16_t* __restrict__ OC, const float* __restrict__ LSE, bf16_t* T2) {
    for (int idx = blockIdx.x * NTHR + otid(); idx < TC * 64; idx += gridDim.x * NTHR) {
        const int tok = idx >> 6, c8 = idx & 63, hh = c8 >> 4, dv = (c8 & 15) * 8;
        const float l0 = LSE[(size_t)tok * 12 + hh], l1 = LSE[(size_t)tok * 12 + 4 + hh], l2 = LSE[(size_t)tok * 12 + 8 + hh];
        const float mx = fmaxf(l0, fmaxf(l1, l2));
        float w0 = fast_exp2(l0 - mx), w1 = fast_exp2(l1 - mx), w2 = fast_exp2(l2 - mx);
        const float iw = 1.f / (w0 + w1 + w2); w0 *= iw; w1 *= iw; w2 *= iw;
        const u32x4 a = *(const u32x4*)(OC + (size_t)tok * 1536 + hh * 128 + dv), b = *(const u32x4*)(OC + (size_t)tok * 1536 + (4 + hh) * 128 + dv),
                    c = *(const u32x4*)(OC + (size_t)tok * 1536 + (8 + hh) * 128 + dv), z = *(const u32x4*)(P + (size_t)tok * NIN + COL_Z + 1024 + hh * 128 + dv);
        u32x4 o;
        o.x = pk2((w0 * bflo(a.x) + w1 * bflo(b.x) + w2 * bflo(c.x)) * bflo(z.x), (w0 * bfhi(a.x) + w1 * bfhi(b.x) + w2 * bfhi(c.x)) * bfhi(z.x));
        o.y = pk2((w0 * bflo(a.y) + w1 * bflo(b.y) + w2 * bflo(c.y)) * bflo(z.y), (w0 * bfhi(a.y) + w1 * bfhi(b.y) + w2 * bfhi(c.y)) * bfhi(z.y));
        o.z = pk2((w0 * bflo(a.z) + w1 * bflo(b.z) + w2 * bflo(c.z)) * bflo(z.z), (w0 * bfhi(a.z) + w1 * bfhi(b.z) + w2 * bfhi(c.z)) * bfhi(z.z));
        o.w = pk2((w0 * bflo(a.w) + w1 * bflo(b.w) + w2 * bflo(c.w)) * bflo(z.w), (w0 * bfhi(a.w) + w1 * bfhi(b.w) + w2 * bfhi(c.w)) * bfhi(z.w));
        *(u32x4*)(T2 + (size_t)tok * 512 + hh * 128 + dv) = o;
    }
}

#ifndef ONE_LAUNCH
#define ONE_LAUNCH 1
#endif

__global__ void __launch_bounds__(NTHR, 2) mega(Params p) {
    extern __shared__ __attribute__((aligned(16))) unsigned char lds_raw[];
    LAS unsigned char* lds = (LAS unsigned char*)lds_raw;
    unsigned char* ws = p.ws;
    for (int ph = p.ph_lo; ph < p.ph_hi; ++ph) {
        if (ph > p.ph_lo) { cg::this_grid().sync(); }
        if (ph == 0) { if (PH_MASK & 1) phase_pre(p, lds); continue; }
        const int q = ph - 1, cl = q / 6, k = q - cl * 6, c = cl >> 1, l = cl & 1;
        const int S = (c == 0) ? 4096 : 2048, slog = (c == 0) ? 12 : 11, seq0 = (c == 0) ? 0 : 4 + (c - 1) * 8;
        const float* xin = (l == 0) ? ((c == 0) ? p.in[0] : p.in[1] + (size_t)(c - 1) * TC * DM) : p.out + (size_t)c * TC * DM;
        float* xout = p.out + (size_t)c * TC * DM;
        const float* mod_l = (const float*)(ws + WS_MOD) + (size_t)l * NSEQ * 3072;
        bf16_t* H = (bf16_t*)(ws + WS_H); bf16_t* P = (bf16_t*)(ws + WS_P); bf16_t* T = (bf16_t*)(ws + WS_T); bf16_t* OC = (bf16_t*)(ws + WS_OC);
        float* LSE = (float*)(ws + WS_LSE); float* MT = (float*)(ws + WS_MT); bf16_t* MB = (bf16_t*)(ws + WS_MB);
        if (k == 0) {
            if (PH_MASK & 2) phase_h(xin, p.in[4] + l * DM, mod_l, seq0, slog, H);
        } else if (k == 1) {
            pg8::Gemm g{H, (const bf16_t*)(ws + WS_WIN) + (size_t)l * NIN * DM, TC, NIN, DM};
            pg8::StaticOrder So; So.init(TC, NIN, (int)gridDim.x, (int)blockIdx.x);
            EpiIn E{P, (const float*)(ws + WS_COSA), (const float*)(ws + WS_SINA), (const float*)(ws + WS_COSC), (const float*)(ws + WS_SINC),
                    (const float*)(ws + WS_GAIN) + l * 6 * 128, S - 1, (LAS float*)(lds + XCH_OFF)};
            if (PH_MASK & 4) pg8::gemm_phase<EpiIn, pg8::StaticOrder, true, true>(lds, g, So, E);
        } else if (k == 2) {
            const float* L = (const float*)(ws + WS_LAM);
            AttnCtx cx{P, T, OC, LSE, p.in[14] + l * 128, p.in[17] + (size_t)l * 8 * 465, L[l], L[2 + l], S, slog};
            phase_attn(lds, cx);
        } else if (k == 3) {
            if (PH_MASK & 64) phase_cmix(P, OC, LSE, T + (size_t)2 * TC * 512);
        } else if (k == 4) {
            pg8::Gemm g{T, (const bf16_t*)(ws + WS_WBR) + (size_t)l * 3072 * 512, 3 * TC, 3072, 512};
            BrOrder So{(int)gridDim.x, (int)blockIdx.x};
            EpiBr E{P, MT, MB};
            if (PH_MASK & 128) pg8::gemm_phase<EpiBr, BrOrder, true, true>(lds, g, So, E);
        } else {
            pg8::Gemm g{MB, (const bf16_t*)(ws + WS_WOUT) + (size_t)l * DM * DM, TC, DM, DM};
            pg8::StaticOrder So; So.init(TC, DM, (int)gridDim.x, (int)blockIdx.x);
            EpiOut E{xin, xout, mod_l, seq0, slog};
            if (PH_MASK & 256) pg8::gemm_phase<EpiOut, pg8::StaticOrder, true, true>(lds, g, So, E);
        }
    }
}

extern "C" void kernel_launch(void* const* d_in, const int* in_sizes, int n_in, void* d_out, int out_size, void* d_ws, size_t ws_size, hipStream_t stream) {
    static int grid = 0;
    if (grid == 0) {
        if (n_in != 22 || ws_size < WS_END) { fprintf(stderr, "kernel_launch: unexpected n_in %d / ws_size %zu (need %zu)\n", n_in, ws_size, (size_t)WS_END); grid = -1; return; }
        int dev = 0, cus = 0, per_cu = 0;
        (void)hipGetDevice(&dev); (void)hipDeviceGetAttribute(&cus, hipDeviceAttributeMultiprocessorCount, dev);
        if (hipFuncSetAttribute((const void*)mega, hipFuncAttributeMaxDynamicSharedMemorySize, LDS_BYTES) != hipSuccess) { fprintf(stderr, "kernel_launch: hipFuncSetAttribute failed\n"); grid = -1; return; }
        (void)hipOccupancyMaxActiveBlocksPerMultiprocessor(&per_cu, (const void*)mega, NTHR, LDS_BYTES);
        if (per_cu < 1) { fprintf(stderr, "kernel_launch: occupancy query says %d blocks per CU\n", per_cu); per_cu = 1; }
        (void)hipGetLastError();
        grid = cus;
    }
    if (grid < 0) return;
    Params p{};
    for (int i = 0; i < 22; ++i) p.in[i] = (const float*)d_in[i];
    p.out = (float*)d_out; p.ws = (unsigned char*)d_ws;
#if ONE_LAUNCH
    p.ph_lo = 0; p.ph_hi = NPHASE;
    void* args[] = {&p};
    hipError_t e = hipLaunchCooperativeKernel((const void*)mega, dim3(grid), dim3(NTHR), args, LDS_BYTES, stream);
    if (e != hipSuccess) fprintf(stderr, "cooperative launch failed: %s (grid %d)\n", hipGetErrorString(e), grid);
#else
    for (int ph = 0; ph < NPHASE; ++ph) {
        p.ph_lo = ph; p.ph_hi = ph + 1;
        hipLaunchKernelGGL(mega, dim3(grid), dim3(NTHR), LDS_BYTES, stream, p);
    }
#endif
}
```

```cpp
#include <hip/hip_runtime.h>
#include <hip/hip_cooperative_groups.h>
#include <cstdio>
#include <cstdint>
namespace cg = cooperative_groups;
__device__ __forceinline__ int otid() { int t = threadIdx.x; asm volatile("" : "+v"(t)); return t; }
namespace pg8 {
#define PG8_LAS __attribute__((address_space(3)))
typedef unsigned short bf16_t;
typedef short bf16x8 __attribute__((ext_vector_type(8)));
typedef float f32x4 __attribute__((ext_vector_type(4)));
typedef unsigned u32x4 __attribute__((ext_vector_type(4)));
constexpr int BM = 256, BK = 64, HALF = 128, HTB = HALF * BK * 2  , STAGE_BYTES = 8 * HTB, NXCD = 8, WGM = 8;

__host__ __device__ __forceinline__ int lds_byte(int r, int c) { const int st = (r >> 4) * 2 + (c >> 5), rr = r & 15, cc = c & 31, ob = rr * 64 + cc * 2; return st * 1024 + (ob ^ (((ob >> 9) & 1) << 5)); }
__host__ __device__ __forceinline__ void stage_rc(int b, int& R, int& C) { const int st = b / 1024, sb = b % 1024, swz = sb ^ (((sb >> 9) & 1) << 5); R = (st >> 1) * 16 + swz / 64; C = (st & 1) * 32 + (swz % 64) / 2; }
__host__ __device__ __forceinline__ int perm32(int rho) { const int n = rho >> 4, i = rho & 15; return 8 * (i >> 2) + 4 * n + (i & 3); }

struct Unit { int pm, pn; };
struct Gemm { const bf16_t* A; const bf16_t* Bt; int M, N, K; };

struct StaticOrder {
    int nM, nN, nwg, G, c;
    __host__ __device__ void init(int M, int N, int G_, int c_) { nM = M / BM; nN = N / BM; nwg = nM * nN; G = G_; c = c_; }
    __host__ __device__ bool next(int i, Unit& u) const {
        const long L = (long)i * G + c; if (L >= nwg) return false;
        int wgid = (int)L; { const int q = nwg / NXCD, r = nwg % NXCD, xcd = wgid % NXCD, off = wgid / NXCD; wgid = (xcd < r ? xcd * (q + 1) : r * (q + 1) + (xcd - r) * q) + off; }
        const int nig = WGM * nN, gid = wgid / nig, fm = gid * WGM, gsz = (nM - fm) < WGM ? (nM - fm) : WGM;
        u.pm = fm + ((wgid % nig) % gsz); u.pn = (wgid % nig) / gsz; return true;
    }
    __device__ __forceinline__ void a_ready(const Unit&) const {}
    __device__ __forceinline__ void done(const Unit&) const {}
};

__device__ __forceinline__ unsigned cvt_pk_bf16(float lo, float hi) { unsigned r; asm volatile("v_cvt_pk_bf16_f32 %0, %1, %2" : "=v"(r) : "v"(lo), "v"(hi)); return r; }

template <class Epi, class Sched, bool ALIGN_EPI = false, bool SP2 = false>
__device__ __forceinline__ void gemm_phase(PG8_LAS unsigned char* lds, const Gemm g, const Sched& S, const Epi& E) {
    const int tid = otid(), wid = __builtin_amdgcn_readfirstlane(tid >> 6), lane = tid & 63, wr = wid >> 2, wc = wid & 3, fr = lane & 15, fq = lane >> 4;
    const int K = g.K, nt = K / BK;
    unsigned voffA[2], voffB[2];
#pragma unroll
    for (int i = 0; i < 2; ++i) { int R, C; stage_rc(tid * 16 + i * 8192, R, C); const int Rb = Epi::PERM ? ((R & ~31) + perm32(R & 31)) : R;
        voffA[i] = (unsigned)(R * K + C) * 2u; voffB[i] = (unsigned)(Rb * K + C) * 2u; }
    const size_t kstep = (size_t)(BK * 2);
    const size_t hstep = (size_t)HALF * K * 2;
    const size_t tstep = 2 * hstep;
    const unsigned ldsw = (unsigned)wid * 1024u;
    const int aoff = lds_byte(wr * 64 + fr, fq * 8), boff = lds_byte(wc * 32 + fr, fq * 8);
#define PG8_SA(b, h) (((b) * 2 + (h)) * HTB)
#define PG8_SB(b, h) ((4 + (b) * 2 + (h)) * HTB)
#define PG8_STAGE(bufoff, gbase, voff) do { _Pragma("unroll") for (int _i = 0; _i < 2; ++_i) \
        __builtin_amdgcn_global_load_lds((const unsigned*)((const char*)(gbase) + (voff)[_i]), (PG8_LAS unsigned*)(lds + (bufoff) + ldsw + _i * 8192), 16, 0, 0); } while (0)
#define PG8_LDA(dst, b, h) do { _Pragma("unroll") for (int m = 0; m < 4; ++m) _Pragma("unroll") for (int k = 0; k < 2; ++k) dst[m][k] = *(const PG8_LAS bf16x8*)(lds + PG8_SA(b, h) + aoff + m * 2048 + k * 1024); } while (0)
#define PG8_LDB(dst, b, h) do { _Pragma("unroll") for (int n = 0; n < 2; ++n) _Pragma("unroll") for (int k = 0; k < 2; ++k) dst[n][k] = *(const PG8_LAS bf16x8*)(lds + PG8_SB(b, h) + boff + n * 2048 + k * 1024); } while (0)
#define PG8_MMA(ai, bj, At, Bt) do { __builtin_amdgcn_s_setprio(1); _Pragma("unroll") for (int m = 0; m < 4; ++m) _Pragma("unroll") for (int n = 0; n < 2; ++n) _Pragma("unroll") for (int k = 0; k < 2; ++k) \
        acc[ai][bj][m][n] = __builtin_amdgcn_mfma_f32_16x16x32_bf16(Bt[n][k], At[m][k], acc[ai][bj][m][n], 0, 0, 0); __builtin_amdgcn_s_setprio(0); } while (0)
#define PG8_WAIT_V(n) asm volatile("s_waitcnt vmcnt(" #n ")" ::: "memory")
#define PG8_WAIT_L(n) asm volatile("s_waitcnt lgkmcnt(" #n ")" ::: "memory")
#define PG8_BAR __builtin_amdgcn_s_barrier()
#define PG8_SCHED __builtin_amdgcn_sched_barrier(0)
    Unit cur, nxt; int ui = 0;
    if (!S.next(0, cur)) return;
    f32x4 acc[2][2][4][2];
#pragma unroll
    for (int a = 0; a < 2; ++a)
#pragma unroll
        for (int b = 0; b < 2; ++b)
#pragma unroll
            for (int m = 0; m < 4; ++m)
#pragma unroll
                for (int n = 0; n < 2; ++n) acc[a][b][m][n] = (f32x4){0.f, 0.f, 0.f, 0.f};
    bf16x8 At[4][2], B0[2][2], B1[2][2];
    const char* cA = (const char*)g.A + (size_t)cur.pm * tstep; const char* cB = (const char*)g.Bt + (size_t)cur.pn * tstep;
    S.a_ready(cur);
    if constexpr (SP2) {
        PG8_STAGE(PG8_SB(0, 0), cB, voffB); PG8_STAGE(PG8_SB(0, 1), cB + hstep, voffB); PG8_STAGE(PG8_SA(0, 0), cA, voffA); PG8_STAGE(PG8_SA(0, 1), cA + hstep, voffA);
        if (wr == 1) PG8_BAR;
        PG8_WAIT_V(2); PG8_BAR;
        PG8_STAGE(PG8_SB(1, 0), cB + kstep, voffB); PG8_STAGE(PG8_SA(1, 0), cA + kstep, voffA); PG8_STAGE(PG8_SB(1, 1), cB + hstep + kstep, voffB);
        PG8_WAIT_V(6); PG8_BAR;
    } else {
        PG8_STAGE(PG8_SB(0, 0), cB, voffB); PG8_STAGE(PG8_SA(0, 0), cA, voffA); PG8_STAGE(PG8_SB(0, 1), cB + hstep, voffB); PG8_STAGE(PG8_SA(0, 1), cA + hstep, voffA);
        if (wr == 1) PG8_BAR;
        PG8_WAIT_V(4); PG8_BAR;
        PG8_STAGE(PG8_SB(1, 0), cB + kstep, voffB); PG8_STAGE(PG8_SA(1, 0), cA + kstep, voffA); PG8_STAGE(PG8_SB(1, 1), cB + hstep + kstep, voffB);
        PG8_WAIT_V(6); PG8_BAR;
    }
    for (;;) {
        const bool has_next = S.next(ui + 1, nxt);
        const char* nA = has_next ? (const char*)g.A + (size_t)nxt.pm * tstep : cA; const char* nB = has_next ? (const char*)g.Bt + (size_t)nxt.pn * tstep : cB;
        for (int t = 0; t < nt; t += 2) {
            const bool last = (t == nt - 2);
            const char* a1 = cA + (size_t)(t + 1) * kstep;
            const char* a2 = last ? nA : cA + (size_t)(t + 2) * kstep; const char* b2 = last ? nB : cB + (size_t)(t + 2) * kstep;
            const char* a3 = a2 + kstep; const char* b3 = b2 + kstep;
            if (last && has_next) S.a_ready(nxt);
            if constexpr (SP2) {
            PG8_LDB(B0, 0, 0); PG8_LDB(B1, 0, 1); PG8_SCHED; PG8_LDA(At, 0, 0); PG8_STAGE(PG8_SA(1, 1), a1 + hstep, voffA);
            PG8_WAIT_V(8); PG8_WAIT_L(0); PG8_BAR; PG8_MMA(0, 0, At, B0); PG8_MMA(0, 1, At, B1); PG8_BAR; PG8_SCHED;
            PG8_LDA(At, 0, 1); PG8_STAGE(PG8_SB(0, 0), b2, voffB); PG8_STAGE(PG8_SB(0, 1), b2 + hstep, voffB); PG8_STAGE(PG8_SA(0, 0), a2, voffA);
            PG8_WAIT_V(8); PG8_WAIT_L(0); PG8_BAR; PG8_MMA(1, 0, At, B0); PG8_MMA(1, 1, At, B1); PG8_BAR; PG8_SCHED;
            PG8_LDB(B0, 1, 0); PG8_LDB(B1, 1, 1); PG8_SCHED; PG8_LDA(At, 1, 0); PG8_STAGE(PG8_SA(0, 1), a2 + hstep, voffA);
            PG8_WAIT_V(8); PG8_WAIT_L(0); PG8_BAR; PG8_MMA(0, 0, At, B0); PG8_MMA(0, 1, At, B1); PG8_BAR; PG8_SCHED;
            PG8_LDA(At, 1, 1); PG8_STAGE(PG8_SB(1, 0), b3, voffB); PG8_STAGE(PG8_SB(1, 1), b3 + hstep, voffB); PG8_STAGE(PG8_SA(1, 0), a3, voffA);
            PG8_WAIT_V(8); PG8_WAIT_L(0); PG8_BAR; PG8_MMA(1, 0, At, B0); PG8_MMA(1, 1, At, B1); PG8_BAR; PG8_SCHED;
            } else {
            PG8_LDB(B0, 0, 0); PG8_SCHED; PG8_LDA(At, 0, 0); PG8_STAGE(PG8_SA(1, 1), a1 + hstep, voffA);
            PG8_WAIT_L(8); PG8_BAR; PG8_WAIT_L(0); PG8_MMA(0, 0, At, B0); PG8_BAR; PG8_SCHED;
            PG8_LDB(B1, 0, 1); PG8_STAGE(PG8_SB(0, 0), b2, voffB);
            PG8_BAR; PG8_WAIT_L(0); PG8_MMA(0, 1, At, B1); PG8_BAR;
            PG8_LDA(At, 0, 1); PG8_STAGE(PG8_SA(0, 0), a2, voffA);
            PG8_BAR; PG8_WAIT_L(0); PG8_MMA(1, 0, At, B0); PG8_BAR; PG8_SCHED;
            PG8_STAGE(PG8_SB(0, 1), b2 + hstep, voffB);
            PG8_WAIT_V(6); PG8_BAR; PG8_MMA(1, 1, At, B1); PG8_BAR;
            PG8_LDB(B0, 1, 0); PG8_SCHED; PG8_LDA(At, 1, 0); PG8_STAGE(PG8_SA(0, 1), a2 + hstep, voffA);
            PG8_WAIT_L(8); PG8_BAR; PG8_WAIT_L(0); PG8_MMA(0, 0, At, B0); PG8_BAR; PG8_SCHED;
            PG8_LDB(B1, 1, 1); PG8_STAGE(PG8_SB(1, 0), b3, voffB);
            PG8_BAR; PG8_WAIT_L(0); PG8_MMA(0, 1, At, B1); PG8_BAR;
            PG8_LDA(At, 1, 1); PG8_STAGE(PG8_SA(1, 0), a3, voffA);
            PG8_BAR; PG8_WAIT_L(0); PG8_MMA(1, 0, At, B0); PG8_BAR; PG8_SCHED;
            PG8_STAGE(PG8_SB(1, 1), b3 + hstep, voffB);
            PG8_WAIT_V(6); PG8_BAR; PG8_MMA(1, 1, At, B1); PG8_BAR;
            }
        }
        if constexpr (ALIGN_EPI) { if (wr == 0) PG8_BAR; }
        if constexpr (!Epi::AFTER_DRAIN) { E(acc, cur, wr, wc, fr, fq); S.done(cur); }
        if (!has_next) break;
#pragma unroll
        for (int a = 0; a < 2; ++a)
#pragma unroll
            for (int b = 0; b < 2; ++b)
#pragma unroll
                for (int m = 0; m < 4; ++m)
#pragma unroll
                    for (int n = 0; n < 2; ++n) acc[a][b][m][n] = (f32x4){0.f, 0.f, 0.f, 0.f};
        cur = nxt; cA = nA; cB = nB; ++ui;
        if constexpr (ALIGN_EPI) { if (wr == 1) PG8_BAR; }
    }
    PG8_WAIT_V(0);
    if constexpr (!ALIGN_EPI) { if (wr == 0) PG8_BAR; }
    PG8_BAR;
    if constexpr (Epi::AFTER_DRAIN) { E.fused(acc, cur, wr, wc, fr, fq, lds, wid, lane); S.done(cur); }
#undef PG8_SA
#undef PG8_SB
#undef PG8_STAGE
#undef PG8_LDA
#undef PG8_LDB
#undef PG8_MMA
#undef PG8_WAIT_V
#undef PG8_WAIT_L
#undef PG8_BAR
#undef PG8_SCHED
}
}

#define LAS __attribute__((address_space(3)))
#ifndef PH_MASK
#define PH_MASK 0xFFF
#endif
#ifndef DUP_PH
#define DUP_PH -1
#endif
typedef unsigned short bf16_t;
typedef short bf16x8 __attribute__((ext_vector_type(8)));
typedef short s16x4 __attribute__((ext_vector_type(4)));
typedef short v4i16_t __attribute__((ext_vector_type(4)));
typedef float f32x2 __attribute__((ext_vector_type(2)));
typedef float f32x4 __attribute__((ext_vector_type(4)));
typedef float f32x16 __attribute__((ext_vector_type(16)));
typedef unsigned u32x2 __attribute__((ext_vector_type(2)));
typedef unsigned u32x4 __attribute__((ext_vector_type(4)));
typedef __bf16 bf16x2_t __attribute__((ext_vector_type(2)));

constexpr int DM = 1024, NIN = 12288, TC = 16384, NCHUNK = 5, NSEQ = 36, NTHR = 512;
constexpr int COL_A_Q = 0, COL_A_K = 512, COL_A_V = 1024, COL_B_Q = 1536, COL_B_K = 2048, COL_B_V = 2560, COL_C_Q = 3072, COL_C_K = 4608,
              COL_C_V = 6144, COL_Z = 7680, COL_G = 9216;
constexpr float EPS = 1e-6f, LOG2E = 1.4426950408889634f, NEGBIG = -1e30f;

constexpr size_t WS_WIN = 0;
constexpr size_t WS_WBR = WS_WIN + 2ull * NIN * DM * 2;
constexpr size_t WS_WOUT = WS_WBR + 2ull * 3072 * 512 * 2;
constexpr size_t WS_MOD = WS_WOUT + 2ull * DM * DM * 2;
constexpr size_t WS_COSA = WS_MOD + 2ull * NSEQ * 3072 * 4;
constexpr size_t WS_SINA = WS_COSA + 4096ull * 32 * 4;
constexpr size_t WS_COSC = WS_SINA + 4096ull * 32 * 4;
constexpr size_t WS_SINC = WS_COSC + 4096ull * 64 * 4;
constexpr size_t WS_LAM = WS_SINC + 4096ull * 64 * 4;
constexpr size_t WS_GAIN = WS_LAM + 256;
constexpr size_t WS_BAR = WS_GAIN + 2 * 6 * 128 * 4;
constexpr size_t WS_H = WS_BAR + 16384;
constexpr size_t WS_P = WS_H + (size_t)TC * DM * 2;
constexpr size_t WS_T = WS_P + (size_t)TC * NIN * 2;
constexpr size_t WS_OC = WS_T + 3ull * TC * 512 * 2;
constexpr size_t WS_LSE = WS_OC + (size_t)TC * 1536 * 2;
constexpr size_t WS_MT = WS_LSE + (size_t)TC * 12 * 4;
constexpr size_t WS_MB = WS_MT + (size_t)TC * DM * 4;
constexpr size_t WS_END = WS_MB + (size_t)TC * DM * 2;

constexpr int LDS_BYTES = 159744;
constexpr int XCH_OFF = 131072;
constexpr int NPHASE = 1 + NCHUNK * 2 * 6;

struct Params { const float* in[22]; float* out; unsigned char* ws; int ph_lo, ph_hi; };

__device__ __forceinline__ unsigned pk2(float lo, float hi) { f32x2 v = {lo, hi}; bf16x2_t b = __builtin_convertvector(v, bf16x2_t); return __builtin_bit_cast(unsigned, b); }
__device__ __forceinline__ float bflo(unsigned u) { return __uint_as_float(u << 16); }
__device__ __forceinline__ float bfhi(unsigned u) { return __uint_as_float(u & 0xffff0000u); }
__device__ __forceinline__ float wave_sum(float v) {
#pragma unroll
    for (int o = 32; o >= 1; o >>= 1) v += __shfl_xor(v, o);
    return v;
}
__device__ __forceinline__ float fast_exp2(float x) { return __builtin_amdgcn_exp2f(x); }
__device__ __forceinline__ float sigmoidf_(float x) { return __builtin_amdgcn_rcpf(1.f + __builtin_amdgcn_exp2f(x * -1.4426950408889634f)); }
__device__ __forceinline__ float siluf_(float x) { return x * sigmoidf_(x); }

__host__ __device__ __forceinline__ int tile_type(int pn) {
    if (pn < 4) return 1; if (pn < 6) return 0; if (pn < 10) return 2; if (pn < 12) return 0; if (pn < 24) return 3; if (pn < 30) return 0; if (pn < 36) return 4; return 5;
}
__device__ __forceinline__ int phys_row(int col) {
    const int pn = col >> 8, lc = col & 255, ty = tile_type(pn);
    if (ty == 1 || ty == 2) { const int wc = (lc >> 6) & 3, bj = (lc >> 5) & 1, rest = lc & 31; return (pn << 8) + 128 * bj + 32 * wc + rest; }
    if (ty == 3) { const int hh = lc >> 7, bj = (lc >> 6) & 1, w0 = (lc >> 5) & 1, rest = lc & 31; return (pn << 8) + 128 * bj + 32 * (2 * hh + w0) + rest; }
    return col;
}

__device__ __forceinline__ void transpose_item(const float* __restrict__ W, int K, int N, bf16_t* Bt, int kt, int nt, bool perm, LAS float* tile) {
    const int t = otid(), k0 = kt * 64, n0 = nt * 64;
#pragma unroll
    for (int i = 0; i < 8; ++i) { const int k = i * 8 + (t >> 6), n = t & 63; tile[k * 65 + n] = W[(size_t)(k0 + k) * N + n0 + n]; }
    __syncthreads();
    const int n = t >> 3, kk = (t & 7) * 8;
    u32x4 w;
    w.x = pk2(tile[(kk + 0) * 65 + n], tile[(kk + 1) * 65 + n]); w.y = pk2(tile[(kk + 2) * 65 + n], tile[(kk + 3) * 65 + n]);
    w.z = pk2(tile[(kk + 4) * 65 + n], tile[(kk + 5) * 65 + n]); w.w = pk2(tile[(kk + 6) * 65 + n], tile[(kk + 7) * 65 + n]);
    const int col = n0 + n, row = perm ? phys_row(col) : col;
    *(u32x4*)(Bt + (size_t)row * K + k0 + kk) = w;
    __syncthreads();
}

__device__ __forceinline__ void mod_item(const Params& p, int item, LAS float* sc) {
    const int l = item / 48, cb = item % 48, t = otid();
    const float* cp = p.in[2]; const float* cs = p.in[3];
    for (int i = t; i < NSEQ * 1024; i += NTHR) { const int s = i >> 10, k = i & 1023; const float c = (s < 4) ? cp[s * 1024 + k] : cs[(s - 4) * 1024 + k]; sc[i] = siluf_(c); }
    __syncthreads();
    const int col = t & 63, ks = t >> 6;
    const float* w = p.in[5] + (size_t)l * 1024 * 3072 + cb * 64 + col;
    float acc[NSEQ];
#pragma unroll
    for (int s = 0; s < NSEQ; ++s) acc[s] = 0.f;
    for (int k = ks * 128; k < ks * 128 + 128; ++k) {
        const float wv = w[(size_t)k * 3072];
#pragma unroll
        for (int s = 0; s < NSEQ; ++s) acc[s] += sc[s * 1024 + k] * wv;
    }
    __syncthreads();
#pragma unroll
    for (int s = 0; s < NSEQ; ++s) sc[(ks * NSEQ + s) * 64 + col] = acc[s];
    __syncthreads();
    float* mod = (float*)(p.ws + WS_MOD) + (size_t)l * NSEQ * 3072;
    const float* b = p.in[6] + (size_t)l * 3072;
    for (int i = t; i < NSEQ * 64; i += NTHR) {
        const int s = i >> 6, c = i & 63; float v = 0.f;
#pragma unroll
        for (int q = 0; q < 8; ++q) v += sc[(q * NSEQ + s) * 64 + c];
        mod[s * 3072 + cb * 64 + c] = v + b[cb * 64 + c];
    }
    __syncthreads();
}

__device__ __forceinline__ void phase_pre(const Params& p, LAS unsigned char* lds) {
    LAS float* scr = (LAS float*)lds;
    const int G = gridDim.x, bid = blockIdx.x, t = otid();
    constexpr int N_MOD = 96, N_WIN = 16 * 192, N_WBR = 3 * 8 * 16, N_WOUT = 16 * 16, PER_L = N_WIN + N_WBR + N_WOUT;
    for (int item = bid; item < N_MOD + 2 * PER_L; item += G) {
        if (item < N_MOD) { mod_item(p, item, scr); continue; }
        int it = item - N_MOD; const int l = it / PER_L; it -= l * PER_L;
        if (it < N_WIN) { transpose_item(p.in[7] + (size_t)l * DM * NIN, DM, NIN, (bf16_t*)(p.ws + WS_WIN) + (size_t)l * NIN * DM, it & 15, it >> 4, true, scr); }
        else if (it < N_WIN + N_WBR) { it -= N_WIN; const int br = it >> 7, r = it & 127;
            transpose_item(p.in[20] + ((size_t)l * 3 + br) * 512 * 1024, 512, 1024, (bf16_t*)(p.ws + WS_WBR) + ((size_t)l * 3 + br) * 1024 * 512, r & 7, r >> 3, false, scr); }
        else { it -= N_WIN + N_WBR; transpose_item(p.in[21] + (size_t)l * DM * DM, DM, DM, (bf16_t*)(p.ws + WS_WOUT) + (size_t)l * DM * DM, it & 15, it >> 4, false, scr); }
    }
    const int gt = bid * NTHR + t, gn = G * NTHR;
    float* cosA = (float*)(p.ws + WS_COSA); float* sinA = (float*)(p.ws + WS_SINA); float* cosC = (float*)(p.ws + WS_COSC); float* sinC = (float*)(p.ws + WS_SINC);
    for (int i = gt; i < 4096 * 96; i += gn) {
        int pos, j; float inv; float* cd; float* sd;
        if (i < 4096 * 32) { pos = i >> 5; j = i & 31; inv = exp2f(-(float)j * (13.287712379549449f / 32.f)); cd = cosA + i; sd = sinA + i; }
        else { const int i2 = i - 4096 * 32; pos = i2 >> 6; j = i2 & 63; inv = exp2f(-(float)j * (13.287712379549449f / 64.f)); cd = cosC + i2; sd = sinC + i2; }
        double x = (double)pos * (double)inv * 0.15915494309189535;
        x -= floor(x);
        const float r = (float)(x * 6.283185307179586);
        *cd = __cosf(r); *sd = __sinf(r);
    }
    if (bid == 1) {
        float* gt = (float*)(p.ws + WS_GAIN);
        for (int i = t; i < 2 * 6 * 128; i += NTHR) {
            const int l = i / 768, w = (i % 768) >> 7, d = i & 127; float v = 0.f;
            if (w == 0) { if (d < 64) v = p.in[8][l * 64 + d]; } else if (w == 1) { if (d < 64) v = p.in[9][l * 64 + d]; }
            else if (w == 2) { if (d < 64) v = p.in[15][l * 64 + d]; } else if (w == 3) { if (d < 64) v = p.in[16][l * 64 + d]; }
            else if (w == 4) v = p.in[18][l * 128 + d]; else v = p.in[19][l * 128 + d];
            gt[i] = v;
        }
    }
    if (bid == 0 && t < 2) {
        const int l = t; float a = 0.f, b = 0.f;
        for (int i = 0; i < 64; ++i) { a += p.in[10][l * 64 + i] * p.in[11][l * 64 + i]; b += p.in[12][l * 64 + i] * p.in[13][l * 64 + i]; }
        const float lam_init = 0.8f - 0.6f * expf(-0.3f * (float)l);
        float* L = (float*)(p.ws + WS_LAM);
        L[l] = expf(a) - expf(b) + lam_init; L[2 + l] = 1.f - lam_init;
    }
}

__device__ __forceinline__ void phase_h(const float* __restrict__ xin, const float* __restrict__ lng, const float* __restrict__ mod_l, int seq0, int slog, bf16_t* H) {
    const int wave = otid() >> 6, lane = otid() & 63;
    for (int row = blockIdx.x * 8 + wave; row < TC; row += gridDim.x * 8) {
        const float* xr = xin + (size_t)row * DM;
        f32x4 v[4]; float ss = 0.f;
#pragma unroll
        for (int j = 0; j < 4; ++j) { v[j] = *(const f32x4*)(xr + j * 256 + lane * 4); ss += v[j][0] * v[j][0] + v[j][1] * v[j][1] + v[j][2] * v[j][2] + v[j][3] * v[j][3]; }
        ss = wave_sum(ss);
        const float rstd = rsqrtf(ss * (1.f / 1024.f) + EPS);
        const float* md = mod_l + (size_t)(seq0 + (row >> slog)) * 3072;
#pragma unroll
        for (int j = 0; j < 4; ++j) {
            const int col = j * 256 + lane * 4;
            const f32x4 g = *(const f32x4*)(lng + col), sh = *(const f32x4*)(md + col), sc = *(const f32x4*)(md + 1024 + col);
            const f32x4 h = v[j] * rstd * g * (sc + 1.0f) + sh;
            u32x2 o; o.x = pk2(h[0], h[1]); o.y = pk2(h[2], h[3]);
            *(u32x2*)(H + (size_t)row * DM + col) = o;
        }
    }
}

__device__ __forceinline__ u32x4 pack8(const f32x4& a, const f32x4& b) { u32x4 w; w.x = pk2(a[0], a[1]); w.y = pk2(a[2], a[3]); w.z = pk2(b[0], b[1]); w.w = pk2(b[2], b[3]); return w; }
__device__ __forceinline__ float dot4(const f32x4& a) { return a[0] * a[0] + a[1] * a[1] + a[2] * a[2] + a[3] * a[3]; }

struct EpiIn {
    static constexpr bool PERM = true, AFTER_DRAIN = false;
    bf16_t* P; const float* cosA; const float* sinA; const float* cosC; const float* sinC;
    const float* gtab; int smask; LAS float* xch;
    __device__ __forceinline__ static void piece(f32x4 a, f32x4 b, float rs, const float* glo, const float* ghi, const float* cp, const float* sp, bool rope, u32x2& pa, u32x2& pb) {
        a = a * rs * *(const f32x4*)glo; b = b * rs * *(const f32x4*)ghi;
        if (rope) { const f32x4 c = *(const f32x4*)cp, sn = *(const f32x4*)sp; const f32x4 na = a * c - b * sn, nb = b * c + a * sn; a = na; b = nb; }
        pa.x = pk2(a[0], a[1]); pa.y = pk2(a[2], a[3]); pb.x = pk2(b[0], b[1]); pb.y = pk2(b[2], b[3]);
    }
    __device__ __forceinline__ void operator()(const f32x4 (&acc)[2][2][4][2], const pg8::Unit& u, int wr, int wc, int fr, int fq) const {
        const int pn = u.pn, ty = tile_type(pn);
        const int rl0 = wr * 64 + fr;
        const size_t rowg0 = (size_t)u.pm * 256 + rl0;
        if (ty == 1 || ty == 2) {
            const bool isq = (ty == 1) ? (pn < 2) : (pn < 8);
            const float* g = gtab + ((ty == 1 ? 0 : 2) + (isq ? 0 : 1)) * 128 + 8 * fq;
            const float qs = isq ? 0.125f * LOG2E : 1.f;
            bf16_t* pb = P + rowg0 * NIN + pn * 256 + 64 * wc + 8 * fq;
#pragma unroll
            for (int ai = 0; ai < 2; ++ai)
#pragma unroll
                for (int m = 0; m < 4; ++m) {
                    float ss = dot4(acc[ai][0][m][0]) + dot4(acc[ai][0][m][1]) + dot4(acc[ai][1][m][0]) + dot4(acc[ai][1][m][1]);
                    ss += __shfl_xor(ss, 16); ss += __shfl_xor(ss, 32);
                    const float rs = rsqrtf(ss * (1.f / 64.f) + EPS) * qs;
                    const int roff = ai * 128 + m * 16;
                    const int pos = (int)((rowg0 + roff) & (size_t)smask);
                    const float* cp = cosA + pos * 32 + 8 * fq; const float* sp = sinA + pos * 32 + 8 * fq;
                    u32x2 pa0, pb0, pa1, pb1;
                    piece(acc[ai][0][m][0], acc[ai][1][m][0], rs, g, g + 32, cp, sp, ty == 1, pa0, pb0);
                    piece(acc[ai][0][m][1], acc[ai][1][m][1], rs, g + 4, g + 36, cp + 4, sp + 4, ty == 1, pa1, pb1);
                    *(u32x4*)(pb + (size_t)roff * NIN) = (u32x4){pa0.x, pa0.y, pa1.x, pa1.y};
                    *(u32x4*)(pb + (size_t)roff * NIN + 32) = (u32x4){pb0.x, pb0.y, pb1.x, pb1.y};
                    __builtin_amdgcn_sched_barrier(0);
                }
        } else if (ty == 3) {
            const bool isq = pn < 18;
            const float qs = isq ? 0.08838834764831845f * LOG2E : 1.f;
            const int hh = wc >> 1, w0 = wc & 1;
#pragma unroll
            for (int ai = 0; ai < 2; ++ai)
#pragma unroll
                for (int m = 0; m < 4; ++m) {
                    float ss = dot4(acc[ai][0][m][0]) + dot4(acc[ai][0][m][1]) + dot4(acc[ai][1][m][0]) + dot4(acc[ai][1][m][1]);
                    ss += __shfl_xor(ss, 16); ss += __shfl_xor(ss, 32);
                    if (fq == 0) xch[(ai * 128 + m * 16 + rl0) * 4 + wc] = ss;
                    __builtin_amdgcn_sched_barrier(0);
                }
            __syncthreads();
            const int dlo = 32 * w0 + 8 * fq;
            const float* g = gtab + (isq ? 4 : 5) * 128 + dlo;
            bf16_t* pb = P + rowg0 * NIN + pn * 256 + 128 * hh + dlo;
#pragma unroll
            for (int ai = 0; ai < 2; ++ai)
#pragma unroll
                for (int m = 0; m < 4; ++m) {
                    const int roff = ai * 128 + m * 16;
                    const f32x2 t2 = *(LAS const f32x2*)(xch + (roff + rl0) * 4 + 2 * hh);
                    const float rs = rsqrtf((t2[0] + t2[1]) * (1.f / 128.f) + EPS) * qs;
                    const int pos = (int)((rowg0 + roff) & (size_t)smask);
                    const float* cp = cosC + pos * 64 + dlo; const float* sp = sinC + pos * 64 + dlo;
                    u32x2 pa0, pb0, pa1, pb1;
                    piece(acc[ai][0][m][0], acc[ai][1][m][0], rs, g, g + 64, cp, sp, true, pa0, pb0);
                    piece(acc[ai][0][m][1], acc[ai][1][m][1], rs, g + 4, g + 68, cp + 4, sp + 4, true, pa1, pb1);
                    *(u32x4*)(pb + (size_t)roff * NIN) = (u32x4){pa0.x, pa0.y, pa1.x, pa1.y};
                    *(u32x4*)(pb + (size_t)roff * NIN + 64) = (u32x4){pb0.x, pb0.y, pb1.x, pb1.y};
                    __builtin_amdgcn_sched_barrier(0);
                }
        } else {
            bf16_t* pb = P + rowg0 * NIN + pn * 256 + 32 * wc + 8 * fq;
#pragma unroll
            for (int ai = 0; ai < 2; ++ai)
#pragma unroll
                for (int m = 0; m < 4; ++m)
#pragma unroll
                    for (int bj = 0; bj < 2; ++bj) {
                        f32x4 v0 = acc[ai][bj][m][0], v1 = acc[ai][bj][m][1];
                        if (ty == 4) {
#pragma unroll
                            for (int e = 0; e < 4; ++e) { v0[e] = siluf_(v0[e]); v1[e] = siluf_(v1[e]); }
                        } else if (ty == 5) {
#pragma unroll
                            for (int e = 0; e < 4; ++e) { v0[e] = sigmoidf_(v0[e]); v1[e] = sigmoidf_(v1[e]); }
                        }
                        *(u32x4*)(pb + (size_t)(ai * 128 + m * 16) * NIN + bj * 128) = pack8(v0, v1);
                        __builtin_amdgcn_sched_barrier(0);
                    }
        }
    }
};

struct BrOrder {
    int G, c;
    __device__ __forceinline__ bool next(int i, pg8::Unit& u) const {
        const int tk = i / 3, br = i - 3 * tk, tile = c + tk * G; if (tile >= 256) return false;
        u.pm = (tile >> 2) + br * 64; u.pn = (tile & 3) + br * 4; return true;
    }
    __device__ __forceinline__ void a_ready(const pg8::Unit&) const {}
    __device__ __forceinline__ void done(const pg8::Unit&) const {}
};

struct EpiBr {
    static constexpr bool PERM = true, AFTER_DRAIN = false;
    const bf16_t* P; float* MT; bf16_t* MB;
    __device__ __forceinline__ void operator()(const f32x4 (&acc)[2][2][4][2], const pg8::Unit& u, int wr, int wc, int fr, int fq) const {
        const int br = u.pm >> 6, pm = u.pm & 63, pn = u.pn & 3;
        const size_t row0 = (size_t)pm * 256 + wr * 64 + fr; const int col0 = pn * 256 + 32 * wc + 8 * fq;
#pragma unroll
        for (int ai = 0; ai < 2; ++ai)
#pragma unroll
            for (int m = 0; m < 4; ++m)
#pragma unroll
                for (int bj = 0; bj < 2; ++bj) {
                    const size_t row = row0 + ai * 128 + m * 16; const int col = col0 + bj * 128;
                    const u32x4 sg = *(const u32x4*)(P + row * NIN + COL_G + br * 1024 + col);
                    f32x4 v0 = acc[ai][bj][m][0], v1 = acc[ai][bj][m][1];
                    v0[0] *= bflo(sg.x); v0[1] *= bfhi(sg.x); v0[2] *= bflo(sg.y); v0[3] *= bfhi(sg.y);
                    v1[0] *= bflo(sg.z); v1[1] *= bfhi(sg.z); v1[2] *= bflo(sg.w); v1[3] *= bfhi(sg.w);
                    float* mt = MT + row * DM + col;
                    if (br > 0) { v0 += *(const f32x4*)mt; v1 += *(const f32x4*)(mt + 4); }
                    if (br < 2) { *(f32x4*)mt = v0; *(f32x4*)(mt + 4) = v1; }
                    else *(u32x4*)(MB + row * DM + col) = pack8(v0, v1);
                }
    }
};

struct EpiOut {
    static constexpr bool PERM = true, AFTER_DRAIN = false;
    const float* xin; float* xout; const float* mod_l; int seq0, slog;
    __device__ __forceinline__ void operator()(const f32x4 (&acc)[2][2][4][2], const pg8::Unit& u, int wr, int wc, int fr, int fq) const {
        const size_t row0 = (size_t)u.pm * 256 + wr * 64 + fr; const int col0 = u.pn * 256 + 32 * wc + 8 * fq;
#pragma unroll
        for (int ai = 0; ai < 2; ++ai)
#pragma unroll
            for (int m = 0; m < 4; ++m) {
                const size_t row = row0 + ai * 128 + m * 16;
                const float* gt = mod_l + (size_t)(seq0 + (int)(row >> slog)) * 3072 + 2048;
#pragma unroll
                for (int bj = 0; bj < 2; ++bj) {
                    const int col = col0 + bj * 128;
                    const f32x4 g0 = *(const f32x4*)(gt + col), g1 = *(const f32x4*)(gt + col + 4);
                    const f32x4 x0 = *(const f32x4*)(xin + row * DM + col), x1 = *(const f32x4*)(xin + row * DM + col + 4);
                    *(f32x4*)(xout + row * DM + col) = x0 + g0 * acc[ai][bj][m][0];
                    *(f32x4*)(xout + row * DM + col + 4) = x1 + g1 * acc[ai][bj][m][1];
                }
            }
    }
};

struct AttnCtx { const bf16_t* P; bf16_t* T; bf16_t* OC; float* LSE; const float* subln; const float* rpb; float lam, oml; int S, slog; };

__device__ __forceinline__ int crow(int i, int h) { return (i & 3) + 8 * (i >> 2) + 4 * h; }
__device__ __forceinline__ s16x4 vtr(LAS const unsigned char* p) { return __builtin_bit_cast(s16x4, __builtin_amdgcn_ds_read_tr16_b64_v4i16((LAS v4i16_t*)p)); }
#define MFMA32(a, b, c) __builtin_amdgcn_mfma_f32_32x32x16_bf16((a), (b), (c), 0, 0, 0)

template <int DQK, int DV, int MODE>
__device__ __forceinline__ void attn_item(LAS unsigned char* lds, int item, const AttnCtx& cx) {
    constexpr int KP = DQK * 2 + 16, VP = DV * 2 + 64, KBY = 64 * KP, VBY = 64 * VP, HB = KBY + VBY;
    constexpr int NQF = DQK / 16, NDV = DV / 32, NKP = DQK / 32, NVP = DV / 32, KPR = DQK / 8, VPR = DV / 8;
    static_assert(4 * HB + 4096 <= LDS_BYTES, "attention LDS");
    const int tid = otid(), lane = tid & 63, wave = __builtin_amdgcn_readfirstlane(tid >> 6), hf = wave >> 2, wq = wave & 3, r = lane & 31, h = lane >> 5, th = tid & 255;
    const int S = cx.S, slog = cx.slog;
    const bf16_t* __restrict__ P = cx.P;
    int head, tok0, seqbase, qcol, kcol, vcol, ntiles, qtok;
    int na_rows = 0, na_rs0 = 0, na_rq = 0, na_cq = 0, na_rsq = 0, na_csq = 0;
    int c_dlog = 0, c_rho = 0, c_l0 = 0, c_L = 0, c_lq = 0;
    if (MODE == 0) {
        head = item & 3; tok0 = (item >> 2) * 128; seqbase = tok0 & ~(S - 1);
        qcol = COL_A_Q + head * 128 + hf * 64; kcol = COL_A_K + head * 128 + hf * 64; vcol = COL_A_V + head * 128; ntiles = S >> 6;
        qtok = tok0 + 32 * wq + r;
    } else if (MODE == 1) {
        const int unit = item * 2 + hf; head = unit & 7; tok0 = (unit >> 3) * 128; seqbase = tok0 & ~(S - 1);
        qcol = COL_B_Q + head * 64; kcol = COL_B_K + head * 64; vcol = COL_B_V + head * 64; ntiles = 9;
        qtok = tok0 + 32 * wq + r;
        na_rows = S >> 6; const int r0 = (tok0 - seqbase) >> 6; na_rs0 = min(max(r0 - 4, 0), na_rows - 8);
        na_rq = r0 + (wq >> 1); na_cq = 32 * (wq & 1) + r; na_rsq = min(max(na_rq - 4, 0), na_rows - 8); na_csq = min(max(na_cq - 8, 0), 48);
    } else {
        const int unit = item * 2 + hf; head = unit % 12; const int blk = unit / 12; tok0 = blk * 128; seqbase = tok0 & ~(S - 1);
        qcol = COL_C_Q + head * 128; kcol = COL_C_K + head * 128; vcol = COL_C_V + head * 128; ntiles = 4;
        c_dlog = 2 * (head >> 2); const int b = (tok0 - seqbase) >> 7; c_rho = b & ((1 << c_dlog) - 1); c_l0 = (b >> c_dlog) * 128; c_L = S >> c_dlog;
        c_lq = c_l0 + 32 * wq + r; qtok = seqbase + (c_lq << c_dlog) + c_rho;
    }
    auto ktok = [&](int j, int kr) -> int {
        if (MODE == 0) return seqbase + 64 * j + kr;
        if (MODE == 1) return seqbase + min(na_rs0 + j, na_rows - 1) * 64 + kr;
        const int lk = min(max(c_l0 - 64 + 64 * j + kr, 0), c_L - 1); return seqbase + (lk << c_dlog) + c_rho;
    };
    const bool loadV = !(MODE == 0 && hf == 1);
    u32x4 kreg[NKP], vreg[NVP];
    auto gload = [&](int j) {
#pragma unroll
        for (int i = 0; i < NKP; ++i) { const int pid = th + 256 * i, row = pid / KPR, cp = pid % KPR; kreg[i] = *(const u32x4*)(P + (size_t)ktok(j, row) * NIN + kcol + cp * 8); }
        if (loadV) {
#pragma unroll
            for (int i = 0; i < NVP; ++i) { const int pid = th + 256 * i, row = pid / VPR, cp = pid % VPR; vreg[i] = *(const u32x4*)(P + (size_t)ktok(j, row) * NIN + vcol + cp * 8); }
        }
    };
    auto lstore = [&](int b) {
        LAS unsigned char* base = lds + (b * 2 + hf) * HB;
#pragma unroll
        for (int i = 0; i < NKP; ++i) { const int pid = th + 256 * i, row = pid / KPR, cp = pid % KPR; *(LAS u32x4*)(base + row * KP + cp * 16) = kreg[i]; }
        if (loadV) {
#pragma unroll
            for (int i = 0; i < NVP; ++i) { const int pid = th + 256 * i, row = pid / VPR, cp = pid % VPR; *(LAS u32x4*)(base + KBY + row * VP + cp * 16) = vreg[i]; }
        }
    };
    LAS float* biasL = (LAS float*)(lds + 4 * HB) + hf * 512;
    gload(0);
    bf16x8 qf[NQF];
#pragma unroll
    for (int ks = 0; ks < NQF; ++ks) qf[ks] = *(const bf16x8*)(P + (size_t)qtok * NIN + qcol + 16 * ks + 8 * h);
    if (MODE == 1) { for (int i = th; i < 465; i += 256) biasL[i] = cx.rpb[head * 465 + i] * LOG2E; }
    lstore(0);
    f32x16 O[NDV];
#pragma unroll
    for (int d = 0; d < NDV; ++d)
#pragma unroll
        for (int i = 0; i < 16; ++i) O[d][i] = 0.f;
    float mrun = NEGBIG, lrun = 0.f;
    __syncthreads();
    const int q4 = (lane & 15) >> 2, p4 = lane & 3, rblk = (lane >> 4) & 1;
    for (int j = 0; j < ntiles; ++j) {
        if (j + 1 < ntiles) gload(j + 1);
        bool active = true;
        if (MODE == 1) { const int rk = na_rs0 + j; active = (rk >= na_rsq) && (rk < na_rsq + 8); }
        if (MODE == 2) { const int lk0 = c_l0 - 64 + 64 * j; active = ((wq < 2) ? (j <= 2) : (j >= 1)) && (lk0 + 63 >= 0) && (lk0 < c_L); }
        if (active) {
            LAS const unsigned char* Kb = lds + ((j & 1) * 2 + hf) * HB;
            LAS const unsigned char* Vb = lds + ((j & 1) * 2 + (MODE == 0 ? 0 : hf)) * HB + KBY;
            f32x16 s0, s1;
#pragma unroll
            for (int i = 0; i < 16; ++i) { s0[i] = 0.f; s1[i] = 0.f; }
#pragma unroll
            for (int ks = 0; ks < NQF; ++ks) {
                const bf16x8 k0 = *(LAS const bf16x8*)(Kb + r * KP + (16 * ks + 8 * h) * 2);
                const bf16x8 k1 = *(LAS const bf16x8*)(Kb + (32 + r) * KP + (16 * ks + 8 * h) * 2);
                s0 = MFMA32(k0, qf[ks], s0); s1 = MFMA32(k1, qf[ks], s1);
            }
            if (MODE == 1) {
                const int rk = na_rs0 + j; const int bbase = (rk - na_rq + 7) * 31 + 15 - na_cq;
#pragma unroll
                for (int i = 0; i < 16; ++i) {
                    const int ck0 = crow(i, h), ck1 = ck0 + 32;
                    const bool v0 = (ck0 >= na_csq) && (ck0 < na_csq + 16), v1 = (ck1 >= na_csq) && (ck1 < na_csq + 16);
                    const float b0 = biasL[v0 ? bbase + ck0 : 0], b1 = biasL[v1 ? bbase + ck1 : 0];
                    s0[i] = v0 ? s0[i] + b0 : NEGBIG; s1[i] = v1 ? s1[i] + b1 : NEGBIG;
                }
            }
            if (MODE == 2) {
                const int lk0 = c_l0 - 64 + 64 * j;
#pragma unroll
                for (int i = 0; i < 16; ++i) {
                    const int lka = lk0 + crow(i, h), lkb = lka + 32;
                    const bool v0 = (lka >= 0) && (lka < c_L) && (abs(lka - c_lq) <= 64), v1 = (lkb >= 0) && (lkb < c_L) && (abs(lkb - c_lq) <= 64);
                    s0[i] = v0 ? s0[i] : NEGBIG; s1[i] = v1 ? s1[i] : NEGBIG;
                }
            }
            float mx = fmaxf(s0[0], s1[0]);
#pragma unroll
            for (int i = 1; i < 16; ++i) mx = fmaxf(mx, fmaxf(s0[i], s1[i]));
            mx = fmaxf(mx, __shfl_xor(mx, 32));
            const float mn = fmaxf(mrun, mx), alpha = fast_exp2(mrun - mn);
            mrun = mn;
            float ps = 0.f;
#pragma unroll
            for (int i = 0; i < 16; ++i) { s0[i] = fast_exp2(s0[i] - mn); s1[i] = fast_exp2(s1[i] - mn); ps += s0[i] + s1[i]; }
            lrun = lrun * alpha + ps;
#pragma unroll
            for (int d = 0; d < NDV; ++d)
#pragma unroll
                for (int i = 0; i < 16; ++i) O[d][i] *= alpha;
            bf16x8 pa[2][2];
            { u32x4 w;
              w.x = pk2(s0[0], s0[1]); w.y = pk2(s0[2], s0[3]); w.z = pk2(s0[4], s0[5]); w.w = pk2(s0[6], s0[7]); pa[0][0] = __builtin_bit_cast(bf16x8, w);
              w.x = pk2(s0[8], s0[9]); w.y = pk2(s0[10], s0[11]); w.z = pk2(s0[12], s0[13]); w.w = pk2(s0[14], s0[15]); pa[0][1] = __builtin_bit_cast(bf16x8, w);
              w.x = pk2(s1[0], s1[1]); w.y = pk2(s1[2], s1[3]); w.z = pk2(s1[4], s1[5]); w.w = pk2(s1[6], s1[7]); pa[1][0] = __builtin_bit_cast(bf16x8, w);
              w.x = pk2(s1[8], s1[9]); w.y = pk2(s1[10], s1[11]); w.z = pk2(s1[12], s1[13]); w.w = pk2(s1[14], s1[15]); pa[1][1] = __builtin_bit_cast(bf16x8, w); }
            LAS const unsigned char* vl = Vb + (4 * h + q4) * VP + (16 * rblk + 4 * p4) * 2;
#pragma unroll
            for (int d = 0; d < NDV; ++d)
#pragma unroll
                for (int t = 0; t < 2; ++t)
#pragma unroll
                    for (int sp = 0; sp < 2; ++sp) {
                        const s16x4 lo = vtr(vl + (32 * t + 16 * sp) * VP + d * 64);
                        const s16x4 hi = vtr(vl + (32 * t + 16 * sp + 8) * VP + d * 64);
                        const bf16x8 vf = __builtin_shufflevector(lo, hi, 0, 1, 2, 3, 4, 5, 6, 7);
                        O[d] = MFMA32(vf, pa[t][sp], O[d]);
                    }
        }
        if (j + 1 < ntiles) lstore((j + 1) & 1);
        __syncthreads();
    }
    const float lt = lrun + __shfl_xor(lrun, 32);
    const float inv = 1.f / lt;
    if (MODE == 0) {
        LAS float* X = (LAS float*)lds;
        if (hf == 1) {
#pragma unroll
            for (int d = 0; d < NDV; ++d)
#pragma unroll
                for (int g4 = 0; g4 < 4; ++g4) {
                    f32x4 v = {O[d][4 * g4] * inv, O[d][4 * g4 + 1] * inv, O[d][4 * g4 + 2] * inv, O[d][4 * g4 + 3] * inv};
                    *(LAS f32x4*)(X + (32 * wq + r) * 132 + 32 * d + 8 * g4 + 4 * h) = v;
                }
        }
        __syncthreads();
        if (hf == 0) {
            float ss = 0.f;
#pragma unroll
            for (int d = 0; d < NDV; ++d)
#pragma unroll
                for (int g4 = 0; g4 < 4; ++g4) {
                    const f32x4 o2 = *(LAS const f32x4*)(X + (32 * wq + r) * 132 + 32 * d + 8 * g4 + 4 * h);
#pragma unroll
                    for (int e = 0; e < 4; ++e) { const float o = O[d][4 * g4 + e] * inv - cx.lam * o2[e]; O[d][4 * g4 + e] = o; ss += o * o; }
                }
            ss += __shfl_xor(ss, 32);
            const float rstd = rsqrtf(ss * (1.f / 128.f) + EPS) * cx.oml;
#pragma unroll
            for (int d = 0; d < NDV; ++d)
#pragma unroll
                for (int g4 = 0; g4 < 4; ++g4) {
                    const int dv = 32 * d + 8 * g4 + 4 * h;
                    const f32x4 gn = *(const f32x4*)(cx.subln + dv);
                    const u32x2 sz = *(const u32x2*)(P + (size_t)qtok * NIN + COL_Z + head * 128 + dv);
                    u32x2 o;
                    o.x = pk2(O[d][4 * g4] * rstd * gn[0] * bflo(sz.x), O[d][4 * g4 + 1] * rstd * gn[1] * bfhi(sz.x));
                    o.y = pk2(O[d][4 * g4 + 2] * rstd * gn[2] * bflo(sz.y), O[d][4 * g4 + 3] * rstd * gn[3] * bfhi(sz.y));
                    *(u32x2*)(cx.T + (size_t)qtok * 512 + head * 128 + dv) = o;
                }
        }
        __syncthreads();
    } else if (MODE == 1) {
#pragma unroll
        for (int d = 0; d < NDV; ++d)
#pragma unroll
            for (int g4 = 0; g4 < 4; ++g4) {
                const int dv = 32 * d + 8 * g4 + 4 * h;
                const u32x2 sz = *(const u32x2*)(P + (size_t)qtok * NIN + COL_Z + 512 + head * 64 + dv);
                u32x2 o;
                o.x = pk2(O[d][4 * g4] * inv * bflo(sz.x), O[d][4 * g4 + 1] * inv * bfhi(sz.x));
                o.y = pk2(O[d][4 * g4 + 2] * inv * bflo(sz.y), O[d][4 * g4 + 3] * inv * bfhi(sz.y));
                *(u32x2*)(cx.T + (size_t)TC * 512 + (size_t)qtok * 512 + head * 64 + dv) = o;
            }
    } else {
#pragma unroll
        for (int d = 0; d < NDV; ++d)
#pragma unroll
            for (int g4 = 0; g4 < 4; ++g4) {
                const int dv = 32 * d + 8 * g4 + 4 * h;
                u32x2 o; o.x = pk2(O[d][4 * g4] * inv, O[d][4 * g4 + 1] * inv); o.y = pk2(O[d][4 * g4 + 2] * inv, O[d][4 * g4 + 3] * inv);
                *(u32x2*)(cx.OC + (size_t)qtok * 1536 + head * 128 + dv) = o;
            }
        if (h == 0) cx.LSE[(size_t)qtok * 12 + head] = mrun + __log2f(lt);
    }
}

constexpr int N_ITEM_A = (TC / 128) * 4, N_ITEM_B = (TC / 128) * 8 / 2, N_ITEM_C = (TC / 128) * 12 / 2;
__device__ __forceinline__ void phase_attn(LAS unsigned char* lds, const AttnCtx& cx) {
    const int G = gridDim.x, c = blockIdx.x;
    for (int rep = 0; rep < (DUP_PH == 20 ? 2 : 1); ++rep)
    if (PH_MASK & 8) for (int it = c; it < N_ITEM_A; it += G) attn_item<64, 128, 0>(lds, it, cx);
    for (int rep = 0; rep < (DUP_PH == 21 ? 2 : 1); ++rep)
    if (PH_MASK & 16) for (int it = c; it < N_ITEM_C; it += G) attn_item<128, 128, 2>(lds, it, cx);
    for (int rep = 0; rep < (DUP_PH == 22 ? 2 : 1); ++rep)
    if (PH_MASK & 32) for (int it = c; it < N_ITEM_B; it += G) attn_item<64, 64, 1>(lds, it, cx);
}

__device__ __forceinline__ void phase_cmix(const bf16_t* __restrict__ P, const bf16_t* __restrict__ OC, const float* __restrict__ LSE, bf16_t* T2) {
    for (int idx = blockIdx.x * NTHR + otid(); idx < TC * 64; idx += gridDim.x * NTHR) {
        const int tok = idx >> 6, c8 = idx & 63, hh = c8 >> 4, dv = (c8 & 15) * 8;
        const float l0 = LSE[(size_t)tok * 12 + hh], l1 = LSE[(size_t)tok * 12 + 4 + hh], l2 = LSE[(size_t)tok * 12 + 8 + hh];
        const float mx = fmaxf(l0, fmaxf(l1, l2));
        float w0 = fast_exp2(l0 - mx), w1 = fast_exp2(l1 - mx), w2 = fast_exp2(l2 - mx);
        const float iw = 1.f / (w0 + w1 + w2); w0 *= iw; w1 *= iw; w2 *= iw;
        const u32x4 a = *(const u32x4*)(OC + (size_t)tok * 1536 + hh * 128 + dv), b = *(const u32x4*)(OC + (size_t)tok * 1536 + (4 + hh) * 128 + dv),
                    c = *(const u32x4*)(OC + (size_t)tok * 1536 + (8 + hh) * 128 + dv), z = *(const u32x4*)(P + (size_t)tok * NIN + COL_Z + 1024 + hh * 128 + dv);
        u32x4 o;
        o.x = pk2((w0 * bflo(a.x) + w1 * bflo(b.x) + w2 * bflo(c.x)) * bflo(z.x), (w0 * bfhi(a.x) + w1 * bfhi(b.x) + w2 * bfhi(c.x)) * bfhi(z.x));
        o.y = pk2((w0 * bflo(a.y) + w1 * bflo(b.y) + w2 * bflo(c.y)) * bflo(z.y), (w0 * bfhi(a.y) + w1 * bfhi(b.y) + w2 * bfhi(c.y)) * bfhi(z.y));
        o.z = pk2((w0 * bflo(a.z) + w1 * bflo(b.z) + w2 * bflo(c.z)) * bflo(z.z), (w0 * bfhi(a.z) + w1 * bfhi(b.z) + w2 * bfhi(c.z)) * bfhi(z.z));
        o.w = pk2((w0 * bflo(a.w) + w1 * bflo(b.w) + w2 * bflo(c.w)) * bflo(z.w), (w0 * bfhi(a.w) + w1 * bfhi(b.w) + w2 * bfhi(c.w)) * bfhi(z.w));
        *(u32x4*)(T2 + (size_t)tok * 512 + hh * 128 + dv) = o;
    }
}

#define XB_TMO      128
#define XB_XCNT(j)  (256  + 64 * (j))
#define XB_XSUB(j)  (1280 + 64 * (j))
#define XB_XGEN(j)  (2304 + 64 * (j))
#define XB_TOP      3328
#define XB_TOPGEN   3392
#define XCD_BAR_WORDS 3456
#define XB_SPIN_CAP (1u << 18)

__device__ __forceinline__ unsigned xb_ld(unsigned* p)              { return __hip_atomic_load(p, __ATOMIC_RELAXED, __HIP_MEMORY_SCOPE_AGENT); }
__device__ __forceinline__ unsigned xb_add(unsigned* p, unsigned v) { return __hip_atomic_fetch_add(p, v, __ATOMIC_RELAXED, __HIP_MEMORY_SCOPE_AGENT); }
__device__ __forceinline__ unsigned xb_xcc_id() { return (unsigned)__builtin_amdgcn_s_getreg((3 << 11) | 20) & 0xFu; }
#define XB_SPIN(cond, bar) do { unsigned _sp = 0; while (cond) { __builtin_amdgcn_s_sleep(1); \
    if ((++_sp & 255u) == 0u) { if (xb_ld(&(bar)[XB_TMO])) break; if (_sp > XB_SPIN_CAP) { atomicAdd(&(bar)[XB_TMO], 1u); break; } } } } while (0)

struct XcdBarrier {
    unsigned* bar; unsigned x;
    volatile LAS unsigned* st;
};

__device__ __forceinline__ XcdBarrier xcd_barrier_post(unsigned* bar, volatile LAS unsigned* st) {
    XcdBarrier b; b.bar = bar; b.x = xb_xcc_id(); b.st = st;
    if (threadIdx.x == 0) (void)xb_add(&bar[XB_XCNT(b.x)], 1u);
    return b;
}
__device__ __forceinline__ void xcd_barrier_complete(unsigned* bar, unsigned x, unsigned& nloc, unsigned& nx) {
    const unsigned G = gridDim.x * gridDim.y * gridDim.z;
    unsigned sum, cnt, mine, sp = 0u;
    for (;;) {
        sum = 0u; cnt = 0u; mine = 0u;
#pragma unroll
        for (unsigned j = 0; j < 16; ++j) { const unsigned c = xb_ld(&bar[XB_XCNT(j)]); sum += c; cnt += (c > 0u) ? 1u : 0u; mine = (j == x) ? c : mine; }
        if (sum == G) break;
        __builtin_amdgcn_s_sleep(1);
        if ((++sp & 255u) == 0u) { if (xb_ld(&bar[XB_TMO])) break; if (sp > XB_SPIN_CAP) { atomicAdd(&bar[XB_TMO], 1u); break; } }
    }
    nloc = mine > 0u ? mine : 1u; nx = cnt > 0u ? cnt : 1u;
}

__device__ __forceinline__ void xcd_barrier(const XcdBarrier& b) {
    asm volatile("s_waitcnt vmcnt(0)" ::: "memory");
    __syncthreads();
    if (threadIdx.x == 0) {
        unsigned* bar = b.bar;
        __builtin_amdgcn_s_waitcnt(0);
        unsigned nloc = b.st[0], nx = b.st[1];
        if (nloc == 0u) { xcd_barrier_complete(bar, b.x, nloc, nx); b.st[0] = nloc; b.st[1] = nx; }
        const unsigned old = xb_add(&bar[XB_XSUB(b.x)], 1u);
        const unsigned gen = old / nloc;
        if (old + 1u == (gen + 1u) * nloc) {
            __builtin_amdgcn_fence(__ATOMIC_RELEASE, "agent");
            asm volatile("s_waitcnt vmcnt(0)" ::: "memory");
            const unsigned og = xb_add(&bar[XB_TOP], 1u);
            const unsigned tg = og / nx;
            if (og + 1u == (tg + 1u) * nx) xb_add(&bar[XB_TOPGEN], 1u);
            else XB_SPIN(xb_ld(&bar[XB_TOPGEN]) == tg, bar);
            __builtin_amdgcn_fence(__ATOMIC_ACQUIRE, "agent");
            xb_add(&bar[XB_XGEN(b.x)], 1u);
            asm volatile("s_waitcnt vmcnt(0)" ::: "memory");
        } else {
            XB_SPIN(xb_ld(&bar[XB_XGEN(b.x)]) == gen, bar);
            __builtin_amdgcn_fence(__ATOMIC_ACQUIRE, "agent");
            asm volatile("s_waitcnt vmcnt(0)" ::: "memory");
        }
    }
    __syncthreads();
}

#ifndef ONE_LAUNCH
#define ONE_LAUNCH 1
#endif

__global__ void __launch_bounds__(NTHR, 2) mega(Params p) {
    extern __shared__ __attribute__((aligned(16))) unsigned char lds_raw[];
    LAS unsigned char* lds = (LAS unsigned char*)lds_raw;
    unsigned char* ws = p.ws;
    volatile LAS unsigned* bst = (volatile LAS unsigned*)(lds + LDS_BYTES - 16);
    if (threadIdx.x < 2) bst[threadIdx.x] = 0u;
    __syncthreads();
    XcdBarrier bar; bar.bar = (unsigned*)(ws + WS_BAR); bar.x = 0; bar.st = bst;
    if (p.ph_hi - p.ph_lo > 1) bar = xcd_barrier_post((unsigned*)(ws + WS_BAR), bst);
    for (int ph = p.ph_lo; ph < p.ph_hi; ++ph) {
        if (ph > p.ph_lo) { if (ph == 1) cg::this_grid().sync(); else xcd_barrier(bar); }
        if (ph == 0) { for (int rep = 0; rep < (DUP_PH == 30 ? 2 : 1); ++rep) { if (PH_MASK & 1) phase_pre(p, lds); } continue; }
        const int q = ph - 1, cl = q / 6, k = q - cl * 6, c = cl >> 1, l = cl & 1;
        const int S = (c == 0) ? 4096 : 2048, slog = (c == 0) ? 12 : 11, seq0 = (c == 0) ? 0 : 4 + (c - 1) * 8;
        const float* xin = (l == 0) ? ((c == 0) ? p.in[0] : p.in[1] + (size_t)(c - 1) * TC * DM) : p.out + (size_t)c * TC * DM;
        float* xout = p.out + (size_t)c * TC * DM;
        const float* mod_l = (const float*)(ws + WS_MOD) + (size_t)l * NSEQ * 3072;
        bf16_t* H = (bf16_t*)(ws + WS_H); bf16_t* P = (bf16_t*)(ws + WS_P); bf16_t* T = (bf16_t*)(ws + WS_T); bf16_t* OC = (bf16_t*)(ws + WS_OC);
        float* LSE = (float*)(ws + WS_LSE); float* MT = (float*)(ws + WS_MT); bf16_t* MB = (bf16_t*)(ws + WS_MB);
        const int nrep = (k == DUP_PH && (k != 5 || l == 0)) ? 2 : 1;
        for (int rep = 0; rep < nrep; ++rep)
        if (k == 0) {
            if (PH_MASK & 2) phase_h(xin, p.in[4] + l * DM, mod_l, seq0, slog, H);
        } else if (k == 1) {
            pg8::Gemm g{H, (const bf16_t*)(ws + WS_WIN) + (size_t)l * NIN * DM, TC, NIN, DM};
            pg8::StaticOrder So; So.init(TC, NIN, (int)gridDim.x, (int)blockIdx.x);
            EpiIn E{P, (const float*)(ws + WS_COSA), (const float*)(ws + WS_SINA), (const float*)(ws + WS_COSC), (const float*)(ws + WS_SINC),
                    (const float*)(ws + WS_GAIN) + l * 6 * 128, S - 1, (LAS float*)(lds + XCH_OFF)};
            if (PH_MASK & 4) pg8::gemm_phase<EpiIn, pg8::StaticOrder, true, true>(lds, g, So, E);
        } else if (k == 2) {
            const float* L = (const float*)(ws + WS_LAM);
            AttnCtx cx{P, T, OC, LSE, p.in[14] + l * 128, p.in[17] + (size_t)l * 8 * 465, L[l], L[2 + l], S, slog};
            phase_attn(lds, cx);
        } else if (k == 3) {
            if (PH_MASK & 64) phase_cmix(P, OC, LSE, T + (size_t)2 * TC * 512);
        } else if (k == 4) {
            pg8::Gemm g{T, (const bf16_t*)(ws + WS_WBR) + (size_t)l * 3072 * 512, 3 * TC, 3072, 512};
            BrOrder So{(int)gridDim.x, (int)blockIdx.x};
            EpiBr E{P, MT, MB};
            if (PH_MASK & 128) pg8::gemm_phase<EpiBr, BrOrder, true, true>(lds, g, So, E);
        } else {
            pg8::Gemm g{MB, (const bf16_t*)(ws + WS_WOUT) + (size_t)l * DM * DM, TC, DM, DM};
            pg8::StaticOrder So; So.init(TC, DM, (int)gridDim.x, (int)blockIdx.x);
            EpiOut E{xin, xout, mod_l, seq0, slog};
            if (PH_MASK & 256) pg8::gemm_phase<EpiOut, pg8::StaticOrder, true, true>(lds, g, So, E);
        }
    }
}

extern "C" void kernel_launch(void* const* d_in, const int* in_sizes, int n_in, void* d_out, int out_size, void* d_ws, size_t ws_size, hipStream_t stream) {
    static int grid = 0;
    if (grid == 0) {
        if (n_in != 22 || ws_size < WS_END) { fprintf(stderr, "kernel_launch: unexpected n_in %d / ws_size %zu (need %zu)\n", n_in, ws_size, (size_t)WS_END); grid = -1; return; }
        int dev = 0, cus = 0, per_cu = 0;
        (void)hipGetDevice(&dev); (void)hipDeviceGetAttribute(&cus, hipDeviceAttributeMultiprocessorCount, dev);
        if (hipFuncSetAttribute((const void*)mega, hipFuncAttributeMaxDynamicSharedMemorySize, LDS_BYTES) != hipSuccess) { fprintf(stderr, "kernel_launch: hipFuncSetAttribute failed\n"); grid = -1; return; }
        (void)hipOccupancyMaxActiveBlocksPerMultiprocessor(&per_cu, (const void*)mega, NTHR, LDS_BYTES);
        if (per_cu < 1) { fprintf(stderr, "kernel_launch: occupancy query says %d blocks per CU\n", per_cu); per_cu = 1; }
        (void)hipGetLastError();
        grid = cus;
    }
    if (grid < 0) return;
    Params p{};
    for (int i = 0; i < 22; ++i) p.in[i] = (const float*)d_in[i];
    p.out = (float*)d_out; p.ws = (unsigned char*)d_ws;
#if ONE_LAUNCH
    if (hipMemsetAsync((char*)d_ws + WS_BAR, 0, 16384, stream) != hipSuccess) { fprintf(stderr, "kernel_launch: memset failed\n"); return; }
    p.ph_lo = 0; p.ph_hi = NPHASE;
    void* args[] = {&p};
    hipError_t e = hipLaunchCooperativeKernel((const void*)mega, dim3(grid), dim3(NTHR), args, LDS_BYTES, stream);
    if (e != hipSuccess) fprintf(stderr, "cooperative launch failed: %s (grid %d)\n", hipGetErrorString(e), grid);
#else
    for (int ph = 0; ph < NPHASE; ++ph) {
        p.ph_lo = ph; p.ph_hi = ph + 1;
        hipLaunchKernelGGL(mega, dim3(grid), dim3(NTHR), LDS_BYTES, stream, p);
    }
#endif
}
```

```cpp
#include <hip/hip_runtime.h>
#include <hip/hip_cooperative_groups.h>
#include <cstdio>
#include <cstdint>
namespace cg = cooperative_groups;
__device__ __forceinline__ int otid() { int t = threadIdx.x; asm volatile("" : "+v"(t)); return t; }
namespace pg8 {
#define PG8_LAS __attribute__((address_space(3)))
typedef unsigned short bf16_t;
typedef short bf16x8 __attribute__((ext_vector_type(8)));
typedef float f32x4 __attribute__((ext_vector_type(4)));
typedef unsigned u32x4 __attribute__((ext_vector_type(4)));
constexpr int BM = 256, BK = 64, HALF = 128, HTB = HALF * BK * 2  , STAGE_BYTES = 8 * HTB, NXCD = 8, WGM = 8;

__host__ __device__ __forceinline__ int lds_byte(int r, int c) { const int st = (r >> 4) * 2 + (c >> 5), rr = r & 15, cc = c & 31, ob = rr * 64 + cc * 2; return st * 1024 + (ob ^ (((ob >> 9) & 1) << 5)); }
__host__ __device__ __forceinline__ void stage_rc(int b, int& R, int& C) { const int st = b / 1024, sb = b % 1024, swz = sb ^ (((sb >> 9) & 1) << 5); R = (st >> 1) * 16 + swz / 64; C = (st & 1) * 32 + (swz % 64) / 2; }
__host__ __device__ __forceinline__ int perm32(int rho) { const int n = rho >> 4, i = rho & 15; return 8 * (i >> 2) + 4 * n + (i & 3); }

struct Unit { int pm, pn; };
struct Gemm { const bf16_t* A; const bf16_t* Bt; int M, N, K, lda; };

struct StaticOrder {
    int nM, nN, nwg, G, c;
    __host__ __device__ void init(int M, int N, int G_, int c_) { nM = M / BM; nN = N / BM; nwg = nM * nN; G = G_; c = c_; }
    __host__ __device__ bool next(int i, Unit& u) const {
        const long L = (long)i * G + c; if (L >= nwg) return false;
        int wgid = (int)L; { const int q = nwg / NXCD, r = nwg % NXCD, xcd = wgid % NXCD, off = wgid / NXCD; wgid = (xcd < r ? xcd * (q + 1) : r * (q + 1) + (xcd - r) * q) + off; }
        const int nig = WGM * nN, gid = wgid / nig, fm = gid * WGM, gsz = (nM - fm) < WGM ? (nM - fm) : WGM;
        u.pm = fm + ((wgid % nig) % gsz); u.pn = (wgid % nig) / gsz; return true;
    }
    __device__ __forceinline__ void a_ready(const Unit&) const {}
    __device__ __forceinline__ void done(const Unit&) const {}
};

__device__ __forceinline__ unsigned cvt_pk_bf16(float lo, float hi) { unsigned r; asm volatile("v_cvt_pk_bf16_f32 %0, %1, %2" : "=v"(r) : "v"(lo), "v"(hi)); return r; }

template <class Epi, class Sched, bool ALIGN_EPI = false, bool SP2 = false>
__device__ __forceinline__ void gemm_phase(PG8_LAS unsigned char* lds, const Gemm g, const Sched& S, const Epi& E) {
    const int tid = otid(), wid = __builtin_amdgcn_readfirstlane(tid >> 6), lane = tid & 63, wr = wid >> 2, wc = wid & 3, fr = lane & 15, fq = lane >> 4;
    const int K = g.K, nt = K / BK;
    unsigned voffA[2], voffB[2];
#pragma unroll
    for (int i = 0; i < 2; ++i) { int R, C; stage_rc(tid * 16 + i * 8192, R, C); const int Rb = Epi::PERM ? ((R & ~31) + perm32(R & 31)) : R;
        voffA[i] = (unsigned)(R * g.lda + C) * 2u; voffB[i] = (unsigned)(Rb * K + C) * 2u; }
    const size_t kstep = (size_t)(BK * 2);
    const size_t hstep = (size_t)HALF * K * 2;
    const size_t tstep = 2 * hstep;
    const size_t hstepA = (size_t)HALF * g.lda * 2, tstepA = 2 * hstepA;
    const unsigned ldsw = (unsigned)wid * 1024u;
    const int aoff = lds_byte(wr * 64 + fr, fq * 8), boff = lds_byte(wc * 32 + fr, fq * 8);
#define PG8_SA(b, h) (((b) * 2 + (h)) * HTB)
#define PG8_SB(b, h) ((4 + (b) * 2 + (h)) * HTB)
#define PG8_STAGE(bufoff, gbase, voff) do { _Pragma("unroll") for (int _i = 0; _i < 2; ++_i) \
        __builtin_amdgcn_global_load_lds((const unsigned*)((const char*)(gbase) + (voff)[_i]), (PG8_LAS unsigned*)(lds + (bufoff) + ldsw + _i * 8192), 16, 0, 0); } while (0)
#define PG8_LDA(dst, b, h) do { _Pragma("unroll") for (int m = 0; m < 4; ++m) _Pragma("unroll") for (int k = 0; k < 2; ++k) dst[m][k] = *(const PG8_LAS bf16x8*)(lds + PG8_SA(b, h) + aoff + m * 2048 + k * 1024); } while (0)
#define PG8_LDB(dst, b, h) do { _Pragma("unroll") for (int n = 0; n < 2; ++n) _Pragma("unroll") for (int k = 0; k < 2; ++k) dst[n][k] = *(const PG8_LAS bf16x8*)(lds + PG8_SB(b, h) + boff + n * 2048 + k * 1024); } while (0)
#define PG8_MMA(ai, bj, At, Bt) do { __builtin_amdgcn_s_setprio(1); _Pragma("unroll") for (int m = 0; m < 4; ++m) _Pragma("unroll") for (int n = 0; n < 2; ++n) _Pragma("unroll") for (int k = 0; k < 2; ++k) \
        acc[ai][bj][m][n] = __builtin_amdgcn_mfma_f32_16x16x32_bf16(Bt[n][k], At[m][k], acc[ai][bj][m][n], 0, 0, 0); __builtin_amdgcn_s_setprio(0); } while (0)
#define PG8_WAIT_V(n) asm volatile("s_waitcnt vmcnt(" #n ")" ::: "memory")
#define PG8_WAIT_L(n) asm volatile("s_waitcnt lgkmcnt(" #n ")" ::: "memory")
#define PG8_BAR __builtin_amdgcn_s_barrier()
#define PG8_SCHED __builtin_amdgcn_sched_barrier(0)
    Unit cur, nxt; int ui = 0;
    if (!S.next(0, cur)) return;
    f32x4 acc[2][2][4][2];
#pragma unroll
    for (int a = 0; a < 2; ++a)
#pragma unroll
        for (int b = 0; b < 2; ++b)
#pragma unroll
            for (int m = 0; m < 4; ++m)
#pragma unroll
                for (int n = 0; n < 2; ++n) acc[a][b][m][n] = (f32x4){0.f, 0.f, 0.f, 0.f};
    bf16x8 At[4][2], B0[2][2], B1[2][2];
    const char* cA = (const char*)g.A + (size_t)cur.pm * tstepA; const char* cB = (const char*)g.Bt + (size_t)cur.pn * tstep;
    S.a_ready(cur);
    if constexpr (SP2) {
        PG8_STAGE(PG8_SB(0, 0), cB, voffB); PG8_STAGE(PG8_SB(0, 1), cB + hstep, voffB); PG8_STAGE(PG8_SA(0, 0), cA, voffA); PG8_STAGE(PG8_SA(0, 1), cA + hstepA, voffA);
        if (wr == 1) PG8_BAR;
        PG8_WAIT_V(2); PG8_BAR;
        PG8_STAGE(PG8_SB(1, 0), cB + kstep, voffB); PG8_STAGE(PG8_SA(1, 0), cA + kstep, voffA); PG8_STAGE(PG8_SB(1, 1), cB + hstep + kstep, voffB);
        PG8_WAIT_V(6); PG8_BAR;
    } else {
        PG8_STAGE(PG8_SB(0, 0), cB, voffB); PG8_STAGE(PG8_SA(0, 0), cA, voffA); PG8_STAGE(PG8_SB(0, 1), cB + hstep, voffB); PG8_STAGE(PG8_SA(0, 1), cA + hstepA, voffA);
        if (wr == 1) PG8_BAR;
        PG8_WAIT_V(4); PG8_BAR;
        PG8_STAGE(PG8_SB(1, 0), cB + kstep, voffB); PG8_STAGE(PG8_SA(1, 0), cA + kstep, voffA); PG8_STAGE(PG8_SB(1, 1), cB + hstep + kstep, voffB);
        PG8_WAIT_V(6); PG8_BAR;
    }
    for (;;) {
        const bool has_next = S.next(ui + 1, nxt);
        const char* nA = has_next ? (const char*)g.A + (size_t)nxt.pm * tstepA : cA; const char* nB = has_next ? (const char*)g.Bt + (size_t)nxt.pn * tstep : cB;
        for (int t = 0; t < nt; t += 2) {
            const bool last = (t == nt - 2);
            const char* a1 = cA + (size_t)(t + 1) * kstep;
            const char* a2 = last ? nA : cA + (size_t)(t + 2) * kstep; const char* b2 = last ? nB : cB + (size_t)(t + 2) * kstep;
            const char* a3 = a2 + kstep; const char* b3 = b2 + kstep;
            if (last && has_next) S.a_ready(nxt);
            if constexpr (SP2) {
            PG8_LDB(B0, 0, 0); PG8_LDB(B1, 0, 1); PG8_SCHED; PG8_LDA(At, 0, 0); PG8_STAGE(PG8_SA(1, 1), a1 + hstepA, voffA);
            PG8_WAIT_V(8); PG8_WAIT_L(0); PG8_BAR; PG8_MMA(0, 0, At, B0); PG8_MMA(0, 1, At, B1); PG8_BAR; PG8_SCHED;
            PG8_LDA(At, 0, 1); PG8_STAGE(PG8_SB(0, 0), b2, voffB); PG8_STAGE(PG8_SB(0, 1), b2 + hstep, voffB); PG8_STAGE(PG8_SA(0, 0), a2, voffA);
            PG8_WAIT_V(8); PG8_WAIT_L(0); PG8_BAR; PG8_MMA(1, 0, At, B0); PG8_MMA(1, 1, At, B1); PG8_BAR; PG8_SCHED;
            PG8_LDB(B0, 1, 0); PG8_LDB(B1, 1, 1); PG8_SCHED; PG8_LDA(At, 1, 0); PG8_STAGE(PG8_SA(0, 1), a2 + hstepA, voffA);
            PG8_WAIT_V(8); PG8_WAIT_L(0); PG8_BAR; PG8_MMA(0, 0, At, B0); PG8_MMA(0, 1, At, B1); PG8_BAR; PG8_SCHED;
            PG8_LDA(At, 1, 1); PG8_STAGE(PG8_SB(1, 0), b3, voffB); PG8_STAGE(PG8_SB(1, 1), b3 + hstep, voffB); PG8_STAGE(PG8_SA(1, 0), a3, voffA);
            PG8_WAIT_V(8); PG8_WAIT_L(0); PG8_BAR; PG8_MMA(1, 0, At, B0); PG8_MMA(1, 1, At, B1); PG8_BAR; PG8_SCHED;
            } else {
            PG8_LDB(B0, 0, 0); PG8_SCHED; PG8_LDA(At, 0, 0); PG8_STAGE(PG8_SA(1, 1), a1 + hstepA, voffA);
            PG8_WAIT_L(8); PG8_BAR; PG8_WAIT_L(0); PG8_MMA(0, 0, At, B0); PG8_BAR; PG8_SCHED;
            PG8_LDB(B1, 0, 1); PG8_STAGE(PG8_SB(0, 0), b2, voffB);
            PG8_BAR; PG8_WAIT_L(0); PG8_MMA(0, 1, At, B1); PG8_BAR;
            PG8_LDA(At, 0, 1); PG8_STAGE(PG8_SA(0, 0), a2, voffA);
            PG8_BAR; PG8_WAIT_L(0); PG8_MMA(1, 0, At, B0); PG8_BAR; PG8_SCHED;
            PG8_STAGE(PG8_SB(0, 1), b2 + hstep, voffB);
            PG8_WAIT_V(6); PG8_BAR; PG8_MMA(1, 1, At, B1); PG8_BAR;
            PG8_LDB(B0, 1, 0); PG8_SCHED; PG8_LDA(At, 1, 0); PG8_STAGE(PG8_SA(0, 1), a2 + hstepA, voffA);
            PG8_WAIT_L(8); PG8_BAR; PG8_WAIT_L(0); PG8_MMA(0, 0, At, B0); PG8_BAR; PG8_SCHED;
            PG8_LDB(B1, 1, 1); PG8_STAGE(PG8_SB(1, 0), b3, voffB);
            PG8_BAR; PG8_WAIT_L(0); PG8_MMA(0, 1, At, B1); PG8_BAR;
            PG8_LDA(At, 1, 1); PG8_STAGE(PG8_SA(1, 0), a3, voffA);
            PG8_BAR; PG8_WAIT_L(0); PG8_MMA(1, 0, At, B0); PG8_BAR; PG8_SCHED;
            PG8_STAGE(PG8_SB(1, 1), b3 + hstep, voffB);
            PG8_WAIT_V(6); PG8_BAR; PG8_MMA(1, 1, At, B1); PG8_BAR;
            }
        }
        if constexpr (ALIGN_EPI) { if (wr == 0) PG8_BAR; }
        if constexpr (!Epi::AFTER_DRAIN) { E(acc, cur, wr, wc, fr, fq); S.done(cur); }
        if (!has_next) break;
#pragma unroll
        for (int a = 0; a < 2; ++a)
#pragma unroll
            for (int b = 0; b < 2; ++b)
#pragma unroll
                for (int m = 0; m < 4; ++m)
#pragma unroll
                    for (int n = 0; n < 2; ++n) acc[a][b][m][n] = (f32x4){0.f, 0.f, 0.f, 0.f};
        cur = nxt; cA = nA; cB = nB; ++ui;
        if constexpr (ALIGN_EPI) { if (wr == 1) PG8_BAR; }
    }
    PG8_WAIT_V(0);
    if constexpr (!ALIGN_EPI) { if (wr == 0) PG8_BAR; }
    PG8_BAR;
    if constexpr (Epi::AFTER_DRAIN) { E.fused(acc, cur, wr, wc, fr, fq, lds, wid, lane); S.done(cur); }
#undef PG8_SA
#undef PG8_SB
#undef PG8_STAGE
#undef PG8_LDA
#undef PG8_LDB
#undef PG8_MMA
#undef PG8_WAIT_V
#undef PG8_WAIT_L
#undef PG8_BAR
#undef PG8_SCHED
}
}

#define LAS __attribute__((address_space(3)))
#ifndef PH_MASK
#define PH_MASK 0xFFF
#endif
#ifndef DUP_PH
#define DUP_PH -1
#endif
typedef unsigned short bf16_t;
typedef short bf16x8 __attribute__((ext_vector_type(8)));
typedef short s16x4 __attribute__((ext_vector_type(4)));
typedef short v4i16_t __attribute__((ext_vector_type(4)));
typedef float f32x2 __attribute__((ext_vector_type(2)));
typedef float f32x4 __attribute__((ext_vector_type(4)));
typedef float f32x16 __attribute__((ext_vector_type(16)));
typedef unsigned u32x2 __attribute__((ext_vector_type(2)));
typedef unsigned u32x4 __attribute__((ext_vector_type(4)));
typedef __bf16 bf16x2_t __attribute__((ext_vector_type(2)));

constexpr int DM = 1024, NIN = 12288, TCMAX = 32768, NCHUNK = 3, NSEQ = 36, NTHR = 512, NPROMPT = 16384;
__device__ __forceinline__ int chunk_row0(int c) { return c * 32768; }
__device__ __forceinline__ int chunk_rows(int c) { return c == 2 ? 16384 : 32768; }
__device__ __forceinline__ int seq_len_of(int g) { return g < NPROMPT ? 4096 : 2048; }
__device__ __forceinline__ int seq_of(int g) { return g < NPROMPT ? (g >> 12) : 4 + ((g - NPROMPT) >> 11); }
constexpr int COL_A_Q = 0, COL_A_K = 512, COL_A_V = 1024, COL_B_Q = 1536, COL_B_K = 2048, COL_B_V = 2560, COL_C_Q = 3072, COL_C_K = 4608,
              COL_C_V = 6144, COL_Z = 7680, COL_G = 9216;
constexpr float EPS = 1e-6f, LOG2E = 1.4426950408889634f, NEGBIG = -1e30f;

constexpr size_t WS_WIN = 0;
constexpr size_t WS_WBR = WS_WIN + (size_t)NIN * DM * 2;
constexpr size_t WS_WOUT = WS_WBR + 3072ull * 512 * 2;
constexpr size_t WS_MOD = WS_WOUT + (size_t)DM * DM * 2;
constexpr size_t WS_COSA = WS_MOD + 2ull * NSEQ * 3072 * 4;
constexpr size_t WS_SINA = WS_COSA + 4096ull * 32 * 4;
constexpr size_t WS_COSC = WS_SINA + 4096ull * 32 * 4;
constexpr size_t WS_SINC = WS_COSC + 4096ull * 64 * 4;
constexpr size_t WS_LAM = WS_SINC + 4096ull * 64 * 4;
constexpr size_t WS_GAIN = WS_LAM + 256;
constexpr size_t WS_BAR = WS_GAIN + 2 * 6 * 128 * 4;
constexpr size_t WS_P = WS_BAR + 16384;
constexpr size_t WS_T = WS_P + (size_t)TCMAX * NIN * 2;
constexpr size_t WS_OC = WS_T + 3ull * TCMAX * 512 * 2;
constexpr size_t WS_LSE = WS_OC + (size_t)TCMAX * 1536 * 2;
constexpr size_t WS_END = WS_LSE + (size_t)TCMAX * 12 * 4;

constexpr int LDS_BYTES = 159744;
constexpr int XCH_OFF = 131072;
constexpr int NPHASE = 2 + 15 + 1 + 15;

struct Params { const float* in[22]; float* out; unsigned char* ws; int ph_lo, ph_hi; };

__device__ __forceinline__ unsigned pk2(float lo, float hi) { f32x2 v = {lo, hi}; bf16x2_t b = __builtin_convertvector(v, bf16x2_t); return __builtin_bit_cast(unsigned, b); }
__device__ __forceinline__ float bflo(unsigned u) { return __uint_as_float(u << 16); }
__device__ __forceinline__ float bfhi(unsigned u) { return __uint_as_float(u & 0xffff0000u); }
__device__ __forceinline__ float wave_sum(float v) {
#pragma unroll
    for (int o = 32; o >= 1; o >>= 1) v += __shfl_xor(v, o);
    return v;
}
__device__ __forceinline__ float fast_exp2(float x) { return __builtin_amdgcn_exp2f(x); }
__device__ __forceinline__ float sigmoidf_(float x) { return __builtin_amdgcn_rcpf(1.f + __builtin_amdgcn_exp2f(x * -1.4426950408889634f)); }
__device__ __forceinline__ float siluf_(float x) { return x * sigmoidf_(x); }

__host__ __device__ __forceinline__ int tile_type(int pn) {
    if (pn < 4) return 1; if (pn < 6) return 0; if (pn < 10) return 2; if (pn < 12) return 0; if (pn < 24) return 3; if (pn < 30) return 0; if (pn < 36) return 4; return 5;
}
__device__ __forceinline__ int phys_row(int col) {
    const int pn = col >> 8, lc = col & 255, ty = tile_type(pn);
    if (ty == 1 || ty == 2) { const int wc = (lc >> 6) & 3, bj = (lc >> 5) & 1, rest = lc & 31; return (pn << 8) + 128 * bj + 32 * wc + rest; }
    if (ty == 3) { const int hh = lc >> 7, bj = (lc >> 6) & 1, w0 = (lc >> 5) & 1, rest = lc & 31; return (pn << 8) + 128 * bj + 32 * (2 * hh + w0) + rest; }
    return col;
}

__device__ __forceinline__ void transpose_item(const float* __restrict__ W, int K, int N, bf16_t* Bt, int kt, int nt, bool perm, LAS float* tile) {
    const int t = otid(), k0 = kt * 64, n0 = nt * 64;
#pragma unroll
    for (int i = 0; i < 8; ++i) { const int k = i * 8 + (t >> 6), n = t & 63; tile[k * 65 + n] = W[(size_t)(k0 + k) * N + n0 + n]; }
    __syncthreads();
    const int n = t >> 3, kk = (t & 7) * 8;
    u32x4 w;
    w.x = pk2(tile[(kk + 0) * 65 + n], tile[(kk + 1) * 65 + n]); w.y = pk2(tile[(kk + 2) * 65 + n], tile[(kk + 3) * 65 + n]);
    w.z = pk2(tile[(kk + 4) * 65 + n], tile[(kk + 5) * 65 + n]); w.w = pk2(tile[(kk + 6) * 65 + n], tile[(kk + 7) * 65 + n]);
    const int col = n0 + n, row = perm ? phys_row(col) : col;
    *(u32x4*)(Bt + (size_t)row * K + k0 + kk) = w;
    __syncthreads();
}

__device__ __forceinline__ void mod_item(const Params& p, int item, LAS float* sc) {
    const int l = item / 48, cb = item % 48, t = otid();
    const float* cp = p.in[2]; const float* cs = p.in[3];
    for (int i = t; i < NSEQ * 1024; i += NTHR) { const int s = i >> 10, k = i & 1023; const float c = (s < 4) ? cp[s * 1024 + k] : cs[(s - 4) * 1024 + k]; sc[i] = siluf_(c); }
    __syncthreads();
    const int col = t & 63, ks = t >> 6;
    const float* w = p.in[5] + (size_t)l * 1024 * 3072 + cb * 64 + col;
    float acc[NSEQ];
#pragma unroll
    for (int s = 0; s < NSEQ; ++s) acc[s] = 0.f;
    for (int k = ks * 128; k < ks * 128 + 128; ++k) {
        const float wv = w[(size_t)k * 3072];
#pragma unroll
        for (int s = 0; s < NSEQ; ++s) acc[s] += sc[s * 1024 + k] * wv;
    }
    __syncthreads();
#pragma unroll
    for (int s = 0; s < NSEQ; ++s) sc[(ks * NSEQ + s) * 64 + col] = acc[s];
    __syncthreads();
    float* mod = (float*)(p.ws + WS_MOD) + (size_t)l * NSEQ * 3072;
    const float* b = p.in[6] + (size_t)l * 3072;
    for (int i = t; i < NSEQ * 64; i += NTHR) {
        const int s = i >> 6, c = i & 63; float v = 0.f;
#pragma unroll
        for (int q = 0; q < 8; ++q) v += sc[(q * NSEQ + s) * 64 + c];
        mod[s * 3072 + cb * 64 + c] = v + b[cb * 64 + c];
    }
    __syncthreads();
}

__device__ __forceinline__ void phase_prew(const Params& p, LAS unsigned char* lds, int l) {
    LAS float* scr = (LAS float*)lds;
    const int G = gridDim.x, bid = blockIdx.x;
    constexpr int N_WIN = 16 * 192, N_WBR = 3 * 8 * 16, N_WOUT = 16 * 16, PER_L = N_WIN + N_WBR + N_WOUT;
    for (int item = bid; item < PER_L; item += G) {
        int it = item;
        if (it < N_WIN) { transpose_item(p.in[7] + (size_t)l * DM * NIN, DM, NIN, (bf16_t*)(p.ws + WS_WIN), it & 15, it >> 4, true, scr); }
        else if (it < N_WIN + N_WBR) { it -= N_WIN; const int br = it >> 7, r = it & 127;
            transpose_item(p.in[20] + ((size_t)l * 3 + br) * 512 * 1024, 512, 1024, (bf16_t*)(p.ws + WS_WBR) + (size_t)br * 1024 * 512, r & 7, r >> 3, false, scr); }
        else { it -= N_WIN + N_WBR; transpose_item(p.in[21] + (size_t)l * DM * DM, DM, DM, (bf16_t*)(p.ws + WS_WOUT), it & 15, it >> 4, false, scr); }
    }
}

__device__ __forceinline__ void phase_pre(const Params& p, LAS unsigned char* lds) {
    LAS float* scr = (LAS float*)lds;
    const int G = gridDim.x, bid = blockIdx.x, t = otid();
    for (int item = bid; item < 96; item += G) mod_item(p, item, scr);
    const int gt = bid * NTHR + t, gn = G * NTHR;
    float* cosA = (float*)(p.ws + WS_COSA); float* sinA = (float*)(p.ws + WS_SINA); float* cosC = (float*)(p.ws + WS_COSC); float* sinC = (float*)(p.ws + WS_SINC);
    for (int i = gt; i < 4096 * 96; i += gn) {
        int pos, j; float inv; float* cd; float* sd;
        if (i < 4096 * 32) { pos = i >> 5; j = i & 31; inv = exp2f(-(float)j * (13.287712379549449f / 32.f)); cd = cosA + i; sd = sinA + i; }
        else { const int i2 = i - 4096 * 32; pos = i2 >> 6; j = i2 & 63; inv = exp2f(-(float)j * (13.287712379549449f / 64.f)); cd = cosC + i2; sd = sinC + i2; }
        double x = (double)pos * (double)inv * 0.15915494309189535;
        x -= floor(x);
        const float r = (float)(x * 6.283185307179586);
        *cd = __cosf(r); *sd = __sinf(r);
    }
    if (bid == 1) {
        float* gt = (float*)(p.ws + WS_GAIN);
        for (int i = t; i < 2 * 6 * 128; i += NTHR) {
            const int l = i / 768, w = (i % 768) >> 7, d = i & 127; float v = 0.f;
            if (w == 0) { if (d < 64) v = p.in[8][l * 64 + d]; } else if (w == 1) { if (d < 64) v = p.in[9][l * 64 + d]; }
            else if (w == 2) { if (d < 64) v = p.in[15][l * 64 + d]; } else if (w == 3) { if (d < 64) v = p.in[16][l * 64 + d]; }
            else if (w == 4) v = p.in[18][l * 128 + d]; else v = p.in[19][l * 128 + d];
            gt[i] = v;
        }
    }
    if (bid == 0 && t < 2) {
        const int l = t; float a = 0.f, b = 0.f;
        for (int i = 0; i < 64; ++i) { a += p.in[10][l * 64 + i] * p.in[11][l * 64 + i]; b += p.in[12][l * 64 + i] * p.in[13][l * 64 + i]; }
        const float lam_init = 0.8f - 0.6f * expf(-0.3f * (float)l);
        float* L = (float*)(p.ws + WS_LAM);
        L[l] = expf(a) - expf(b) + lam_init; L[2 + l] = 1.f - lam_init;
    }
}

__device__ __forceinline__ void phase_h(const Params& p, int c, int l, bf16_t* H) {
    const int wave = otid() >> 6, lane = otid() & 63;
    const int row0 = chunk_row0(c), n = chunk_rows(c);
    const float* lng = p.in[4] + l * DM;
    const float* mod_l = (const float*)(p.ws + WS_MOD) + (size_t)l * NSEQ * 3072;
    for (int row = blockIdx.x * 8 + wave; row < n; row += gridDim.x * 8) {
        const int g = row0 + row;
        const float* xr = (l == 0) ? ((g < NPROMPT) ? p.in[0] + (size_t)g * DM : p.in[1] + (size_t)(g - NPROMPT) * DM) : p.out + (size_t)g * DM;
        f32x4 v[4]; float ss = 0.f;
#pragma unroll
        for (int j = 0; j < 4; ++j) { v[j] = *(const f32x4*)(xr + j * 256 + lane * 4); ss += v[j][0] * v[j][0] + v[j][1] * v[j][1] + v[j][2] * v[j][2] + v[j][3] * v[j][3]; }
        ss = wave_sum(ss);
        const float rstd = rsqrtf(ss * (1.f / 1024.f) + EPS);
        const float* md = mod_l + (size_t)seq_of(g) * 3072;
#pragma unroll
        for (int j = 0; j < 4; ++j) {
            const int col = j * 256 + lane * 4;
            const f32x4 gg = *(const f32x4*)(lng + col), sh = *(const f32x4*)(md + col), sc = *(const f32x4*)(md + 1024 + col);
            const f32x4 h = v[j] * rstd * gg * (sc + 1.0f) + sh;
            u32x2 o; o.x = pk2(h[0], h[1]); o.y = pk2(h[2], h[3]);
            *(u32x2*)(H + (size_t)row * DM + col) = o;
        }
    }
}

__device__ __forceinline__ u32x4 pack8(const f32x4& a, const f32x4& b) { u32x4 w; w.x = pk2(a[0], a[1]); w.y = pk2(a[2], a[3]); w.z = pk2(b[0], b[1]); w.w = pk2(b[2], b[3]); return w; }
__device__ __forceinline__ float dot4(const f32x4& a) { return a[0] * a[0] + a[1] * a[1] + a[2] * a[2] + a[3] * a[3]; }

struct EpiIn {
    static constexpr bool PERM = true, AFTER_DRAIN = false;
    bf16_t* P; const float* cosA; const float* sinA; const float* cosC; const float* sinC;
    const float* gtab; int row0; LAS float* xch;
    __device__ __forceinline__ static void piece(f32x4 a, f32x4 b, float rs, const float* glo, const float* ghi, const float* cp, const float* sp, bool rope, u32x2& pa, u32x2& pb) {
        a = a * rs * *(const f32x4*)glo; b = b * rs * *(const f32x4*)ghi;
        if (rope) { const f32x4 c = *(const f32x4*)cp, sn = *(const f32x4*)sp; const f32x4 na = a * c - b * sn, nb = b * c + a * sn; a = na; b = nb; }
        pa.x = pk2(a[0], a[1]); pa.y = pk2(a[2], a[3]); pb.x = pk2(b[0], b[1]); pb.y = pk2(b[2], b[3]);
    }
    __device__ __forceinline__ void operator()(const f32x4 (&acc)[2][2][4][2], const pg8::Unit& u, int wr, int wc, int fr, int fq) const {
        const int pn = u.pn, ty = tile_type(pn);
        const int rl0 = wr * 64 + fr;
        const size_t rowg0 = (size_t)u.pm * 256 + rl0;
        if (ty == 1 || ty == 2) {
            const bool isq = (ty == 1) ? (pn < 2) : (pn < 8);
            const float* g = gtab + ((ty == 1 ? 0 : 2) + (isq ? 0 : 1)) * 128 + 8 * fq;
            const float qs = isq ? 0.125f * LOG2E : 1.f;
            bf16_t* pb = P + rowg0 * NIN + pn * 256 + 64 * wc + 8 * fq;
#pragma unroll
            for (int ai = 0; ai < 2; ++ai)
#pragma unroll
                for (int m = 0; m < 4; ++m) {
                    float ss = dot4(acc[ai][0][m][0]) + dot4(acc[ai][0][m][1]) + dot4(acc[ai][1][m][0]) + dot4(acc[ai][1][m][1]);
                    ss += __shfl_xor(ss, 16); ss += __shfl_xor(ss, 32);
                    const float rs = rsqrtf(ss * (1.f / 64.f) + EPS) * qs;
                    const int roff = ai * 128 + m * 16;
                    const int gq = row0 + (int)rowg0 + roff; const int pos = gq & (seq_len_of(gq) - 1);
                    const float* cp = cosA + pos * 32 + 8 * fq; const float* sp = sinA + pos * 32 + 8 * fq;
                    u32x2 pa0, pb0, pa1, pb1;
                    piece(acc[ai][0][m][0], acc[ai][1][m][0], rs, g, g + 32, cp, sp, ty == 1, pa0, pb0);
                    piece(acc[ai][0][m][1], acc[ai][1][m][1], rs, g + 4, g + 36, cp + 4, sp + 4, ty == 1, pa1, pb1);
                    *(u32x4*)(pb + (size_t)roff * NIN) = (u32x4){pa0.x, pa0.y, pa1.x, pa1.y};
                    *(u32x4*)(pb + (size_t)roff * NIN + 32) = (u32x4){pb0.x, pb0.y, pb1.x, pb1.y};
                    __builtin_amdgcn_sched_barrier(0);
                }
        } else if (ty == 3) {
            const bool isq = pn < 18;
            const float qs = isq ? 0.08838834764831845f * LOG2E : 1.f;
            const int hh = wc >> 1, w0 = wc & 1;
#pragma unroll
            for (int ai = 0; ai < 2; ++ai)
#pragma unroll
                for (int m = 0; m < 4; ++m) {
                    float ss = dot4(acc[ai][0][m][0]) + dot4(acc[ai][0][m][1]) + dot4(acc[ai][1][m][0]) + dot4(acc[ai][1][m][1]);
                    ss += __shfl_xor(ss, 16); ss += __shfl_xor(ss, 32);
                    if (fq == 0) xch[(ai * 128 + m * 16 + rl0) * 4 + wc] = ss;
                    __builtin_amdgcn_sched_barrier(0);
                }
            __syncthreads();
            const int dlo = 32 * w0 + 8 * fq;
            const float* g = gtab + (isq ? 4 : 5) * 128 + dlo;
            bf16_t* pb = P + rowg0 * NIN + pn * 256 + 128 * hh + dlo;
#pragma unroll
            for (int ai = 0; ai < 2; ++ai)
#pragma unroll
                for (int m = 0; m < 4; ++m) {
                    const int roff = ai * 128 + m * 16;
                    const f32x2 t2 = *(LAS const f32x2*)(xch + (roff + rl0) * 4 + 2 * hh);
                    const float rs = rsqrtf((t2[0] + t2[1]) * (1.f / 128.f) + EPS) * qs;
                    const int gq = row0 + (int)rowg0 + roff; const int pos = gq & (seq_len_of(gq) - 1);
                    const float* cp = cosC + pos * 64 + dlo; const float* sp = sinC + pos * 64 + dlo;
                    u32x2 pa0, pb0, pa1, pb1;
                    piece(acc[ai][0][m][0], acc[ai][1][m][0], rs, g, g + 64, cp, sp, true, pa0, pb0);
                    piece(acc[ai][0][m][1], acc[ai][1][m][1], rs, g + 4, g + 68, cp + 4, sp + 4, true, pa1, pb1);
                    *(u32x4*)(pb + (size_t)roff * NIN) = (u32x4){pa0.x, pa0.y, pa1.x, pa1.y};
                    *(u32x4*)(pb + (size_t)roff * NIN + 64) = (u32x4){pb0.x, pb0.y, pb1.x, pb1.y};
                    __builtin_amdgcn_sched_barrier(0);
                }
        } else {
            bf16_t* pb = P + rowg0 * NIN + pn * 256 + 32 * wc + 8 * fq;
#pragma unroll
            for (int ai = 0; ai < 2; ++ai)
#pragma unroll
                for (int m = 0; m < 4; ++m)
#pragma unroll
                    for (int bj = 0; bj < 2; ++bj) {
                        f32x4 v0 = acc[ai][bj][m][0], v1 = acc[ai][bj][m][1];
                        if (ty == 4) {
#pragma unroll
                            for (int e = 0; e < 4; ++e) { v0[e] = siluf_(v0[e]); v1[e] = siluf_(v1[e]); }
                        } else if (ty == 5) {
#pragma unroll
                            for (int e = 0; e < 4; ++e) { v0[e] = sigmoidf_(v0[e]); v1[e] = sigmoidf_(v1[e]); }
                        }
                        *(u32x4*)(pb + (size_t)(ai * 128 + m * 16) * NIN + bj * 128) = pack8(v0, v1);
                        __builtin_amdgcn_sched_barrier(0);
                    }
        }
    }
};

struct BrOrder {
    int G, c, ntile;
    __device__ __forceinline__ bool next(int i, pg8::Unit& u) const {
        const int tk = i / 3, br = i - 3 * tk, tile = c + tk * G; if (tile >= ntile) return false;
        u.pm = (tile >> 2) + br * (TCMAX / 256); u.pn = (tile & 3) + br * 4; return true;
    }
    __device__ __forceinline__ void a_ready(const pg8::Unit&) const {}
    __device__ __forceinline__ void done(const pg8::Unit&) const {}
};

struct EpiBr {
    static constexpr bool PERM = true, AFTER_DRAIN = false;
    bf16_t* P;
    __device__ __forceinline__ void operator()(const f32x4 (&acc)[2][2][4][2], const pg8::Unit& u, int wr, int wc, int fr, int fq) const {
        const int br = u.pm >> 7, pm = u.pm & 127, pn = u.pn & 3;
        const size_t row0 = (size_t)pm * 256 + wr * 64 + fr; const int col0 = pn * 256 + 32 * wc + 8 * fq;
#pragma unroll
        for (int ai = 0; ai < 2; ++ai)
#pragma unroll
            for (int m = 0; m < 4; ++m)
#pragma unroll
                for (int bj = 0; bj < 2; ++bj) {
                    const size_t row = row0 + ai * 128 + m * 16; const int col = col0 + bj * 128;
                    const u32x4 sg = *(const u32x4*)(P + row * NIN + COL_G + br * 1024 + col);
                    f32x4 v0 = acc[ai][bj][m][0], v1 = acc[ai][bj][m][1];
                    v0[0] *= bflo(sg.x); v0[1] *= bfhi(sg.x); v0[2] *= bflo(sg.y); v0[3] *= bfhi(sg.y);
                    v1[0] *= bflo(sg.z); v1[1] *= bfhi(sg.z); v1[2] *= bflo(sg.w); v1[3] *= bfhi(sg.w);
                    float* mt = (float*)(P + row * NIN + 1024) + col;
                    if (br > 0) { v0 += *(const f32x4*)mt; v1 += *(const f32x4*)(mt + 4); }
                    if (br < 2) { *(f32x4*)mt = v0; *(f32x4*)(mt + 4) = v1; }
                    else *(u32x4*)(P + row * NIN + col) = pack8(v0, v1);
                }
    }
};

struct EpiOut {
    static constexpr bool PERM = true, AFTER_DRAIN = false;
    const float* xp; const float* xs; float* out; const float* mod_l; int row0, layer;
    __device__ __forceinline__ void operator()(const f32x4 (&acc)[2][2][4][2], const pg8::Unit& u, int wr, int wc, int fr, int fq) const {
        const int g0 = row0 + u.pm * 256 + wr * 64 + fr; const int col0 = u.pn * 256 + 32 * wc + 8 * fq;
#pragma unroll
        for (int ai = 0; ai < 2; ++ai)
#pragma unroll
            for (int m = 0; m < 4; ++m) {
                const int g = g0 + ai * 128 + m * 16;
                const float* gt = mod_l + (size_t)seq_of(g) * 3072 + 2048;
                const float* xr = (layer == 0) ? ((g < NPROMPT) ? xp + (size_t)g * DM : xs + (size_t)(g - NPROMPT) * DM) : out + (size_t)g * DM;
                float* orow = out + (size_t)g * DM;
#pragma unroll
                for (int bj = 0; bj < 2; ++bj) {
                    const int col = col0 + bj * 128;
                    const f32x4 g0v = *(const f32x4*)(gt + col), g1v = *(const f32x4*)(gt + col + 4);
                    const f32x4 x0 = *(const f32x4*)(xr + col), x1 = *(const f32x4*)(xr + col + 4);
                    *(f32x4*)(orow + col) = x0 + g0v * acc[ai][bj][m][0];
                    *(f32x4*)(orow + col + 4) = x1 + g1v * acc[ai][bj][m][1];
                }
            }
    }
};

struct AttnCtx { const bf16_t* P; bf16_t* T; bf16_t* OC; float* LSE; const float* subln; const float* rpb; float lam, oml; int row0, n; };

__device__ __forceinline__ int crow(int i, int h) { return (i & 3) + 8 * (i >> 2) + 4 * h; }
__device__ __forceinline__ s16x4 vtr(LAS const unsigned char* p) { return __builtin_bit_cast(s16x4, __builtin_amdgcn_ds_read_tr16_b64_v4i16((LAS v4i16_t*)p)); }
#define MFMA32(a, b, c) __builtin_amdgcn_mfma_f32_32x32x16_bf16((a), (b), (c), 0, 0, 0)
#define DS_TR16(dst, addr, off) asm volatile("ds_read_b64_tr_b16 %0, %1 offset:%c2" : "=&v"(dst) : "v"(addr), "i"(off) : "memory")
#define DS_RD128(dst, addr, off) asm volatile("ds_read_b128 %0, %1 offset:%c2" : "=&v"(dst) : "v"(addr), "i"(off) : "memory")
#define LGKM0() asm volatile("s_waitcnt lgkmcnt(0)" ::: "memory")
#define SBAR() __builtin_amdgcn_sched_barrier(0)

template <int DQK, int DV, int MODE>
__device__ __forceinline__ void attn_item(LAS unsigned char* lds, int item, const AttnCtx& cx) {
    constexpr int KP = DQK * 2 + 16, VP = DV * 2 + 64, KBY = 64 * KP, VBY = 64 * VP, HB = KBY + VBY;
    constexpr int NQF = DQK / 16, NDV = DV / 32, NKP = DQK / 32, NVP = DV / 32, KPR = DQK / 8, VPR = DV / 8;
    static_assert(4 * HB + 4096 <= LDS_BYTES, "attention LDS");
    const int tid = otid(), lane = tid & 63, wave = __builtin_amdgcn_readfirstlane(tid >> 6), hf = wave >> 2, wq = wave & 3, r = lane & 31, h = lane >> 5, th = tid & 255;
    const bf16_t* __restrict__ P = cx.P;
    int head, tok0, seqbase, qcol, kcol, vcol, ntiles, qtok, S;
    int na_rows = 0, na_rs0 = 0, na_rq = 0, na_cq = 0, na_rsq = 0, na_csq = 0;
    int c_dlog = 0, c_rho = 0, c_l0 = 0, c_L = 0, c_lq = 0;
    if (MODE == 0) {
        head = item & 3; tok0 = (item >> 2) * 128; S = seq_len_of(cx.row0 + tok0); seqbase = ((cx.row0 + tok0) & ~(S - 1)) - cx.row0;
        qcol = COL_A_Q + head * 128 + hf * 64; kcol = COL_A_K + head * 128 + hf * 64; vcol = COL_A_V + head * 128; ntiles = S >> 6;
        qtok = tok0 + 32 * wq + r;
    } else if (MODE == 1) {
        const int unit = item * 2 + hf; head = unit & 7; tok0 = (unit >> 3) * 128; S = seq_len_of(cx.row0 + tok0); seqbase = ((cx.row0 + tok0) & ~(S - 1)) - cx.row0;
        qcol = COL_B_Q + head * 64; kcol = COL_B_K + head * 64; vcol = COL_B_V + head * 64; ntiles = 9;
        qtok = tok0 + 32 * wq + r;
        na_rows = S >> 6; const int r0 = (tok0 - seqbase) >> 6; na_rs0 = min(max(r0 - 4, 0), na_rows - 8);
        na_rq = r0 + (wq >> 1); na_cq = 32 * (wq & 1) + r; na_rsq = min(max(na_rq - 4, 0), na_rows - 8); na_csq = min(max(na_cq - 8, 0), 48);
    } else {
        const int unit = item * 2 + hf; head = unit % 12; const int blk = unit / 12; tok0 = blk * 128; S = seq_len_of(cx.row0 + tok0); seqbase = ((cx.row0 + tok0) & ~(S - 1)) - cx.row0;
        qcol = COL_C_Q + head * 128; kcol = COL_C_K + head * 128; vcol = COL_C_V + head * 128; ntiles = 4;
        c_dlog = 2 * (head >> 2); const int b = (tok0 - seqbase) >> 7; c_rho = b & ((1 << c_dlog) - 1); c_l0 = (b >> c_dlog) * 128; c_L = S >> c_dlog;
        c_lq = c_l0 + 32 * wq + r; qtok = seqbase + (c_lq << c_dlog) + c_rho;
    }
    auto ktok = [&](int j, int kr) -> int {
        if (MODE == 0) return seqbase + 64 * j + kr;
        if (MODE == 1) return seqbase + min(na_rs0 + j, na_rows - 1) * 64 + kr;
        const int lk = min(max(c_l0 - 64 + 64 * j + kr, 0), c_L - 1); return seqbase + (lk << c_dlog) + c_rho;
    };
    const bool loadV = !(MODE == 0 && hf == 1);
    u32x4 kreg[NKP], vreg[NVP];
    auto gload = [&](int j) {
#pragma unroll
        for (int i = 0; i < NKP; ++i) { const int pid = th + 256 * i, row = pid / KPR, cp = pid % KPR; kreg[i] = *(const u32x4*)(P + (size_t)ktok(j, row) * NIN + kcol + cp * 8); }
        if (loadV) {
#pragma unroll
            for (int i = 0; i < NVP; ++i) { const int pid = th + 256 * i, row = pid / VPR, cp = pid % VPR; vreg[i] = *(const u32x4*)(P + (size_t)ktok(j, row) * NIN + vcol + cp * 8); }
        }
    };
    auto lstore = [&](int b) {
        LAS unsigned char* base = lds + (b * 2 + hf) * HB;
#pragma unroll
        for (int i = 0; i < NKP; ++i) { const int pid = th + 256 * i, row = pid / KPR, cp = pid % KPR; *(LAS u32x4*)(base + row * KP + cp * 16) = kreg[i]; }
        if (loadV) {
#pragma unroll
            for (int i = 0; i < NVP; ++i) { const int pid = th + 256 * i, row = pid / VPR, cp = pid % VPR; *(LAS u32x4*)(base + KBY + row * VP + cp * 16) = vreg[i]; }
        }
    };
    LAS float* biasL = (LAS float*)(lds + 4 * HB) + hf * 512;
    gload(0);
    bf16x8 qf[NQF];
#pragma unroll
    for (int ks = 0; ks < NQF; ++ks) qf[ks] = *(const bf16x8*)(P + (size_t)qtok * NIN + qcol + 16 * ks + 8 * h);
    if (MODE == 1) { for (int i = th; i < 465; i += 256) biasL[i] = cx.rpb[head * 465 + i] * LOG2E; }
    lstore(0);
    f32x16 O[NDV];
#pragma unroll
    for (int d = 0; d < NDV; ++d)
#pragma unroll
        for (int i = 0; i < 16; ++i) O[d][i] = 0.f;
    float mrun = NEGBIG, lrun = 0.f;
#pragma unroll
    for (int ks = 0; ks < NQF; ++ks) asm volatile("" : "+v"(qf[ks]));
    __syncthreads();
    const int q4 = (lane & 15) >> 2, p4 = lane & 3, rblk = (lane >> 4) & 1;
    for (int j = 0; j < ntiles; ++j) {
        if (j + 1 < ntiles) gload(j + 1);
        bool active = true;
        if (MODE == 1) { const int rk = na_rs0 + j; active = (rk >= na_rsq) && (rk < na_rsq + 8); }
        if (MODE == 2) { const int lk0 = c_l0 - 64 + 64 * j; active = ((wq < 2) ? (j <= 2) : (j >= 1)) && (lk0 + 63 >= 0) && (lk0 < c_L); }
        if (active) {
            LAS const unsigned char* Kb = lds + ((j & 1) * 2 + hf) * HB;
            LAS const unsigned char* Vb = lds + ((j & 1) * 2 + (MODE == 0 ? 0 : hf)) * HB + KBY;
            f32x16 s0, s1;
#pragma unroll
            for (int i = 0; i < 16; ++i) { s0[i] = 0.f; s1[i] = 0.f; }
            const unsigned kaddr = (unsigned)(size_t)Kb + r * KP + 16 * h;
            const unsigned vaddr = (unsigned)(size_t)Vb + (4 * h + q4) * VP + (16 * rblk + 4 * p4) * 2;
            bf16x8 kfr[2][4];
#define K_ISSUE(b, kb) do { DS_RD128(kfr[b][0], kaddr, (2 * (kb)) * 32); DS_RD128(kfr[b][1], kaddr, 32 * KP + (2 * (kb)) * 32); \
                            DS_RD128(kfr[b][2], kaddr, (2 * (kb) + 1) * 32); DS_RD128(kfr[b][3], kaddr, 32 * KP + (2 * (kb) + 1) * 32); } while (0)
            s16x4 vlo[2][4], vhi[2][4];
#define V_ISSUE(b, d) do { _Pragma("unroll") for (int k4 = 0; k4 < 4; ++k4) { DS_TR16(vlo[b][k4], vaddr, (16 * k4) * VP + (d) * 64); DS_TR16(vhi[b][k4], vaddr, (16 * k4 + 8) * VP + (d) * 64); } } while (0)
            K_ISSUE(0, 0);
#pragma unroll
            for (int kb = 0; kb < NQF / 2; ++kb) {
                LGKM0(); SBAR();
                s0 = MFMA32(kfr[kb & 1][0], qf[2 * kb], s0); s1 = MFMA32(kfr[kb & 1][1], qf[2 * kb], s1);
                s0 = MFMA32(kfr[kb & 1][2], qf[2 * kb + 1], s0); s1 = MFMA32(kfr[kb & 1][3], qf[2 * kb + 1], s1);
                SBAR();
                if (kb + 1 < NQF / 2) K_ISSUE((kb + 1) & 1, kb + 1); else V_ISSUE(0, 0);
            }
            if (MODE == 1) {
                const int rk = na_rs0 + j; const int bbase = (rk - na_rq + 7) * 31 + 15 - na_cq;
#pragma unroll
                for (int i = 0; i < 16; ++i) {
                    const int ck0 = crow(i, h), ck1 = ck0 + 32;
                    const bool v0 = (ck0 >= na_csq) && (ck0 < na_csq + 16), v1 = (ck1 >= na_csq) && (ck1 < na_csq + 16);
                    const float b0 = biasL[v0 ? bbase + ck0 : 0], b1 = biasL[v1 ? bbase + ck1 : 0];
                    s0[i] = v0 ? s0[i] + b0 : NEGBIG; s1[i] = v1 ? s1[i] + b1 : NEGBIG;
                }
            }
            if (MODE == 2) {
                const int lk0 = c_l0 - 64 + 64 * j;
#pragma unroll
                for (int i = 0; i < 16; ++i) {
                    const int lka = lk0 + crow(i, h), lkb = lka + 32;
                    const bool v0 = (lka >= 0) && (lka < c_L) && (abs(lka - c_lq) <= 64), v1 = (lkb >= 0) && (lkb < c_L) && (abs(lkb - c_lq) <= 64);
                    s0[i] = v0 ? s0[i] : NEGBIG; s1[i] = v1 ? s1[i] : NEGBIG;
                }
            }
            float mx = fmaxf(s0[0], s1[0]);
#pragma unroll
            for (int i = 1; i < 16; ++i) mx = fmaxf(mx, fmaxf(s0[i], s1[i]));
            { auto rr = __builtin_amdgcn_permlane32_swap(__float_as_uint(mx), __float_as_uint(mx), false, false); mx = fmaxf(__uint_as_float(rr[0]), __uint_as_float(rr[1])); }
            const float mn = fmaxf(mrun, mx), alpha = fast_exp2(mrun - mn);
            const bool moved = __builtin_amdgcn_ballot_w64(mn > mrun) != 0ull;
            mrun = mn;
            float ps = 0.f;
#pragma unroll
            for (int i = 0; i < 16; ++i) { s0[i] = fast_exp2(s0[i] - mn); s1[i] = fast_exp2(s1[i] - mn); ps += s0[i] + s1[i]; }
            lrun = lrun * alpha + ps;
            if (moved) {
#pragma unroll
                for (int d = 0; d < NDV; ++d)
#pragma unroll
                    for (int i = 0; i < 16; ++i) O[d][i] *= alpha;
            }
            bf16x8 pa[2][2];
            { u32x4 w;
              w.x = pk2(s0[0], s0[1]); w.y = pk2(s0[2], s0[3]); w.z = pk2(s0[4], s0[5]); w.w = pk2(s0[6], s0[7]); pa[0][0] = __builtin_bit_cast(bf16x8, w);
              w.x = pk2(s0[8], s0[9]); w.y = pk2(s0[10], s0[11]); w.z = pk2(s0[12], s0[13]); w.w = pk2(s0[14], s0[15]); pa[0][1] = __builtin_bit_cast(bf16x8, w);
              w.x = pk2(s1[0], s1[1]); w.y = pk2(s1[2], s1[3]); w.z = pk2(s1[4], s1[5]); w.w = pk2(s1[6], s1[7]); pa[1][0] = __builtin_bit_cast(bf16x8, w);
              w.x = pk2(s1[8], s1[9]); w.y = pk2(s1[10], s1[11]); w.z = pk2(s1[12], s1[13]); w.w = pk2(s1[14], s1[15]); pa[1][1] = __builtin_bit_cast(bf16x8, w); }
#pragma unroll
            for (int d = 0; d < NDV; ++d) {
                LGKM0(); SBAR();
#pragma unroll
                for (int k4 = 0; k4 < 4; ++k4) {
                    const bf16x8 vf = __builtin_shufflevector(vlo[d & 1][k4], vhi[d & 1][k4], 0, 1, 2, 3, 4, 5, 6, 7);
                    O[d] = MFMA32(vf, pa[k4 >> 1][k4 & 1], O[d]);
                }
                SBAR();
                if (d + 1 < NDV) V_ISSUE((d + 1) & 1, d + 1);
            }
#undef K_ISSUE
#undef V_ISSUE
        }
        if (j + 1 < ntiles) lstore((j + 1) & 1);
        __syncthreads();
    }
    const float lt = lrun + __shfl_xor(lrun, 32);
    const float inv = 1.f / lt;
    if (MODE == 0) {
        LAS float* X = (LAS float*)lds;
        if (hf == 1) {
#pragma unroll
            for (int d = 0; d < NDV; ++d)
#pragma unroll
                for (int g4 = 0; g4 < 4; ++g4) {
                    f32x4 v = {O[d][4 * g4] * inv, O[d][4 * g4 + 1] * inv, O[d][4 * g4 + 2] * inv, O[d][4 * g4 + 3] * inv};
                    *(LAS f32x4*)(X + (32 * wq + r) * 132 + 32 * d + 8 * g4 + 4 * h) = v;
                }
        }
        __syncthreads();
        if (hf == 0) {
            float ss = 0.f;
#pragma unroll
            for (int d = 0; d < NDV; ++d)
#pragma unroll
                for (int g4 = 0; g4 < 4; ++g4) {
                    const f32x4 o2 = *(LAS const f32x4*)(X + (32 * wq + r) * 132 + 32 * d + 8 * g4 + 4 * h);
#pragma unroll
                    for (int e = 0; e < 4; ++e) { const float o = O[d][4 * g4 + e] * inv - cx.lam * o2[e]; O[d][4 * g4 + e] = o; ss += o * o; }
                }
            ss += __shfl_xor(ss, 32);
            const float rstd = rsqrtf(ss * (1.f / 128.f) + EPS) * cx.oml;
#pragma unroll
            for (int d = 0; d < NDV; ++d)
#pragma unroll
                for (int g4 = 0; g4 < 4; ++g4) {
                    const int dv = 32 * d + 8 * g4 + 4 * h;
                    const f32x4 gn = *(const f32x4*)(cx.subln + dv);
                    const u32x2 sz = *(const u32x2*)(P + (size_t)qtok * NIN + COL_Z + head * 128 + dv);
                    u32x2 o;
                    o.x = pk2(O[d][4 * g4] * rstd * gn[0] * bflo(sz.x), O[d][4 * g4 + 1] * rstd * gn[1] * bfhi(sz.x));
                    o.y = pk2(O[d][4 * g4 + 2] * rstd * gn[2] * bflo(sz.y), O[d][4 * g4 + 3] * rstd * gn[3] * bfhi(sz.y));
                    *(u32x2*)(cx.T + (size_t)qtok * 512 + head * 128 + dv) = o;
                }
        }
        __syncthreads();
    } else if (MODE == 1) {
#pragma unroll
        for (int d = 0; d < NDV; ++d)
#pragma unroll
            for (int g4 = 0; g4 < 4; ++g4) {
                const int dv = 32 * d + 8 * g4 + 4 * h;
                const u32x2 sz = *(const u32x2*)(P + (size_t)qtok * NIN + COL_Z + 512 + head * 64 + dv);
                u32x2 o;
                o.x = pk2(O[d][4 * g4] * inv * bflo(sz.x), O[d][4 * g4 + 1] * inv * bfhi(sz.x));
                o.y = pk2(O[d][4 * g4 + 2] * inv * bflo(sz.y), O[d][4 * g4 + 3] * inv * bfhi(sz.y));
                *(u32x2*)(cx.T + (size_t)TCMAX * 512 + (size_t)qtok * 512 + head * 64 + dv) = o;
            }
    } else {
#pragma unroll
        for (int d = 0; d < NDV; ++d)
#pragma unroll
            for (int g4 = 0; g4 < 4; ++g4) {
                const int dv = 32 * d + 8 * g4 + 4 * h;
                u32x2 o; o.x = pk2(O[d][4 * g4] * inv, O[d][4 * g4 + 1] * inv); o.y = pk2(O[d][4 * g4 + 2] * inv, O[d][4 * g4 + 3] * inv);
                *(u32x2*)(cx.OC + (size_t)qtok * 1536 + head * 128 + dv) = o;
            }
        if (h == 0) cx.LSE[(size_t)qtok * 12 + head] = mrun + __log2f(lt);
    }
}

__device__ __forceinline__ void phase_attn(LAS unsigned char* lds, const AttnCtx& cx) {
    const int G = gridDim.x, c = blockIdx.x, nb = cx.n >> 7;
    for (int it = c; it < nb * 4; it += G) attn_item<64, 128, 0>(lds, it, cx);
    for (int it = c; it < nb * 6; it += G) attn_item<128, 128, 2>(lds, it, cx);
    for (int it = c; it < nb * 4; it += G) attn_item<64, 64, 1>(lds, it, cx);
}

__device__ __forceinline__ void phase_cmix(const bf16_t* __restrict__ P, const bf16_t* __restrict__ OC, const float* __restrict__ LSE, bf16_t* T2, int n) {
#pragma unroll 4
    for (int idx = blockIdx.x * NTHR + otid(); idx < n * 64; idx += gridDim.x * NTHR) {
        const int tok = idx >> 6, c8 = idx & 63, hh = c8 >> 4, dv = (c8 & 15) * 8;
        const float l0 = LSE[(size_t)tok * 12 + hh], l1 = LSE[(size_t)tok * 12 + 4 + hh], l2 = LSE[(size_t)tok * 12 + 8 + hh];
        const float mx = fmaxf(l0, fmaxf(l1, l2));
        float w0 = fast_exp2(l0 - mx), w1 = fast_exp2(l1 - mx), w2 = fast_exp2(l2 - mx);
        const float iw = 1.f / (w0 + w1 + w2); w0 *= iw; w1 *= iw; w2 *= iw;
        const u32x4 a = *(const u32x4*)(OC + (size_t)tok * 1536 + hh * 128 + dv), b = *(const u32x4*)(OC + (size_t)tok * 1536 + (4 + hh) * 128 + dv),
                    c = *(const u32x4*)(OC + (size_t)tok * 1536 + (8 + hh) * 128 + dv), z = *(const u32x4*)(P + (size_t)tok * NIN + COL_Z + 1024 + hh * 128 + dv);
        u32x4 o;
        o.x = pk2((w0 * bflo(a.x) + w1 * bflo(b.x) + w2 * bflo(c.x)) * bflo(z.x), (w0 * bfhi(a.x) + w1 * bfhi(b.x) + w2 * bfhi(c.x)) * bfhi(z.x));
        o.y = pk2((w0 * bflo(a.y) + w1 * bflo(b.y) + w2 * bflo(c.y)) * bflo(z.y), (w0 * bfhi(a.y) + w1 * bfhi(b.y) + w2 * bfhi(c.y)) * bfhi(z.y));
        o.z = pk2((w0 * bflo(a.z) + w1 * bflo(b.z) + w2 * bflo(c.z)) * bflo(z.z), (w0 * bfhi(a.z) + w1 * bfhi(b.z) + w2 * bfhi(c.z)) * bfhi(z.z));
        o.w = pk2((w0 * bflo(a.w) + w1 * bflo(b.w) + w2 * bflo(c.w)) * bflo(z.w), (w0 * bfhi(a.w) + w1 * bfhi(b.w) + w2 * bfhi(c.w)) * bfhi(z.w));
        *(u32x4*)(T2 + (size_t)tok * 512 + hh * 128 + dv) = o;
    }
}

#define XB_TMO      128
#define XB_XCNT(j)  (256  + 64 * (j))
#define XB_XSUB(j)  (1280 + 64 * (j))
#define XB_XGEN(j)  (2304 + 64 * (j))
#define XB_TOP      3328
#define XB_TOPGEN   3392
#define XCD_BAR_WORDS 3456
#define XB_SPIN_CAP (1u << 18)

__device__ __forceinline__ unsigned xb_ld(unsigned* p)              { return __hip_atomic_load(p, __ATOMIC_RELAXED, __HIP_MEMORY_SCOPE_AGENT); }
__device__ __forceinline__ unsigned xb_add(unsigned* p, unsigned v) { return __hip_atomic_fetch_add(p, v, __ATOMIC_RELAXED, __HIP_MEMORY_SCOPE_AGENT); }
__device__ __forceinline__ unsigned xb_xcc_id() { return (unsigned)__builtin_amdgcn_s_getreg((3 << 11) | 20) & 0xFu; }
#define XB_SPIN(cond, bar) do { unsigned _sp = 0; while (cond) { __builtin_amdgcn_s_sleep(1); \
    if ((++_sp & 255u) == 0u) { if (xb_ld(&(bar)[XB_TMO])) break; if (_sp > XB_SPIN_CAP) { atomicAdd(&(bar)[XB_TMO], 1u); break; } } } } while (0)

struct XcdBarrier {
    unsigned* bar; unsigned x;
    volatile LAS unsigned* st;
};

__device__ __forceinline__ XcdBarrier xcd_barrier_post(unsigned* bar, volatile LAS unsigned* st) {
    XcdBarrier b; b.bar = bar; b.x = xb_xcc_id(); b.st = st;
    if (threadIdx.x == 0) (void)xb_add(&bar[XB_XCNT(b.x)], 1u);
    return b;
}
__device__ __forceinline__ void xcd_barrier_complete(unsigned* bar, unsigned x, unsigned& nloc, unsigned& nx) {
    const unsigned G = gridDim.x * gridDim.y * gridDim.z;
    unsigned sum, cnt, mine, sp = 0u;
    for (;;) {
        sum = 0u; cnt = 0u; mine = 0u;
#pragma unroll
        for (unsigned j = 0; j < 16; ++j) { const unsigned c = xb_ld(&bar[XB_XCNT(j)]); sum += c; cnt += (c > 0u) ? 1u : 0u; mine = (j == x) ? c : mine; }
        if (sum == G) break;
        __builtin_amdgcn_s_sleep(1);
        if ((++sp & 255u) == 0u) { if (xb_ld(&bar[XB_TMO])) break; if (sp > XB_SPIN_CAP) { atomicAdd(&bar[XB_TMO], 1u); break; } }
    }
    nloc = mine > 0u ? mine : 1u; nx = cnt > 0u ? cnt : 1u;
}

__device__ __forceinline__ void xcd_barrier(const XcdBarrier& b) {
    asm volatile("s_waitcnt vmcnt(0)" ::: "memory");
    __syncthreads();
    if (threadIdx.x == 0) {
        unsigned* bar = b.bar;
        __builtin_amdgcn_s_waitcnt(0);
        unsigned nloc = b.st[0], nx = b.st[1];
        if (nloc == 0u) { xcd_barrier_complete(bar, b.x, nloc, nx); b.st[0] = nloc; b.st[1] = nx; }
        const unsigned old = xb_add(&bar[XB_XSUB(b.x)], 1u);
        const unsigned gen = old / nloc;
        if (old + 1u == (gen + 1u) * nloc) {
            __builtin_amdgcn_fence(__ATOMIC_RELEASE, "agent");
            asm volatile("s_waitcnt vmcnt(0)" ::: "memory");
            const unsigned og = xb_add(&bar[XB_TOP], 1u);
            const unsigned tg = og / nx;
            if (og + 1u == (tg + 1u) * nx) xb_add(&bar[XB_TOPGEN], 1u);
            else XB_SPIN(xb_ld(&bar[XB_TOPGEN]) == tg, bar);
            __builtin_amdgcn_fence(__ATOMIC_ACQUIRE, "agent");
            xb_add(&bar[XB_XGEN(b.x)], 1u);
            asm volatile("s_waitcnt vmcnt(0)" ::: "memory");
        } else {
            XB_SPIN(xb_ld(&bar[XB_XGEN(b.x)]) == gen, bar);
            __builtin_amdgcn_fence(__ATOMIC_ACQUIRE, "agent");
            asm volatile("s_waitcnt vmcnt(0)" ::: "memory");
        }
    }
    __syncthreads();
}

#ifndef ONE_LAUNCH
#define ONE_LAUNCH 1
#endif

__global__ void __launch_bounds__(NTHR, 2) mega(Params p) {
    extern __shared__ __attribute__((aligned(16))) unsigned char lds_raw[];
    LAS unsigned char* lds = (LAS unsigned char*)lds_raw;
    unsigned char* ws = p.ws;
    volatile LAS unsigned* bst = (volatile LAS unsigned*)(lds + LDS_BYTES - 16);
    if (threadIdx.x < 2) bst[threadIdx.x] = 0u;
    __syncthreads();
    XcdBarrier bar; bar.bar = (unsigned*)(ws + WS_BAR); bar.x = 0; bar.st = bst;
    if (p.ph_hi - p.ph_lo > 1) bar = xcd_barrier_post((unsigned*)(ws + WS_BAR), bst);
    bf16_t* P = (bf16_t*)(ws + WS_P); bf16_t* T = (bf16_t*)(ws + WS_T); bf16_t* H = T; bf16_t* OC = (bf16_t*)(ws + WS_OC); float* LSE = (float*)(ws + WS_LSE);
    for (int ph = p.ph_lo; ph < p.ph_hi; ++ph) {
        if (ph > p.ph_lo) { if (ph == 1) cg::this_grid().sync(); else xcd_barrier(bar); }
        if (ph == 0) { phase_pre(p, lds); phase_prew(p, lds, 0); continue; }
        if (ph == 1) { phase_h(p, 0, 0, H); continue; }
        if (ph == 17) { phase_prew(p, lds, 1); phase_h(p, 0, 1, H); continue; }
        const int l = (ph > 17) ? 1 : 0, q = ph - (l ? 18 : 2), c = q / 5, k = q - c * 5;
        const int row0 = chunk_row0(c), n = chunk_rows(c);
        const float* mod_l = (const float*)(ws + WS_MOD) + (size_t)l * NSEQ * 3072;
        if (k == 0) {
            pg8::Gemm g{H, (const bf16_t*)(ws + WS_WIN), n, NIN, DM, DM};
            pg8::StaticOrder So; So.init(n, NIN, (int)gridDim.x, (int)blockIdx.x);
            EpiIn E{P, (const float*)(ws + WS_COSA), (const float*)(ws + WS_SINA), (const float*)(ws + WS_COSC), (const float*)(ws + WS_SINC),
                    (const float*)(ws + WS_GAIN) + l * 6 * 128, row0, (LAS float*)(lds + XCH_OFF)};
            pg8::gemm_phase<EpiIn, pg8::StaticOrder, true, true>(lds, g, So, E);
        } else if (k == 1) {
            const float* L = (const float*)(ws + WS_LAM);
            AttnCtx cx{P, T, OC, LSE, p.in[14] + l * 128, p.in[17] + (size_t)l * 8 * 465, L[l], L[2 + l], row0, n};
            phase_attn(lds, cx);
        } else if (k == 2) {
            phase_cmix(P, OC, LSE, T + (size_t)2 * TCMAX * 512, n);
        } else if (k == 3) {
            pg8::Gemm g{T, (const bf16_t*)(ws + WS_WBR), 3 * TCMAX, 3072, 512, 512};
            BrOrder So{(int)gridDim.x, (int)blockIdx.x, (n >> 8) * 4};
            EpiBr E{P};
            pg8::gemm_phase<EpiBr, BrOrder, true, true>(lds, g, So, E);
        } else {
            pg8::Gemm g{P, (const bf16_t*)(ws + WS_WOUT), n, DM, DM, NIN};
            pg8::StaticOrder So; So.init(n, DM, (int)gridDim.x, (int)blockIdx.x);
            EpiOut E{p.in[0], p.in[1], p.out, mod_l, row0, l};
            pg8::gemm_phase<EpiOut, pg8::StaticOrder, true, true>(lds, g, So, E);
            if (c < 2) phase_h(p, c + 1, l, H);
        }
    }
}

extern "C" void kernel_launch(void* const* d_in, const int* in_sizes, int n_in, void* d_out, int out_size, void* d_ws, size_t ws_size, hipStream_t stream) {
    static int grid = 0;
    if (grid == 0) {
        if (n_in != 22 || ws_size < WS_END) { fprintf(stderr, "kernel_launch: unexpected n_in %d / ws_size %zu (need %zu)\n", n_in, ws_size, (size_t)WS_END); grid = -1; return; }
        int dev = 0, cus = 0, per_cu = 0;
        (void)hipGetDevice(&dev); (void)hipDeviceGetAttribute(&cus, hipDeviceAttributeMultiprocessorCount, dev);
        if (hipFuncSetAttribute((const void*)mega, hipFuncAttributeMaxDynamicSharedMemorySize, LDS_BYTES) != hipSuccess) { fprintf(stderr, "kernel_launch: hipFuncSetAttribute failed\n"); grid = -1; return; }
        (void)hipOccupancyMaxActiveBlocksPerMultiprocessor(&per_cu, (const void*)mega, NTHR, LDS_BYTES);
        if (per_cu < 1) { fprintf(stderr, "kernel_launch: occupancy query says %d blocks per CU\n", per_cu); per_cu = 1; }
        (void)hipGetLastError();
        grid = cus;
    }
    if (grid < 0) return;
    Params p{};
    for (int i = 0; i < 22; ++i) p.in[i] = (const float*)d_in[i];
    p.out = (float*)d_out; p.ws = (unsigned char*)d_ws;
#if ONE_LAUNCH
    if (hipMemsetAsync((char*)d_ws + WS_BAR, 0, 16384, stream) != hipSuccess) { fprintf(stderr, "kernel_launch: memset failed\n"); return; }
    p.ph_lo = 0; p.ph_hi = NPHASE;
    void* args[] = {&p};
    hipError_t e = hipLaunchCooperativeKernel((const void*)mega, dim3(grid), dim3(NTHR), args, LDS_BYTES, stream);
    if (e != hipSuccess) fprintf(stderr, "cooperative launch failed: %s (grid %d)\n", hipGetErrorString(e), grid);
#else
    for (int ph = 0; ph < NPHASE; ++ph) {
        p.ph_lo = ph; p.ph_hi = ph + 1;
        hipLaunchKernelGGL(mega, dim3(grid), dim3(NTHR), LDS_BYTES, stream, p);
    }
#endif
}
```

```cpp
#include <hip/hip_runtime.h>
#include <hip/hip_cooperative_groups.h>
#include <cstdio>
#include <cstdint>
namespace cg = cooperative_groups;
__device__ __forceinline__ int otid() { int t = threadIdx.x; asm volatile("" : "+v"(t)); return t; }
namespace pg8 {
#define PG8_LAS __attribute__((address_space(3)))
typedef unsigned short bf16_t;
typedef short bf16x8 __attribute__((ext_vector_type(8)));
typedef float f32x4 __attribute__((ext_vector_type(4)));
typedef unsigned u32x4 __attribute__((ext_vector_type(4)));
constexpr int BM = 256, BK = 64, HALF = 128, HTB = HALF * BK * 2  , STAGE_BYTES = 8 * HTB, NXCD = 8, WGM = 8;

__host__ __device__ __forceinline__ int lds_byte(int r, int c) { const int st = (r >> 4) * 2 + (c >> 5), rr = r & 15, cc = c & 31, ob = rr * 64 + cc * 2; return st * 1024 + (ob ^ (((ob >> 9) & 1) << 5)); }
__host__ __device__ __forceinline__ void stage_rc(int b, int& R, int& C) { const int st = b / 1024, sb = b % 1024, swz = sb ^ (((sb >> 9) & 1) << 5); R = (st >> 1) * 16 + swz / 64; C = (st & 1) * 32 + (swz % 64) / 2; }
__host__ __device__ __forceinline__ int perm32(int rho) { const int n = rho >> 4, i = rho & 15; return 8 * (i >> 2) + 4 * n + (i & 3); }

struct Unit { int pm, pn; };
struct Gemm { const bf16_t* A; const bf16_t* Bt; int M, N, K, lda; };

struct StaticOrder {
    int nM, nN, nwg, G, c;
    __host__ __device__ void init(int M, int N, int G_, int c_) { nM = M / BM; nN = N / BM; nwg = nM * nN; G = G_; c = c_; }
    __host__ __device__ bool next(int i, Unit& u) const {
        const long L = (long)i * G + c; if (L >= nwg) return false;
        int wgid = (int)L; { const int q = nwg / NXCD, r = nwg % NXCD, xcd = wgid % NXCD, off = wgid / NXCD; wgid = (xcd < r ? xcd * (q + 1) : r * (q + 1) + (xcd - r) * q) + off; }
        const int nig = WGM * nN, gid = wgid / nig, fm = gid * WGM, gsz = (nM - fm) < WGM ? (nM - fm) : WGM;
        u.pm = fm + ((wgid % nig) % gsz); u.pn = (wgid % nig) / gsz; return true;
    }
    __device__ __forceinline__ void a_ready(const Unit&) const {}
    __device__ __forceinline__ void done(const Unit&) const {}
};

__device__ __forceinline__ unsigned cvt_pk_bf16(float lo, float hi) { unsigned r; asm volatile("v_cvt_pk_bf16_f32 %0, %1, %2" : "=v"(r) : "v"(lo), "v"(hi)); return r; }

template <class Epi, class Sched, bool ALIGN_EPI = false, bool SP2 = false>
__device__ __forceinline__ void gemm_phase(PG8_LAS unsigned char* lds, const Gemm g, const Sched& S, const Epi& E) {
    const int tid = otid(), wid = __builtin_amdgcn_readfirstlane(tid >> 6), lane = tid & 63, wr = wid >> 2, wc = wid & 3, fr = lane & 15, fq = lane >> 4;
    const int K = g.K, nt = K / BK;
    unsigned voffA[2], voffB[2];
#pragma unroll
    for (int i = 0; i < 2; ++i) { int R, C; stage_rc(tid * 16 + i * 8192, R, C); const int Rb = Epi::PERM ? ((R & ~31) + perm32(R & 31)) : R;
        voffA[i] = (unsigned)(R * g.lda + C) * 2u; voffB[i] = (unsigned)(Rb * K + C) * 2u; }
    const size_t kstep = (size_t)(BK * 2);
    const size_t hstep = (size_t)HALF * K * 2;
    const size_t tstep = 2 * hstep;
    const size_t hstepA = (size_t)HALF * g.lda * 2, tstepA = 2 * hstepA;
    const unsigned ldsw = (unsigned)wid * 1024u;
    const int aoff = lds_byte(wr * 64 + fr, fq * 8), boff = lds_byte(wc * 32 + fr, fq * 8);
#define PG8_SA(b, h) (((b) * 2 + (h)) * HTB)
#define PG8_SB(b, h) ((4 + (b) * 2 + (h)) * HTB)
#define PG8_STAGE(bufoff, gbase, voff) do { _Pragma("unroll") for (int _i = 0; _i < 2; ++_i) \
        __builtin_amdgcn_global_load_lds((const unsigned*)((const char*)(gbase) + (voff)[_i]), (PG8_LAS unsigned*)(lds + (bufoff) + ldsw + _i * 8192), 16, 0, 0); } while (0)
#define PG8_LDA(dst, b, h) do { _Pragma("unroll") for (int m = 0; m < 4; ++m) _Pragma("unroll") for (int k = 0; k < 2; ++k) dst[m][k] = *(const PG8_LAS bf16x8*)(lds + PG8_SA(b, h) + aoff + m * 2048 + k * 1024); } while (0)
#define PG8_LDB(dst, b, h) do { _Pragma("unroll") for (int n = 0; n < 2; ++n) _Pragma("unroll") for (int k = 0; k < 2; ++k) dst[n][k] = *(const PG8_LAS bf16x8*)(lds + PG8_SB(b, h) + boff + n * 2048 + k * 1024); } while (0)
#define PG8_MMA(ai, bj, At, Bt) do { __builtin_amdgcn_s_setprio(1); _Pragma("unroll") for (int m = 0; m < 4; ++m) _Pragma("unroll") for (int n = 0; n < 2; ++n) _Pragma("unroll") for (int k = 0; k < 2; ++k) \
        acc[ai][bj][m][n] = __builtin_amdgcn_mfma_f32_16x16x32_bf16(Bt[n][k], At[m][k], acc[ai][bj][m][n], 0, 0, 0); __builtin_amdgcn_s_setprio(0); } while (0)
#define PG8_WAIT_V(n) asm volatile("s_waitcnt vmcnt(" #n ")" ::: "memory")
#define PG8_WAIT_L(n) asm volatile("s_waitcnt lgkmcnt(" #n ")" ::: "memory")
#define PG8_BAR __builtin_amdgcn_s_barrier()
#define PG8_SCHED __builtin_amdgcn_sched_barrier(0)
    Unit cur, nxt; int ui = 0;
    if (!S.next(0, cur)) return;
    f32x4 acc[2][2][4][2];
#pragma unroll
    for (int a = 0; a < 2; ++a)
#pragma unroll
        for (int b = 0; b < 2; ++b)
#pragma unroll
            for (int m = 0; m < 4; ++m)
#pragma unroll
                for (int n = 0; n < 2; ++n) acc[a][b][m][n] = (f32x4){0.f, 0.f, 0.f, 0.f};
    bf16x8 At[4][2], B0[2][2], B1[2][2];
    const char* cA = (const char*)g.A + (size_t)cur.pm * tstepA; const char* cB = (const char*)g.Bt + (size_t)cur.pn * tstep;
    S.a_ready(cur);
    if constexpr (SP2) {
        PG8_STAGE(PG8_SB(0, 0), cB, voffB); PG8_STAGE(PG8_SB(0, 1), cB + hstep, voffB); PG8_STAGE(PG8_SA(0, 0), cA, voffA); PG8_STAGE(PG8_SA(0, 1), cA + hstepA, voffA);
        if (wr == 1) PG8_BAR;
        PG8_WAIT_V(2); PG8_BAR;
        PG8_STAGE(PG8_SB(1, 0), cB + kstep, voffB); PG8_STAGE(PG8_SA(1, 0), cA + kstep, voffA); PG8_STAGE(PG8_SB(1, 1), cB + hstep + kstep, voffB);
        PG8_WAIT_V(6); PG8_BAR;
    } else {
        PG8_STAGE(PG8_SB(0, 0), cB, voffB); PG8_STAGE(PG8_SA(0, 0), cA, voffA); PG8_STAGE(PG8_SB(0, 1), cB + hstep, voffB); PG8_STAGE(PG8_SA(0, 1), cA + hstepA, voffA);
        if (wr == 1) PG8_BAR;
        PG8_WAIT_V(4); PG8_BAR;
        PG8_STAGE(PG8_SB(1, 0), cB + kstep, voffB); PG8_STAGE(PG8_SA(1, 0), cA + kstep, voffA); PG8_STAGE(PG8_SB(1, 1), cB + hstep + kstep, voffB);
        PG8_WAIT_V(6); PG8_BAR;
    }
    for (;;) {
        const bool has_next = S.next(ui + 1, nxt);
        const char* nA = has_next ? (const char*)g.A + (size_t)nxt.pm * tstepA : cA; const char* nB = has_next ? (const char*)g.Bt + (size_t)nxt.pn * tstep : cB;
        for (int t = 0; t < nt; t += 2) {
            const bool last = (t == nt - 2);
            const char* a1 = cA + (size_t)(t + 1) * kstep;
            const char* a2 = last ? nA : cA + (size_t)(t + 2) * kstep; const char* b2 = last ? nB : cB + (size_t)(t + 2) * kstep;
            const char* a3 = a2 + kstep; const char* b3 = b2 + kstep;
            if (last && has_next) S.a_ready(nxt);
            if constexpr (SP2) {
            PG8_LDB(B0, 0, 0); PG8_LDB(B1, 0, 1); PG8_SCHED; PG8_LDA(At, 0, 0); PG8_STAGE(PG8_SA(1, 1), a1 + hstepA, voffA);
            PG8_WAIT_V(8); PG8_WAIT_L(0); PG8_BAR; PG8_MMA(0, 0, At, B0); PG8_MMA(0, 1, At, B1); PG8_BAR; PG8_SCHED;
            PG8_LDA(At, 0, 1); PG8_STAGE(PG8_SB(0, 0), b2, voffB); PG8_STAGE(PG8_SB(0, 1), b2 + hstep, voffB); PG8_STAGE(PG8_SA(0, 0), a2, voffA);
            PG8_WAIT_V(8); PG8_WAIT_L(0); PG8_BAR; PG8_MMA(1, 0, At, B0); PG8_MMA(1, 1, At, B1); PG8_BAR; PG8_SCHED;
            PG8_LDB(B0, 1, 0); PG8_LDB(B1, 1, 1); PG8_SCHED; PG8_LDA(At, 1, 0); PG8_STAGE(PG8_SA(0, 1), a2 + hstepA, voffA);
            PG8_WAIT_V(8); PG8_WAIT_L(0); PG8_BAR; PG8_MMA(0, 0, At, B0); PG8_MMA(0, 1, At, B1); PG8_BAR; PG8_SCHED;
            PG8_LDA(At, 1, 1); PG8_STAGE(PG8_SB(1, 0), b3, voffB); PG8_STAGE(PG8_SB(1, 1), b3 + hstep, voffB); PG8_STAGE(PG8_SA(1, 0), a3, voffA);
            PG8_WAIT_V(8); PG8_WAIT_L(0); PG8_BAR; PG8_MMA(1, 0, At, B0); PG8_MMA(1, 1, At, B1); PG8_BAR; PG8_SCHED;
            } else {
            PG8_LDB(B0, 0, 0); PG8_SCHED; PG8_LDA(At, 0, 0); PG8_STAGE(PG8_SA(1, 1), a1 + hstepA, voffA);
            PG8_WAIT_L(8); PG8_BAR; PG8_WAIT_L(0); PG8_MMA(0, 0, At, B0); PG8_BAR; PG8_SCHED;
            PG8_LDB(B1, 0, 1); PG8_STAGE(PG8_SB(0, 0), b2, voffB);
            PG8_BAR; PG8_WAIT_L(0); PG8_MMA(0, 1, At, B1); PG8_BAR;
            PG8_LDA(At, 0, 1); PG8_STAGE(PG8_SA(0, 0), a2, voffA);
            PG8_BAR; PG8_WAIT_L(0); PG8_MMA(1, 0, At, B0); PG8_BAR; PG8_SCHED;
            PG8_STAGE(PG8_SB(0, 1), b2 + hstep, voffB);
            PG8_WAIT_V(6); PG8_BAR; PG8_MMA(1, 1, At, B1); PG8_BAR;
            PG8_LDB(B0, 1, 0); PG8_SCHED; PG8_LDA(At, 1, 0); PG8_STAGE(PG8_SA(0, 1), a2 + hstepA, voffA);
            PG8_WAIT_L(8); PG8_BAR; PG8_WAIT_L(0); PG8_MMA(0, 0, At, B0); PG8_BAR; PG8_SCHED;
            PG8_LDB(B1, 1, 1); PG8_STAGE(PG8_SB(1, 0), b3, voffB);
            PG8_BAR; PG8_WAIT_L(0); PG8_MMA(0, 1, At, B1); PG8_BAR;
            PG8_LDA(At, 1, 1); PG8_STAGE(PG8_SA(1, 0), a3, voffA);
            PG8_BAR; PG8_WAIT_L(0); PG8_MMA(1, 0, At, B0); PG8_BAR; PG8_SCHED;
            PG8_STAGE(PG8_SB(1, 1), b3 + hstep, voffB);
            PG8_WAIT_V(6); PG8_BAR; PG8_MMA(1, 1, At, B1); PG8_BAR;
            }
        }
        if constexpr (ALIGN_EPI) { if (wr == 0) PG8_BAR; }
        if constexpr (!Epi::AFTER_DRAIN) { E(acc, cur, wr, wc, fr, fq); S.done(cur); }
        if (!has_next) break;
#pragma unroll
        for (int a = 0; a < 2; ++a)
#pragma unroll
            for (int b = 0; b < 2; ++b)
#pragma unroll
                for (int m = 0; m < 4; ++m)
#pragma unroll
                    for (int n = 0; n < 2; ++n) acc[a][b][m][n] = (f32x4){0.f, 0.f, 0.f, 0.f};
        cur = nxt; cA = nA; cB = nB; ++ui;
        if constexpr (ALIGN_EPI) { if (wr == 1) PG8_BAR; }
    }
    PG8_WAIT_V(0);
    if constexpr (!ALIGN_EPI) { if (wr == 0) PG8_BAR; }
    PG8_BAR;
    if constexpr (Epi::AFTER_DRAIN) { E.fused(acc, cur, wr, wc, fr, fq, lds, wid, lane); S.done(cur); }
#undef PG8_SA
#undef PG8_SB
#undef PG8_STAGE
#undef PG8_LDA
#undef PG8_LDB
#undef PG8_MMA
#undef PG8_WAIT_V
#undef PG8_WAIT_L
#undef PG8_BAR
#undef PG8_SCHED
}
}

#define LAS __attribute__((address_space(3)))
#ifndef PH_MASK
#define PH_MASK 0xFFF
#endif
#ifndef DUP_PH
#define DUP_PH -1
#endif
typedef unsigned short bf16_t;
typedef short bf16x8 __attribute__((ext_vector_type(8)));
typedef short s16x4 __attribute__((ext_vector_type(4)));
typedef short v4i16_t __attribute__((ext_vector_type(4)));
typedef float f32x2 __attribute__((ext_vector_type(2)));
typedef float f32x4 __attribute__((ext_vector_type(4)));
typedef float f32x16 __attribute__((ext_vector_type(16)));
typedef unsigned u32x2 __attribute__((ext_vector_type(2)));
typedef unsigned u32x4 __attribute__((ext_vector_type(4)));
typedef __bf16 bf16x2_t __attribute__((ext_vector_type(2)));

constexpr int DM = 1024, NIN = 12288, TCMAX = 32768, NCHUNK = 3, NSEQ = 36, NTHR = 512, NPROMPT = 16384;
__device__ __forceinline__ int chunk_row0(int c) { return c * 32768; }
__device__ __forceinline__ int chunk_rows(int c) { return c == 2 ? 16384 : 32768; }
__device__ __forceinline__ int seq_len_of(int g) { return g < NPROMPT ? 4096 : 2048; }
__device__ __forceinline__ int seq_of(int g) { return g < NPROMPT ? (g >> 12) : 4 + ((g - NPROMPT) >> 11); }
constexpr int COL_A_Q = 0, COL_A_K = 512, COL_A_V = 1024, COL_B_Q = 1536, COL_B_K = 2048, COL_B_V = 2560, COL_C_Q = 3072, COL_C_K = 4608,
              COL_C_V = 6144, COL_Z = 7680, COL_G = 9216;
constexpr float EPS = 1e-6f, LOG2E = 1.4426950408889634f, NEGBIG = -1e30f;

constexpr size_t WS_WIN = 0;
constexpr size_t WS_WBR = WS_WIN + (size_t)NIN * DM * 2;
constexpr size_t WS_WOUT = WS_WBR + 3072ull * 512 * 2;
constexpr size_t WS_MOD = WS_WOUT + (size_t)DM * DM * 2;
constexpr size_t WS_COSA = WS_MOD + 2ull * NSEQ * 3072 * 4;
constexpr size_t WS_SINA = WS_COSA + 4096ull * 32 * 4;
constexpr size_t WS_COSC = WS_SINA + 4096ull * 32 * 4;
constexpr size_t WS_SINC = WS_COSC + 4096ull * 64 * 4;
constexpr size_t WS_LAM = WS_SINC + 4096ull * 64 * 4;
constexpr size_t WS_GAIN = WS_LAM + 256;
constexpr size_t WS_BAR = WS_GAIN + 2 * 6 * 128 * 4;
constexpr size_t WS_P = WS_BAR + 16384;
constexpr size_t WS_T = WS_P + (size_t)TCMAX * NIN * 2;
constexpr size_t WS_OC = WS_T + 3ull * TCMAX * 512 * 2;
constexpr size_t WS_LSE = WS_OC + (size_t)TCMAX * 1536 * 2;
constexpr size_t WS_END = WS_LSE + (size_t)TCMAX * 12 * 4;

constexpr int LDS_BYTES = 159744;
constexpr int XCH_OFF = 131072;
constexpr int NPHASE = 2 + 15 + 1 + 15;

struct Params { const float* in[22]; float* out; unsigned char* ws; int ph_lo, ph_hi; };

__device__ __forceinline__ unsigned pk2(float lo, float hi) { f32x2 v = {lo, hi}; bf16x2_t b = __builtin_convertvector(v, bf16x2_t); return __builtin_bit_cast(unsigned, b); }
__device__ __forceinline__ float bflo(unsigned u) { return __uint_as_float(u << 16); }
__device__ __forceinline__ float bfhi(unsigned u) { return __uint_as_float(u & 0xffff0000u); }
__device__ __forceinline__ float wave_sum(float v) {
#pragma unroll
    for (int o = 32; o >= 1; o >>= 1) v += __shfl_xor(v, o);
    return v;
}
__device__ __forceinline__ float fast_exp2(float x) { return __builtin_amdgcn_exp2f(x); }
__device__ __forceinline__ float sigmoidf_(float x) { return __builtin_amdgcn_rcpf(1.f + __builtin_amdgcn_exp2f(x * -1.4426950408889634f)); }
__device__ __forceinline__ float siluf_(float x) { return x * sigmoidf_(x); }

__host__ __device__ __forceinline__ int tile_type(int pn) {
    if (pn < 4) return 1; if (pn < 6) return 0; if (pn < 10) return 2; if (pn < 12) return 0; if (pn < 24) return 3; if (pn < 30) return 0; if (pn < 36) return 4; return 5;
}
__device__ __forceinline__ int phys_row(int col) {
    const int pn = col >> 8, lc = col & 255, ty = tile_type(pn);
    if (ty == 1 || ty == 2) { const int wc = (lc >> 6) & 3, bj = (lc >> 5) & 1, rest = lc & 31; return (pn << 8) + 128 * bj + 32 * wc + rest; }
    if (ty == 3) { const int hh = lc >> 7, bj = (lc >> 6) & 1, w0 = (lc >> 5) & 1, rest = lc & 31; return (pn << 8) + 128 * bj + 32 * (2 * hh + w0) + rest; }
    return col;
}

__device__ __forceinline__ void transpose_item(const float* __restrict__ W, int K, int N, bf16_t* Bt, int kt, int nt, bool perm, LAS float* tile) {
    const int t = otid(), k0 = kt * 64, n0 = nt * 64;
#pragma unroll
    for (int i = 0; i < 8; ++i) { const int k = i * 8 + (t >> 6), n = t & 63; tile[k * 65 + n] = W[(size_t)(k0 + k) * N + n0 + n]; }
    __syncthreads();
    const int n = t >> 3, kk = (t & 7) * 8;
    u32x4 w;
    w.x = pk2(tile[(kk + 0) * 65 + n], tile[(kk + 1) * 65 + n]); w.y = pk2(tile[(kk + 2) * 65 + n], tile[(kk + 3) * 65 + n]);
    w.z = pk2(tile[(kk + 4) * 65 + n], tile[(kk + 5) * 65 + n]); w.w = pk2(tile[(kk + 6) * 65 + n], tile[(kk + 7) * 65 + n]);
    const int col = n0 + n, row = perm ? phys_row(col) : col;
    *(u32x4*)(Bt + (size_t)row * K + k0 + kk) = w;
    __syncthreads();
}

__device__ __forceinline__ void mod_item(const Params& p, int item, LAS float* sc) {
    const int l = item / 48, cb = item % 48, t = otid();
    const float* cp = p.in[2]; const float* cs = p.in[3];
    for (int i = t; i < NSEQ * 1024; i += NTHR) { const int s = i >> 10, k = i & 1023; const float c = (s < 4) ? cp[s * 1024 + k] : cs[(s - 4) * 1024 + k]; sc[i] = siluf_(c); }
    __syncthreads();
    const int col = t & 63, ks = t >> 6;
    const float* w = p.in[5] + (size_t)l * 1024 * 3072 + cb * 64 + col;
    float acc[NSEQ];
#pragma unroll
    for (int s = 0; s < NSEQ; ++s) acc[s] = 0.f;
    for (int k = ks * 128; k < ks * 128 + 128; ++k) {
        const float wv = w[(size_t)k * 3072];
#pragma unroll
        for (int s = 0; s < NSEQ; ++s) acc[s] += sc[s * 1024 + k] * wv;
    }
    __syncthreads();
#pragma unroll
    for (int s = 0; s < NSEQ; ++s) sc[(ks * NSEQ + s) * 64 + col] = acc[s];
    __syncthreads();
    float* mod = (float*)(p.ws + WS_MOD) + (size_t)l * NSEQ * 3072;
    const float* b = p.in[6] + (size_t)l * 3072;
    for (int i = t; i < NSEQ * 64; i += NTHR) {
        const int s = i >> 6, c = i & 63; float v = 0.f;
#pragma unroll
        for (int q = 0; q < 8; ++q) v += sc[(q * NSEQ + s) * 64 + c];
        mod[s * 3072 + cb * 64 + c] = v + b[cb * 64 + c];
    }
    __syncthreads();
}

__device__ __forceinline__ void phase_prew(const Params& p, LAS unsigned char* lds, int l) {
    LAS float* scr = (LAS float*)lds;
    const int G = gridDim.x, bid = blockIdx.x;
    constexpr int N_WIN = 16 * 192, N_WBR = 3 * 8 * 16, N_WOUT = 16 * 16, PER_L = N_WIN + N_WBR + N_WOUT;
    for (int item = bid; item < PER_L; item += G) {
        int it = item;
        if (it < N_WIN) { transpose_item(p.in[7] + (size_t)l * DM * NIN, DM, NIN, (bf16_t*)(p.ws + WS_WIN), it & 15, it >> 4, true, scr); }
        else if (it < N_WIN + N_WBR) { it -= N_WIN; const int br = it >> 7, r = it & 127;
            transpose_item(p.in[20] + ((size_t)l * 3 + br) * 512 * 1024, 512, 1024, (bf16_t*)(p.ws + WS_WBR) + (size_t)br * 1024 * 512, r & 7, r >> 3, false, scr); }
        else { it -= N_WIN + N_WBR; transpose_item(p.in[21] + (size_t)l * DM * DM, DM, DM, (bf16_t*)(p.ws + WS_WOUT), it & 15, it >> 4, false, scr); }
    }
}

__device__ __forceinline__ void phase_pre(const Params& p, LAS unsigned char* lds) {
    LAS float* scr = (LAS float*)lds;
    const int G = gridDim.x, bid = blockIdx.x, t = otid();
    for (int item = bid; item < 96; item += G) mod_item(p, item, scr);
    const int gt = bid * NTHR + t, gn = G * NTHR;
    float* cosA = (float*)(p.ws + WS_COSA); float* sinA = (float*)(p.ws + WS_SINA); float* cosC = (float*)(p.ws + WS_COSC); float* sinC = (float*)(p.ws + WS_SINC);
    for (int i = gt; i < 4096 * 96; i += gn) {
        int pos, j; float inv; float* cd; float* sd;
        if (i < 4096 * 32) { pos = i >> 5; j = i & 31; inv = exp2f(-(float)j * (13.287712379549449f / 32.f)); cd = cosA + i; sd = sinA + i; }
        else { const int i2 = i - 4096 * 32; pos = i2 >> 6; j = i2 & 63; inv = exp2f(-(float)j * (13.287712379549449f / 64.f)); cd = cosC + i2; sd = sinC + i2; }
        double x = (double)pos * (double)inv * 0.15915494309189535;
        x -= floor(x);
        const float r = (float)(x * 6.283185307179586);
        *cd = __cosf(r); *sd = __sinf(r);
    }
    if (bid == 1) {
        float* gt = (float*)(p.ws + WS_GAIN);
        for (int i = t; i < 2 * 6 * 128; i += NTHR) {
            const int l = i / 768, w = (i % 768) >> 7, d = i & 127; float v = 0.f;
            if (w == 0) { if (d < 64) v = p.in[8][l * 64 + d]; } else if (w == 1) { if (d < 64) v = p.in[9][l * 64 + d]; }
            else if (w == 2) { if (d < 64) v = p.in[15][l * 64 + d]; } else if (w == 3) { if (d < 64) v = p.in[16][l * 64 + d]; }
            else if (w == 4) v = p.in[18][l * 128 + d]; else v = p.in[19][l * 128 + d];
            gt[i] = v;
        }
    }
    if (bid == 0 && t < 2) {
        const int l = t; float a = 0.f, b = 0.f;
        for (int i = 0; i < 64; ++i) { a += p.in[10][l * 64 + i] * p.in[11][l * 64 + i]; b += p.in[12][l * 64 + i] * p.in[13][l * 64 + i]; }
        const float lam_init = 0.8f - 0.6f * expf(-0.3f * (float)l);
        float* L = (float*)(p.ws + WS_LAM);
        L[l] = expf(a) - expf(b) + lam_init; L[2 + l] = 1.f - lam_init;
    }
}

__device__ __forceinline__ void phase_h(const Params& p, int c, int l, bf16_t* H) {
    const int wave = otid() >> 6, lane = otid() & 63;
    const int row0 = chunk_row0(c), n = chunk_rows(c);
    const float* lng = p.in[4] + l * DM;
    const float* mod_l = (const float*)(p.ws + WS_MOD) + (size_t)l * NSEQ * 3072;
    for (int row = blockIdx.x * 8 + wave; row < n; row += gridDim.x * 8) {
        const int g = row0 + row;
        const float* xr = (l == 0) ? ((g < NPROMPT) ? p.in[0] + (size_t)g * DM : p.in[1] + (size_t)(g - NPROMPT) * DM) : p.out + (size_t)g * DM;
        f32x4 v[4]; float ss = 0.f;
#pragma unroll
        for (int j = 0; j < 4; ++j) { v[j] = *(const f32x4*)(xr + j * 256 + lane * 4); ss += v[j][0] * v[j][0] + v[j][1] * v[j][1] + v[j][2] * v[j][2] + v[j][3] * v[j][3]; }
        ss = wave_sum(ss);
        const float rstd = rsqrtf(ss * (1.f / 1024.f) + EPS);
        const float* md = mod_l + (size_t)seq_of(g) * 3072;
#pragma unroll
        for (int j = 0; j < 4; ++j) {
            const int col = j * 256 + lane * 4;
            const f32x4 gg = *(const f32x4*)(lng + col), sh = *(const f32x4*)(md + col), sc = *(const f32x4*)(md + 1024 + col);
            const f32x4 h = v[j] * rstd * gg * (sc + 1.0f) + sh;
            u32x2 o; o.x = pk2(h[0], h[1]); o.y = pk2(h[2], h[3]);
            *(u32x2*)(H + (size_t)row * DM + col) = o;
        }
    }
}

__device__ __forceinline__ u32x4 pack8(const f32x4& a, const f32x4& b) { u32x4 w; w.x = pk2(a[0], a[1]); w.y = pk2(a[2], a[3]); w.z = pk2(b[0], b[1]); w.w = pk2(b[2], b[3]); return w; }
__device__ __forceinline__ float dot4(const f32x4& a) { return a[0] * a[0] + a[1] * a[1] + a[2] * a[2] + a[3] * a[3]; }

struct EpiIn {
    static constexpr bool PERM = true, AFTER_DRAIN = false;
    bf16_t* P; const float* cosA; const float* sinA; const float* cosC; const float* sinC;
    const float* gtab; int row0; LAS float* xch;
    __device__ __forceinline__ static void piece(f32x4 a, f32x4 b, float rs, const float* glo, const float* ghi, const float* cp, const float* sp, bool rope, u32x2& pa, u32x2& pb) {
        a = a * rs * *(const f32x4*)glo; b = b * rs * *(const f32x4*)ghi;
        if (rope) { const f32x4 c = *(const f32x4*)cp, sn = *(const f32x4*)sp; const f32x4 na = a * c - b * sn, nb = b * c + a * sn; a = na; b = nb; }
        pa.x = pk2(a[0], a[1]); pa.y = pk2(a[2], a[3]); pb.x = pk2(b[0], b[1]); pb.y = pk2(b[2], b[3]);
    }
    __device__ __forceinline__ void operator()(const f32x4 (&acc)[2][2][4][2], const pg8::Unit& u, int wr, int wc, int fr, int fq) const {
        const int pn = u.pn, ty = tile_type(pn);
        const int rl0 = wr * 64 + fr;
        const size_t rowg0 = (size_t)u.pm * 256 + rl0;
        if (ty == 1 || ty == 2) {
            const bool isq = (ty == 1) ? (pn < 2) : (pn < 8);
            const float* g = gtab + ((ty == 1 ? 0 : 2) + (isq ? 0 : 1)) * 128 + 8 * fq;
            const float qs = isq ? 0.125f * LOG2E : 1.f;
            bf16_t* pb = P + rowg0 * NIN + pn * 256 + 64 * wc + 8 * fq;
#pragma unroll
            for (int ai = 0; ai < 2; ++ai)
#pragma unroll
                for (int m = 0; m < 4; ++m) {
                    float ss = dot4(acc[ai][0][m][0]) + dot4(acc[ai][0][m][1]) + dot4(acc[ai][1][m][0]) + dot4(acc[ai][1][m][1]);
                    ss += __shfl_xor(ss, 16); ss += __shfl_xor(ss, 32);
                    const float rs = rsqrtf(ss * (1.f / 64.f) + EPS) * qs;
                    const int roff = ai * 128 + m * 16;
                    const int gq = row0 + (int)rowg0 + roff; const int pos = gq & (seq_len_of(gq) - 1);
                    const float* cp = cosA + pos * 32 + 8 * fq; const float* sp = sinA + pos * 32 + 8 * fq;
                    u32x2 pa0, pb0, pa1, pb1;
                    piece(acc[ai][0][m][0], acc[ai][1][m][0], rs, g, g + 32, cp, sp, ty == 1, pa0, pb0);
                    piece(acc[ai][0][m][1], acc[ai][1][m][1], rs, g + 4, g + 36, cp + 4, sp + 4, ty == 1, pa1, pb1);
                    *(u32x4*)(pb + (size_t)roff * NIN) = (u32x4){pa0.x, pa0.y, pa1.x, pa1.y};
                    *(u32x4*)(pb + (size_t)roff * NIN + 32) = (u32x4){pb0.x, pb0.y, pb1.x, pb1.y};
                    __builtin_amdgcn_sched_barrier(0);
                }
        } else if (ty == 3) {
            const bool isq = pn < 18;
            const float qs = isq ? 0.08838834764831845f * LOG2E : 1.f;
            const int hh = wc >> 1, w0 = wc & 1;
#pragma unroll
            for (int ai = 0; ai < 2; ++ai)
#pragma unroll
                for (int m = 0; m < 4; ++m) {
                    float ss = dot4(acc[ai][0][m][0]) + dot4(acc[ai][0][m][1]) + dot4(acc[ai][1][m][0]) + dot4(acc[ai][1][m][1]);
                    ss += __shfl_xor(ss, 16); ss += __shfl_xor(ss, 32);
                    if (fq == 0) xch[(ai * 128 + m * 16 + rl0) * 4 + wc] = ss;
                    __builtin_amdgcn_sched_barrier(0);
                }
            __syncthreads();
            const int dlo = 32 * w0 + 8 * fq;
            const float* g = gtab + (isq ? 4 : 5) * 128 + dlo;
            bf16_t* pb = P + rowg0 * NIN + pn * 256 + 128 * hh + dlo;
#pragma unroll
            for (int ai = 0; ai < 2; ++ai)
#pragma unroll
                for (int m = 0; m < 4; ++m) {
                    const int roff = ai * 128 + m * 16;
                    const f32x2 t2 = *(LAS const f32x2*)(xch + (roff + rl0) * 4 + 2 * hh);
                    const float rs = rsqrtf((t2[0] + t2[1]) * (1.f / 128.f) + EPS) * qs;
                    const int gq = row0 + (int)rowg0 + roff; const int pos = gq & (seq_len_of(gq) - 1);
                    const float* cp = cosC + pos * 64 + dlo; const float* sp = sinC + pos * 64 + dlo;
                    u32x2 pa0, pb0, pa1, pb1;
                    piece(acc[ai][0][m][0], acc[ai][1][m][0], rs, g, g + 64, cp, sp, true, pa0, pb0);
                    piece(acc[ai][0][m][1], acc[ai][1][m][1], rs, g + 4, g + 68, cp + 4, sp + 4, true, pa1, pb1);
                    *(u32x4*)(pb + (size_t)roff * NIN) = (u32x4){pa0.x, pa0.y, pa1.x, pa1.y};
                    *(u32x4*)(pb + (size_t)roff * NIN + 64) = (u32x4){pb0.x, pb0.y, pb1.x, pb1.y};
                    __builtin_amdgcn_sched_barrier(0);
                }
        } else {
            bf16_t* pb = P + rowg0 * NIN + pn * 256 + 32 * wc + 8 * fq;
#pragma unroll
            for (int ai = 0; ai < 2; ++ai)
#pragma unroll
                for (int m = 0; m < 4; ++m)
#pragma unroll
                    for (int bj = 0; bj < 2; ++bj) {
                        f32x4 v0 = acc[ai][bj][m][0], v1 = acc[ai][bj][m][1];
                        if (ty == 4) {
#pragma unroll
                            for (int e = 0; e < 4; ++e) { v0[e] = siluf_(v0[e]); v1[e] = siluf_(v1[e]); }
                        } else if (ty == 5) {
#pragma unroll
                            for (int e = 0; e < 4; ++e) { v0[e] = sigmoidf_(v0[e]); v1[e] = sigmoidf_(v1[e]); }
                        }
                        *(u32x4*)(pb + (size_t)(ai * 128 + m * 16) * NIN + bj * 128) = pack8(v0, v1);
                        __builtin_amdgcn_sched_barrier(0);
                    }
        }
    }
};

struct BrOrder {
    int G, c, ntile;
    __device__ __forceinline__ bool next(int i, pg8::Unit& u) const {
        const int tk = i / 3, br = i - 3 * tk, tile = c + tk * G; if (tile >= ntile) return false;
        u.pm = (tile >> 2) + br * (TCMAX / 256); u.pn = (tile & 3) + br * 4; return true;
    }
    __device__ __forceinline__ void a_ready(const pg8::Unit&) const {}
    __device__ __forceinline__ void done(const pg8::Unit&) const {}
};

struct EpiBr {
    static constexpr bool PERM = true, AFTER_DRAIN = false;
    bf16_t* P;
    __device__ __forceinline__ void operator()(const f32x4 (&acc)[2][2][4][2], const pg8::Unit& u, int wr, int wc, int fr, int fq) const {
        const int br = u.pm >> 7, pm = u.pm & 127, pn = u.pn & 3;
        const size_t row0 = (size_t)pm * 256 + wr * 64 + fr; const int col0 = pn * 256 + 32 * wc + 8 * fq;
#pragma unroll
        for (int ai = 0; ai < 2; ++ai)
#pragma unroll
            for (int m = 0; m < 4; ++m)
#pragma unroll
                for (int bj = 0; bj < 2; ++bj) {
                    const size_t row = row0 + ai * 128 + m * 16; const int col = col0 + bj * 128;
                    const u32x4 sg = *(const u32x4*)(P + row * NIN + COL_G + br * 1024 + col);
                    f32x4 v0 = acc[ai][bj][m][0], v1 = acc[ai][bj][m][1];
                    v0[0] *= bflo(sg.x); v0[1] *= bfhi(sg.x); v0[2] *= bflo(sg.y); v0[3] *= bfhi(sg.y);
                    v1[0] *= bflo(sg.z); v1[1] *= bfhi(sg.z); v1[2] *= bflo(sg.w); v1[3] *= bfhi(sg.w);
                    float* mt = (float*)(P + row * NIN + 1024) + col;
                    if (br > 0) { v0 += *(const f32x4*)mt; v1 += *(const f32x4*)(mt + 4); }
                    if (br < 2) { *(f32x4*)mt = v0; *(f32x4*)(mt + 4) = v1; }
                    else *(u32x4*)(P + row * NIN + col) = pack8(v0, v1);
                }
    }
};

struct EpiOut {
    static constexpr bool PERM = true, AFTER_DRAIN = false;
    const float* xp; const float* xs; float* out; const float* mod_l; int row0, layer;
    __device__ __forceinline__ void operator()(const f32x4 (&acc)[2][2][4][2], const pg8::Unit& u, int wr, int wc, int fr, int fq) const {
        const int g0 = row0 + u.pm * 256 + wr * 64 + fr; const int col0 = u.pn * 256 + 32 * wc + 8 * fq;
#pragma unroll
        for (int ai = 0; ai < 2; ++ai)
#pragma unroll
            for (int m = 0; m < 4; ++m) {
                const int g = g0 + ai * 128 + m * 16;
                const float* gt = mod_l + (size_t)seq_of(g) * 3072 + 2048;
                const float* xr = (layer == 0) ? ((g < NPROMPT) ? xp + (size_t)g * DM : xs + (size_t)(g - NPROMPT) * DM) : out + (size_t)g * DM;
                float* orow = out + (size_t)g * DM;
#pragma unroll
                for (int bj = 0; bj < 2; ++bj) {
                    const int col = col0 + bj * 128;
                    const f32x4 g0v = *(const f32x4*)(gt + col), g1v = *(const f32x4*)(gt + col + 4);
                    const f32x4 x0 = *(const f32x4*)(xr + col), x1 = *(const f32x4*)(xr + col + 4);
                    *(f32x4*)(orow + col) = x0 + g0v * acc[ai][bj][m][0];
                    *(f32x4*)(orow + col + 4) = x1 + g1v * acc[ai][bj][m][1];
                }
            }
    }
};

struct AttnCtx { const bf16_t* P; bf16_t* T; bf16_t* OC; float* LSE; const float* subln; const float* rpb; float lam, oml; int row0, n; };

__device__ __forceinline__ int crow(int i, int h) { return (i & 3) + 8 * (i >> 2) + 4 * h; }
__device__ __forceinline__ s16x4 vtr(LAS const unsigned char* p) { return __builtin_bit_cast(s16x4, __builtin_amdgcn_ds_read_tr16_b64_v4i16((LAS v4i16_t*)p)); }
#define MFMA32(a, b, c) __builtin_amdgcn_mfma_f32_32x32x16_bf16((a), (b), (c), 0, 0, 0)
#define DS_TR16(dst, addr, off) asm volatile("ds_read_b64_tr_b16 %0, %1 offset:%c2" : "=&v"(dst) : "v"(addr), "i"(off) : "memory")
#define DS_RD128(dst, addr, off) asm volatile("ds_read_b128 %0, %1 offset:%c2" : "=&v"(dst) : "v"(addr), "i"(off) : "memory")
#define LGKM0() asm volatile("s_waitcnt lgkmcnt(0)" ::: "memory")
#define SBAR() __builtin_amdgcn_sched_barrier(0)
__device__ __forceinline__ float max3f(float a, float b, float c) { float r; asm("v_max3_f32 %0, %1, %2, %3" : "=v"(r) : "v"(a), "v"(b), "v"(c)); return r; }
__device__ __forceinline__ void wait_vm(int n) {
    switch (n) {
#define WV(k) case k: asm volatile("s_waitcnt vmcnt(" #k ")" ::: "memory"); break;
        WV(1) WV(2) WV(3) WV(4) WV(5) WV(6) WV(7) WV(8) WV(9) WV(10) WV(12) WV(14) WV(15) WV(16) WV(18) WV(20)
#undef WV
        default: asm volatile("s_waitcnt vmcnt(0)" ::: "memory"); break;
    }
}

template <int DQK, int DV, int MODE>
__device__ __forceinline__ void attn_item(LAS unsigned char* lds, int item, const AttnCtx& cx) {
    constexpr int KP = DQK * 2 + 16, VP = DV * 2 + 64, KBY = 64 * KP, VBY = 64 * VP, HB = KBY + VBY;
    constexpr int NQF = DQK / 16, NDV = DV / 32, NKP = DQK / 32, NVP = DV / 32, KPR = DQK / 8, VPR = DV / 8;
    const int tid = otid(), lane = tid & 63, wave = __builtin_amdgcn_readfirstlane(tid >> 6), hf = wave >> 2, wq = wave & 3, r = lane & 31, h = lane >> 5, th = tid & 255;
    const bf16_t* __restrict__ P = cx.P;
    int head, tok0, seqbase, qcol, kcol, vcol, ntiles, qtok, S;
    int na_rows = 0, na_rs0 = 0, na_rq = 0, na_cq = 0, na_rsq = 0, na_csq = 0;
    int c_dlog = 0, c_rho = 0, c_l0 = 0, c_L = 0, c_lq = 0;
    if (MODE == 0) {
        head = item & 3; tok0 = (item >> 2) * 128; S = seq_len_of(cx.row0 + tok0); seqbase = ((cx.row0 + tok0) & ~(S - 1)) - cx.row0;
        qcol = COL_A_Q + head * 128 + hf * 64; kcol = COL_A_K + head * 128 + hf * 64; vcol = COL_A_V + head * 128; ntiles = S >> 6;
        qtok = tok0 + 32 * wq + r;
    } else if (MODE == 1) {
        const int unit = item * 2 + hf; head = unit & 7; tok0 = (unit >> 3) * 128; S = seq_len_of(cx.row0 + tok0); seqbase = ((cx.row0 + tok0) & ~(S - 1)) - cx.row0;
        qcol = COL_B_Q + head * 64; kcol = COL_B_K + head * 64; vcol = COL_B_V + head * 64; ntiles = 9;
        qtok = tok0 + 32 * wq + r;
        na_rows = S >> 6; const int r0 = (tok0 - seqbase) >> 6; na_rs0 = min(max(r0 - 4, 0), na_rows - 8);
        na_rq = r0 + (wq >> 1); na_cq = 32 * (wq & 1) + r; na_rsq = min(max(na_rq - 4, 0), na_rows - 8); na_csq = min(max(na_cq - 8, 0), 48);
    } else {
        const int unit = item * 2 + hf; head = unit % 12; const int blk = unit / 12; tok0 = blk * 128; S = seq_len_of(cx.row0 + tok0); seqbase = ((cx.row0 + tok0) & ~(S - 1)) - cx.row0;
        qcol = COL_C_Q + head * 128; kcol = COL_C_K + head * 128; vcol = COL_C_V + head * 128; ntiles = 4;
        c_dlog = 2 * (head >> 2); const int b = (tok0 - seqbase) >> 7; c_rho = b & ((1 << c_dlog) - 1); c_l0 = (b >> c_dlog) * 128; c_L = S >> c_dlog;
        c_lq = c_l0 + 32 * wq + r; qtok = seqbase + (c_lq << c_dlog) + c_rho;
    }
    auto ktok = [&](int j, int kr) -> int {
        if (MODE == 0) return seqbase + 64 * j + kr;
        if (MODE == 1) return seqbase + min(na_rs0 + j, na_rows - 1) * 64 + kr;
        const int lk = min(max(c_l0 - 64 + 64 * j + kr, 0), c_L - 1); return seqbase + (lk << c_dlog) + c_rho;
    };
    const bool loadV = !(MODE == 0 && hf == 1);
    constexpr int NST = (MODE == 0) ? 4 : ((MODE == 1) ? 3 : 2);
    constexpr bool LAGOK = (MODE != 2);
    constexpr int DIST = LAGOK ? NST - 2 : NST - 1;
    const bool lag = LAGOK && (hf == 1);
    constexpr int SB = (MODE == 0) ? (2 * KBY + VBY) : (2 * HB);
    constexpr int KCH = KBY / 1024, VCH = VBY / 1024, LPWMAX = (KCH + VCH + 3) / 4;
    static_assert(KBY % 1024 == 0 && VBY % 1024 == 0 && NST * SB + (MODE == 1 ? 4096 : 0) <= LDS_BYTES - 16, "attention LDS ring");
    const int koff = (MODE == 0) ? hf * KBY : hf * HB, voff = (MODE == 0) ? 2 * KBY : hf * HB + KBY;
    const int nchh = KCH + (loadV ? VCH : 0);
    const int n_w = (nchh - wq + 3) >> 2;
    auto issue = [&](int j) {
        const int sbase = (j % NST) * SB;
#pragma unroll
        for (int i = 0; i < LPWMAX; ++i) {
            const int cid = wq + 4 * i;
            if (cid < nchh) {
                const bool isv = cid >= KCH; const int lc = isv ? cid - KCH : cid;
                const int pc = lc * 64 + lane, ppr = isv ? VP / 16 : KP / 16, row = pc / ppr, cp = pc - row * ppr;
                if (cp < (isv ? DV / 8 : DQK / 8)) {
                    const bf16_t* src = P + (size_t)ktok(j, row) * NIN + (isv ? vcol : kcol) + cp * 8;
                    __builtin_amdgcn_global_load_lds((const unsigned*)src, (LAS unsigned*)(lds + sbase + (isv ? voff : koff) + lc * 1024), 16, 0, 0);
                }
            }
        }
    };
    LAS float* biasL = (LAS float*)(lds + NST * SB) + hf * 512;
#pragma unroll
    for (int j0 = 0; j0 < DIST; ++j0) if (j0 < ntiles) issue(j0);
    bf16x8 qf[NQF];
#pragma unroll
    for (int ks = 0; ks < NQF; ++ks) qf[ks] = *(const bf16x8*)(P + (size_t)qtok * NIN + qcol + 16 * ks + 8 * h);
    if (MODE == 1) { for (int i = th; i < 465; i += 256) biasL[i] = cx.rpb[head * 465 + i] * LOG2E; }
    f32x16 O[NDV];
#pragma unroll
    for (int d = 0; d < NDV; ++d)
#pragma unroll
        for (int i = 0; i < 16; ++i) O[d][i] = 0.f;
    float mhat = 0.f; bool first = true;
    f32x16 negm, Lacc;
#pragma unroll
    for (int i = 0; i < 16; ++i) { negm[i] = 0.f; Lacc[i] = 0.f; }
    const bf16x8 ones8 = {(short)0x3F80, (short)0x3F80, (short)0x3F80, (short)0x3F80, (short)0x3F80, (short)0x3F80, (short)0x3F80, (short)0x3F80};
    constexpr float THR = 6.f;
#pragma unroll
    for (int ks = 0; ks < NQF; ++ks) asm volatile("" : "+v"(qf[ks]));
    if (MODE == 1) __syncthreads();
    const int q4 = (lane & 15) >> 2, p4 = lane & 3, rblk = (lane >> 4) & 1;
    bf16x8 pa[2][2];
    s16x4 vlo[2][4], vhi[2][4];
#define V_ISSUE(va, b, d) do { _Pragma("unroll") for (int k4 = 0; k4 < 4; ++k4) { DS_TR16(vlo[b][k4], va, (16 * k4) * VP + (d) * 64); DS_TR16(vhi[b][k4], va, (16 * k4 + 8) * VP + (d) * 64); } } while (0)
    auto do_pv = [&](unsigned va, bool preissued) {
        if (!preissued) V_ISSUE(va, 0, 0);
#pragma unroll
        for (int k4 = 0; k4 < 4; ++k4) Lacc = MFMA32(ones8, pa[k4 >> 1][k4 & 1], Lacc);
#pragma unroll
        for (int d = 0; d < NDV; ++d) {
            LGKM0(); SBAR();
#pragma unroll
            for (int k4 = 0; k4 < 4; ++k4) {
                const bf16x8 vf = __builtin_shufflevector(vlo[d & 1][k4], vhi[d & 1][k4], 0, 1, 2, 3, 4, 5, 6, 7);
                O[d] = MFMA32(vf, pa[k4 >> 1][k4 & 1], O[d]);
            }
            SBAR();
            if (d + 1 < NDV) V_ISSUE(va, (d + 1) & 1, d + 1);
        }
    };
    bool pv_pending = false; unsigned pv_va = 0u;
    for (int j = 0; j < ntiles; ++j) {
        wait_vm(n_w * min(DIST - 1, ntiles - 1 - j));
        __builtin_amdgcn_s_barrier();
        SBAR();
        if (j + DIST < ntiles) issue(j + DIST);
        if (pv_pending) { do_pv(pv_va, false); pv_pending = false; }
        bool active = true;
        if (MODE == 1) { const int rk = na_rs0 + j; active = (rk >= na_rsq) && (rk < na_rsq + 8); }
        if (MODE == 2) { const int lk0 = c_l0 - 64 + 64 * j; active = ((wq < 2) ? (j <= 2) : (j >= 1)) && (lk0 + 63 >= 0) && (lk0 < c_L); }
        if (active) {
            LAS const unsigned char* Kb = lds + (j % NST) * SB + koff;
            LAS const unsigned char* Vb = lds + (j % NST) * SB + voff;
            f32x16 s0, s1;
            const unsigned kaddr = (unsigned)(size_t)Kb + r * KP + 16 * h;
            const unsigned vaddr = (unsigned)(size_t)Vb + (4 * h + q4) * VP + (16 * rblk + 4 * p4) * 2;
            bf16x8 kfr[2][4];
#define K_ISSUE(b, kb) do { DS_RD128(kfr[b][0], kaddr, (2 * (kb)) * 32); DS_RD128(kfr[b][1], kaddr, 32 * KP + (2 * (kb)) * 32); \
                            DS_RD128(kfr[b][2], kaddr, (2 * (kb) + 1) * 32); DS_RD128(kfr[b][3], kaddr, 32 * KP + (2 * (kb) + 1) * 32); } while (0)
            K_ISSUE(0, 0);
#pragma unroll
            for (int kb = 0; kb < NQF / 2; ++kb) {
                LGKM0(); SBAR();
                if (kb == 0) { s0 = MFMA32(kfr[0][0], qf[0], negm); s1 = MFMA32(kfr[0][1], qf[0], negm); }
                else { s0 = MFMA32(kfr[kb & 1][0], qf[2 * kb], s0); s1 = MFMA32(kfr[kb & 1][1], qf[2 * kb], s1); }
                s0 = MFMA32(kfr[kb & 1][2], qf[2 * kb + 1], s0); s1 = MFMA32(kfr[kb & 1][3], qf[2 * kb + 1], s1);
                SBAR();
                if (kb + 1 < NQF / 2) K_ISSUE((kb + 1) & 1, kb + 1); else if (!lag) V_ISSUE(vaddr, 0, 0);
            }
            if (MODE == 1) {
                const int rk = na_rs0 + j; const int bbase = (rk - na_rq + 7) * 31 + 15 - na_cq;
#pragma unroll
                for (int i = 0; i < 16; ++i) {
                    const int ck0 = crow(i, h), ck1 = ck0 + 32;
                    const bool v0 = (ck0 >= na_csq) && (ck0 < na_csq + 16), v1 = (ck1 >= na_csq) && (ck1 < na_csq + 16);
                    const float b0 = biasL[v0 ? bbase + ck0 : 0], b1 = biasL[v1 ? bbase + ck1 : 0];
                    s0[i] = v0 ? s0[i] + b0 : NEGBIG; s1[i] = v1 ? s1[i] + b1 : NEGBIG;
                }
            }
            if (MODE == 2) {
                const int lk0 = c_l0 - 64 + 64 * j;
#pragma unroll
                for (int i = 0; i < 16; ++i) {
                    const int lka = lk0 + crow(i, h), lkb = lka + 32;
                    const bool v0 = (lka >= 0) && (lka < c_L) && (abs(lka - c_lq) <= 64), v1 = (lkb >= 0) && (lkb < c_L) && (abs(lkb - c_lq) <= 64);
                    s0[i] = v0 ? s0[i] : NEGBIG; s1[i] = v1 ? s1[i] : NEGBIG;
                }
            }
            float mx = max3f(s0[0], s1[0], s0[1]);
            mx = max3f(mx, s1[1], s0[2]);
#pragma unroll
            for (int i = 2; i < 15; ++i) mx = max3f(mx, s1[i], s0[i + 1]);
            mx = fmaxf(mx, s1[15]);
            { auto rr = __builtin_amdgcn_permlane32_swap(__float_as_uint(mx), __float_as_uint(mx), false, false); mx = max3f(__uint_as_float(rr[0]), __uint_as_float(rr[1]), __uint_as_float(rr[0])); }
            if (first || __builtin_amdgcn_ballot_w64(mx > THR) != 0ull) {
                const float delta = first ? mx : fmaxf(mx, 0.f), alpha = fast_exp2(-delta);
#pragma unroll
                for (int i = 0; i < 16; ++i) { s0[i] -= delta; s1[i] -= delta; }
                if (!first) {
#pragma unroll
                    for (int d = 0; d < NDV; ++d)
#pragma unroll
                        for (int i = 0; i < 16; ++i) O[d][i] *= alpha;
#pragma unroll
                    for (int i = 0; i < 16; ++i) Lacc[i] *= alpha;
                }
                mhat += delta;
#pragma unroll
                for (int i = 0; i < 16; ++i) negm[i] = -mhat;
                first = false;
            }
#pragma unroll
            for (int i = 0; i < 16; ++i) { s0[i] = fast_exp2(s0[i]); s1[i] = fast_exp2(s1[i]); }
            { u32x4 w;
              w.x = pk2(s0[0], s0[1]); w.y = pk2(s0[2], s0[3]); w.z = pk2(s0[4], s0[5]); w.w = pk2(s0[6], s0[7]); pa[0][0] = __builtin_bit_cast(bf16x8, w);
              w.x = pk2(s0[8], s0[9]); w.y = pk2(s0[10], s0[11]); w.z = pk2(s0[12], s0[13]); w.w = pk2(s0[14], s0[15]); pa[0][1] = __builtin_bit_cast(bf16x8, w);
              w.x = pk2(s1[0], s1[1]); w.y = pk2(s1[2], s1[3]); w.z = pk2(s1[4], s1[5]); w.w = pk2(s1[6], s1[7]); pa[1][0] = __builtin_bit_cast(bf16x8, w);
              w.x = pk2(s1[8], s1[9]); w.y = pk2(s1[10], s1[11]); w.z = pk2(s1[12], s1[13]); w.w = pk2(s1[14], s1[15]); pa[1][1] = __builtin_bit_cast(bf16x8, w); }
            if (!lag) do_pv(vaddr, true); else { pv_pending = true; pv_va = vaddr; }
#undef K_ISSUE
        }
    }
    if (pv_pending) do_pv(pv_va, false);
#undef V_ISSUE
    const float lt = Lacc[0];
    const float inv = 1.f / lt;
    __syncthreads();
    if (MODE == 0) {
        LAS float* X = (LAS float*)lds;
        if (hf == 1) {
#pragma unroll
            for (int d = 0; d < NDV; ++d)
#pragma unroll
                for (int g4 = 0; g4 < 4; ++g4) {
                    f32x4 v = {O[d][4 * g4] * inv, O[d][4 * g4 + 1] * inv, O[d][4 * g4 + 2] * inv, O[d][4 * g4 + 3] * inv};
                    *(LAS f32x4*)(X + (32 * wq + r) * 132 + 32 * d + 8 * g4 + 4 * h) = v;
                }
        }
        __syncthreads();
        if (hf == 0) {
            float ss = 0.f;
#pragma unroll
            for (int d = 0; d < NDV; ++d)
#pragma unroll
                for (int g4 = 0; g4 < 4; ++g4) {
                    const f32x4 o2 = *(LAS const f32x4*)(X + (32 * wq + r) * 132 + 32 * d + 8 * g4 + 4 * h);
#pragma unroll
                    for (int e = 0; e < 4; ++e) { const float o = O[d][4 * g4 + e] * inv - cx.lam * o2[e]; O[d][4 * g4 + e] = o; ss += o * o; }
                }
            ss += __shfl_xor(ss, 32);
            const float rstd = rsqrtf(ss * (1.f / 128.f) + EPS) * cx.oml;
#pragma unroll
            for (int d = 0; d < NDV; ++d)
#pragma unroll
                for (int g4 = 0; g4 < 4; ++g4) {
                    const int dv = 32 * d + 8 * g4 + 4 * h;
                    const f32x4 gn = *(const f32x4*)(cx.subln + dv);
                    const u32x2 sz = *(const u32x2*)(P + (size_t)qtok * NIN + COL_Z + head * 128 + dv);
                    u32x2 o;
                    o.x = pk2(O[d][4 * g4] * rstd * gn[0] * bflo(sz.x), O[d][4 * g4 + 1] * rstd * gn[1] * bfhi(sz.x));
                    o.y = pk2(O[d][4 * g4 + 2] * rstd * gn[2] * bflo(sz.y), O[d][4 * g4 + 3] * rstd * gn[3] * bfhi(sz.y));
                    *(u32x2*)(cx.T + (size_t)qtok * 512 + head * 128 + dv) = o;
                }
        }
        __syncthreads();
    } else if (MODE == 1) {
#pragma unroll
        for (int d = 0; d < NDV; ++d)
#pragma unroll
            for (int g4 = 0; g4 < 4; ++g4) {
                const int dv = 32 * d + 8 * g4 + 4 * h;
                const u32x2 sz = *(const u32x2*)(P + (size_t)qtok * NIN + COL_Z + 512 + head * 64 + dv);
                u32x2 o;
                o.x = pk2(O[d][4 * g4] * inv * bflo(sz.x), O[d][4 * g4 + 1] * inv * bfhi(sz.x));
                o.y = pk2(O[d][4 * g4 + 2] * inv * bflo(sz.y), O[d][4 * g4 + 3] * inv * bfhi(sz.y));
                *(u32x2*)(cx.T + (size_t)TCMAX * 512 + (size_t)qtok * 512 + head * 64 + dv) = o;
            }
    } else {
#pragma unroll
        for (int d = 0; d < NDV; ++d)
#pragma unroll
            for (int g4 = 0; g4 < 4; ++g4) {
                const int dv = 32 * d + 8 * g4 + 4 * h;
                u32x2 o; o.x = pk2(O[d][4 * g4] * inv, O[d][4 * g4 + 1] * inv); o.y = pk2(O[d][4 * g4 + 2] * inv, O[d][4 * g4 + 3] * inv);
                *(u32x2*)(cx.OC + (size_t)qtok * 1536 + head * 128 + dv) = o;
            }
        if (h == 0) cx.LSE[(size_t)qtok * 12 + head] = mhat + __log2f(lt);
    }
}

__device__ __forceinline__ void phase_attn(LAS unsigned char* lds, const AttnCtx& cx) {
    const int G = gridDim.x, c = blockIdx.x, nb = cx.n >> 7;
    for (int it = c; it < nb * 4; it += G) attn_item<64, 128, 0>(lds, it, cx);
    for (int it = c; it < nb * 6; it += G) attn_item<128, 128, 2>(lds, it, cx);
    for (int it = c; it < nb * 4; it += G) attn_item<64, 64, 1>(lds, it, cx);
}

__device__ __forceinline__ void phase_cmix(const bf16_t* __restrict__ P, const bf16_t* __restrict__ OC, const float* __restrict__ LSE, bf16_t* T2, int n) {
#pragma unroll 4
    for (int idx = blockIdx.x * NTHR + otid(); idx < n * 64; idx += gridDim.x * NTHR) {
        const int tok = idx >> 6, c8 = idx & 63, hh = c8 >> 4, dv = (c8 & 15) * 8;
        const float l0 = LSE[(size_t)tok * 12 + hh], l1 = LSE[(size_t)tok * 12 + 4 + hh], l2 = LSE[(size_t)tok * 12 + 8 + hh];
        const float mx = fmaxf(l0, fmaxf(l1, l2));
        float w0 = fast_exp2(l0 - mx), w1 = fast_exp2(l1 - mx), w2 = fast_exp2(l2 - mx);
        const float iw = 1.f / (w0 + w1 + w2); w0 *= iw; w1 *= iw; w2 *= iw;
        const u32x4 a = *(const u32x4*)(OC + (size_t)tok * 1536 + hh * 128 + dv), b = *(const u32x4*)(OC + (size_t)tok * 1536 + (4 + hh) * 128 + dv),
                    c = *(const u32x4*)(OC + (size_t)tok * 1536 + (8 + hh) * 128 + dv), z = *(const u32x4*)(P + (size_t)tok * NIN + COL_Z + 1024 + hh * 128 + dv);
        u32x4 o;
        o.x = pk2((w0 * bflo(a.x) + w1 * bflo(b.x) + w2 * bflo(c.x)) * bflo(z.x), (w0 * bfhi(a.x) + w1 * bfhi(b.x) + w2 * bfhi(c.x)) * bfhi(z.x));
        o.y = pk2((w0 * bflo(a.y) + w1 * bflo(b.y) + w2 * bflo(c.y)) * bflo(z.y), (w0 * bfhi(a.y) + w1 * bfhi(b.y) + w2 * bfhi(c.y)) * bfhi(z.y));
        o.z = pk2((w0 * bflo(a.z) + w1 * bflo(b.z) + w2 * bflo(c.z)) * bflo(z.z), (w0 * bfhi(a.z) + w1 * bfhi(b.z) + w2 * bfhi(c.z)) * bfhi(z.z));
        o.w = pk2((w0 * bflo(a.w) + w1 * bflo(b.w) + w2 * bflo(c.w)) * bflo(z.w), (w0 * bfhi(a.w) + w1 * bfhi(b.w) + w2 * bfhi(c.w)) * bfhi(z.w));
        *(u32x4*)(T2 + (size_t)tok * 512 + hh * 128 + dv) = o;
    }
}

#define XB_TMO      128
#define XB_XCNT(j)  (256  + 64 * (j))
#define XB_XSUB(j)  (1280 + 64 * (j))
#define XB_XGEN(j)  (2304 + 64 * (j))
#define XB_TOP      3328
#define XB_TOPGEN   3392
#define XCD_BAR_WORDS 3456
#define XB_SPIN_CAP (1u << 18)

__device__ __forceinline__ unsigned xb_ld(unsigned* p)              { return __hip_atomic_load(p, __ATOMIC_RELAXED, __HIP_MEMORY_SCOPE_AGENT); }
__device__ __forceinline__ unsigned xb_add(unsigned* p, unsigned v) { return __hip_atomic_fetch_add(p, v, __ATOMIC_RELAXED, __HIP_MEMORY_SCOPE_AGENT); }
__device__ __forceinline__ unsigned xb_xcc_id() { return (unsigned)__builtin_amdgcn_s_getreg((3 << 11) | 20) & 0xFu; }
#define XB_SPIN(cond, bar) do { unsigned _sp = 0; while (cond) { __builtin_amdgcn_s_sleep(1); \
    if ((++_sp & 255u) == 0u) { if (xb_ld(&(bar)[XB_TMO])) break; if (_sp > XB_SPIN_CAP) { atomicAdd(&(bar)[XB_TMO], 1u); break; } } } } while (0)

struct XcdBarrier {
    unsigned* bar; unsigned x;
    volatile LAS unsigned* st;
};

__device__ __forceinline__ XcdBarrier xcd_barrier_post(unsigned* bar, volatile LAS unsigned* st) {
    XcdBarrier b; b.bar = bar; b.x = xb_xcc_id(); b.st = st;
    if (threadIdx.x == 0) (void)xb_add(&bar[XB_XCNT(b.x)], 1u);
    return b;
}
__device__ __forceinline__ void xcd_barrier_complete(unsigned* bar, unsigned x, unsigned& nloc, unsigned& nx) {
    const unsigned G = gridDim.x * gridDim.y * gridDim.z;
    unsigned sum, cnt, mine, sp = 0u;
    for (;;) {
        sum = 0u; cnt = 0u; mine = 0u;
#pragma unroll
        for (unsigned j = 0; j < 16; ++j) { const unsigned c = xb_ld(&bar[XB_XCNT(j)]); sum += c; cnt += (c > 0u) ? 1u : 0u; mine = (j == x) ? c : mine; }
        if (sum == G) break;
        __builtin_amdgcn_s_sleep(1);
        if ((++sp & 255u) == 0u) { if (xb_ld(&bar[XB_TMO])) break; if (sp > XB_SPIN_CAP) { atomicAdd(&bar[XB_TMO], 1u); break; } }
    }
    nloc = mine > 0u ? mine : 1u; nx = cnt > 0u ? cnt : 1u;
}

__device__ __forceinline__ void xcd_barrier(const XcdBarrier& b) {
    asm volatile("s_waitcnt vmcnt(0)" ::: "memory");
    __syncthreads();
    if (threadIdx.x == 0) {
        unsigned* bar = b.bar;
        __builtin_amdgcn_s_waitcnt(0);
        unsigned nloc = b.st[0], nx = b.st[1];
        if (nloc == 0u) { xcd_barrier_complete(bar, b.x, nloc, nx); b.st[0] = nloc; b.st[1] = nx; }
        const unsigned old = xb_add(&bar[XB_XSUB(b.x)], 1u);
        const unsigned gen = old / nloc;
        if (old + 1u == (gen + 1u) * nloc) {
            __builtin_amdgcn_fence(__ATOMIC_RELEASE, "agent");
            asm volatile("s_waitcnt vmcnt(0)" ::: "memory");
            const unsigned og = xb_add(&bar[XB_TOP], 1u);
            const unsigned tg = og / nx;
            if (og + 1u == (tg + 1u) * nx) xb_add(&bar[XB_TOPGEN], 1u);
            else XB_SPIN(xb_ld(&bar[XB_TOPGEN]) == tg, bar);
            __builtin_amdgcn_fence(__ATOMIC_ACQUIRE, "agent");
            xb_add(&bar[XB_XGEN(b.x)], 1u);
            asm volatile("s_waitcnt vmcnt(0)" ::: "memory");
        } else {
            XB_SPIN(xb_ld(&bar[XB_XGEN(b.x)]) == gen, bar);
            __builtin_amdgcn_fence(__ATOMIC_ACQUIRE, "agent");
            asm volatile("s_waitcnt vmcnt(0)" ::: "memory");
        }
    }
    __syncthreads();
}

#ifndef ONE_LAUNCH
#define ONE_LAUNCH 1
#endif

__global__ void __launch_bounds__(NTHR, 2) mega(Params p) {
    extern __shared__ __attribute__((aligned(16))) unsigned char lds_raw[];
    LAS unsigned char* lds = (LAS unsigned char*)lds_raw;
    unsigned char* ws = p.ws;
    volatile LAS unsigned* bst = (volatile LAS unsigned*)(lds + LDS_BYTES - 16);
    if (threadIdx.x < 2) bst[threadIdx.x] = 0u;
    __syncthreads();
    XcdBarrier bar; bar.bar = (unsigned*)(ws + WS_BAR); bar.x = 0; bar.st = bst;
    if (p.ph_hi - p.ph_lo > 1) bar = xcd_barrier_post((unsigned*)(ws + WS_BAR), bst);
    bf16_t* P = (bf16_t*)(ws + WS_P); bf16_t* T = (bf16_t*)(ws + WS_T); bf16_t* H = T; bf16_t* OC = (bf16_t*)(ws + WS_OC); float* LSE = (float*)(ws + WS_LSE);
    for (int ph = p.ph_lo; ph < p.ph_hi; ++ph) {
        if (ph > p.ph_lo) { if (ph == 1) cg::this_grid().sync(); else xcd_barrier(bar); }
        if (ph == 0) { phase_pre(p, lds); phase_prew(p, lds, 0); continue; }
        if (ph == 1) { phase_h(p, 0, 0, H); continue; }
        if (ph == 17) { phase_prew(p, lds, 1); phase_h(p, 0, 1, H); continue; }
        const int l = (ph > 17) ? 1 : 0, q = ph - (l ? 18 : 2), c = q / 5, k = q - c * 5;
        const int row0 = chunk_row0(c), n = chunk_rows(c);
        const float* mod_l = (const float*)(ws + WS_MOD) + (size_t)l * NSEQ * 3072;
        if (k == 0) {
            pg8::Gemm g{H, (const bf16_t*)(ws + WS_WIN), n, NIN, DM, DM};
            pg8::StaticOrder So; So.init(n, NIN, (int)gridDim.x, (int)blockIdx.x);
            EpiIn E{P, (const float*)(ws + WS_COSA), (const float*)(ws + WS_SINA), (const float*)(ws + WS_COSC), (const float*)(ws + WS_SINC),
                    (const float*)(ws + WS_GAIN) + l * 6 * 128, row0, (LAS float*)(lds + XCH_OFF)};
            pg8::gemm_phase<EpiIn, pg8::StaticOrder, true, true>(lds, g, So, E);
        } else if (k == 1) {
            const float* L = (const float*)(ws + WS_LAM);
            AttnCtx cx{P, T, OC, LSE, p.in[14] + l * 128, p.in[17] + (size_t)l * 8 * 465, L[l], L[2 + l], row0, n};
            phase_attn(lds, cx);
        } else if (k == 2) {
            phase_cmix(P, OC, LSE, T + (size_t)2 * TCMAX * 512, n);
        } else if (k == 3) {
            pg8::Gemm g{T, (const bf16_t*)(ws + WS_WBR), 3 * TCMAX, 3072, 512, 512};
            BrOrder So{(int)gridDim.x, (int)blockIdx.x, (n >> 8) * 4};
            EpiBr E{P};
            pg8::gemm_phase<EpiBr, BrOrder, true, true>(lds, g, So, E);
        } else {
            pg8::Gemm g{P, (const bf16_t*)(ws + WS_WOUT), n, DM, DM, NIN};
            pg8::StaticOrder So; So.init(n, DM, (int)gridDim.x, (int)blockIdx.x);
            EpiOut E{p.in[0], p.in[1], p.out, mod_l, row0, l};
            pg8::gemm_phase<EpiOut, pg8::StaticOrder, true, true>(lds, g, So, E);
            if (c < 2) phase_h(p, c + 1, l, H);
        }
    }
}

extern "C" void kernel_launch(void* const* d_in, const int* in_sizes, int n_in, void* d_out, int out_size, void* d_ws, size_t ws_size, hipStream_t stream) {
    static int grid = 0;
    if (grid == 0) {
        if (n_in != 22 || ws_size < WS_END) { fprintf(stderr, "kernel_launch: unexpected n_in %d / ws_size %zu (need %zu)\n", n_in, ws_size, (size_t)WS_END); grid = -1; return; }
        int dev = 0, cus = 0, per_cu = 0;
        (void)hipGetDevice(&dev); (void)hipDeviceGetAttribute(&cus, hipDeviceAttributeMultiprocessorCount, dev);
        if (hipFuncSetAttribute((const void*)mega, hipFuncAttributeMaxDynamicSharedMemorySize, LDS_BYTES) != hipSuccess) { fprintf(stderr, "kernel_launch: hipFuncSetAttribute failed\n"); grid = -1; return; }
        (void)hipOccupancyMaxActiveBlocksPerMultiprocessor(&per_cu, (const void*)mega, NTHR, LDS_BYTES);
        if (per_cu < 1) { fprintf(stderr, "kernel_launch: occupancy query says %d blocks per CU\n", per_cu); per_cu = 1; }
        (void)hipGetLastError();
        grid = cus;
    }
    if (grid < 0) return;
    Params p{};
    for (int i = 0; i < 22; ++i) p.in[i] = (const float*)d_in[i];
    p.out = (float*)d_out; p.ws = (unsigned char*)d_ws;
#if ONE_LAUNCH
    if (hipMemsetAsync((char*)d_ws + WS_BAR, 0, 16384, stream) != hipSuccess) { fprintf(stderr, "kernel_launch: memset failed\n"); return; }
    p.ph_lo = 0; p.ph_hi = NPHASE;
    void* args[] = {&p};
    hipError_t e = hipLaunchCooperativeKernel((const void*)mega, dim3(grid), dim3(NTHR), args, LDS_BYTES, stream);
    if (e != hipSuccess) fprintf(stderr, "cooperative launch failed: %s (grid %d)\n", hipGetErrorString(e), grid);
#else
    for (int ph = 0; ph < NPHASE; ++ph) {
        p.ph_lo = ph; p.ph_hi = ph + 1;
        hipLaunchKernelGGL(mega, dim3(grid), dim3(NTHR), LDS_BYTES, stream, p);
    }
#endif
}
```

```cpp
#include <hip/hip_runtime.h>
#include <hip/hip_cooperative_groups.h>
#include <cstdio>
#include <cstdint>
namespace cg = cooperative_groups;
__device__ __forceinline__ int otid() { int t = threadIdx.x; asm volatile("" : "+v"(t)); return t; }
namespace pg8 {
#define PG8_LAS __attribute__((address_space(3)))
typedef unsigned short bf16_t;
typedef short bf16x8 __attribute__((ext_vector_type(8)));
typedef float f32x4 __attribute__((ext_vector_type(4)));
typedef unsigned u32x4 __attribute__((ext_vector_type(4)));
constexpr int BM = 256, BK = 64, HALF = 128, HTB = HALF * BK * 2  , STAGE_BYTES = 8 * HTB, NXCD = 8, WGM = 8;

__host__ __device__ __forceinline__ int lds_byte(int r, int c) { const int st = (r >> 4) * 2 + (c >> 5), rr = r & 15, cc = c & 31, ob = rr * 64 + cc * 2; return st * 1024 + (ob ^ (((ob >> 9) & 1) << 5)); }
__host__ __device__ __forceinline__ void stage_rc(int b, int& R, int& C) { const int st = b / 1024, sb = b % 1024, swz = sb ^ (((sb >> 9) & 1) << 5); R = (st >> 1) * 16 + swz / 64; C = (st & 1) * 32 + (swz % 64) / 2; }
__host__ __device__ __forceinline__ int perm32(int rho) { const int n = rho >> 4, i = rho & 15; return 8 * (i >> 2) + 4 * n + (i & 3); }

struct Unit { int pm, pn; };
struct Gemm { const bf16_t* A; const bf16_t* Bt; int M, N, K, lda; };

struct StaticOrder {
    int nM, nN, nwg, G, c;
    __host__ __device__ void init(int M, int N, int G_, int c_) { nM = M / BM; nN = N / BM; nwg = nM * nN; G = G_; c = c_; }
    __host__ __device__ bool next(int i, Unit& u) const {
        const long L = (long)i * G + c; if (L >= nwg) return false;
        int wgid = (int)L; { const int q = nwg / NXCD, r = nwg % NXCD, xcd = wgid % NXCD, off = wgid / NXCD; wgid = (xcd < r ? xcd * (q + 1) : r * (q + 1) + (xcd - r) * q) + off; }
        const int nig = WGM * nN, gid = wgid / nig, fm = gid * WGM, gsz = (nM - fm) < WGM ? (nM - fm) : WGM;
        u.pm = fm + ((wgid % nig) % gsz); u.pn = (wgid % nig) / gsz; return true;
    }
    __device__ __forceinline__ void a_ready(const Unit&) const {}
    __device__ __forceinline__ void done(const Unit&) const {}
};

__device__ __forceinline__ unsigned cvt_pk_bf16(float lo, float hi) { unsigned r; asm volatile("v_cvt_pk_bf16_f32 %0, %1, %2" : "=v"(r) : "v"(lo), "v"(hi)); return r; }

template <class Epi, class Sched, bool ALIGN_EPI = false, bool SP2 = false>
__device__ __forceinline__ void gemm_phase(PG8_LAS unsigned char* lds, const Gemm g, const Sched& S, const Epi& E) {
    const int tid = otid(), wid = __builtin_amdgcn_readfirstlane(tid >> 6), lane = tid & 63, wr = wid >> 2, wc = wid & 3, fr = lane & 15, fq = lane >> 4;
    const int K = g.K, nt = K / BK;
    unsigned voffA[2], voffB[2];
#pragma unroll
    for (int i = 0; i < 2; ++i) { int R, C; stage_rc(tid * 16 + i * 8192, R, C); const int Rb = Epi::PERM ? ((R & ~31) + perm32(R & 31)) : R;
        voffA[i] = (unsigned)(R * g.lda + C) * 2u; voffB[i] = (unsigned)(Rb * K + C) * 2u; }
    const size_t kstep = (size_t)(BK * 2);
    const size_t hstep = (size_t)HALF * K * 2;
    const size_t tstep = 2 * hstep;
    const size_t hstepA = (size_t)HALF * g.lda * 2, tstepA = 2 * hstepA;
    const unsigned ldsw = (unsigned)wid * 1024u;
    const int aoff = lds_byte(wr * 64 + fr, fq * 8), boff = lds_byte(wc * 32 + fr, fq * 8);
#define PG8_SA(b, h) (((b) * 2 + (h)) * HTB)
#define PG8_SB(b, h) ((4 + (b) * 2 + (h)) * HTB)
#define PG8_STAGE(bufoff, gbase, voff) do { _Pragma("unroll") for (int _i = 0; _i < 2; ++_i) \
        __builtin_amdgcn_global_load_lds((const unsigned*)((const char*)(gbase) + (voff)[_i]), (PG8_LAS unsigned*)(lds + (bufoff) + ldsw + _i * 8192), 16, 0, 0); } while (0)
#define PG8_LDA(dst, b, h) do { _Pragma("unroll") for (int m = 0; m < 4; ++m) _Pragma("unroll") for (int k = 0; k < 2; ++k) dst[m][k] = *(const PG8_LAS bf16x8*)(lds + PG8_SA(b, h) + aoff + m * 2048 + k * 1024); } while (0)
#define PG8_LDB(dst, b, h) do { _Pragma("unroll") for (int n = 0; n < 2; ++n) _Pragma("unroll") for (int k = 0; k < 2; ++k) dst[n][k] = *(const PG8_LAS bf16x8*)(lds + PG8_SB(b, h) + boff + n * 2048 + k * 1024); } while (0)
#define PG8_MMA(ai, bj, At, Bt) do { __builtin_amdgcn_s_setprio(1); _Pragma("unroll") for (int m = 0; m < 4; ++m) _Pragma("unroll") for (int n = 0; n < 2; ++n) _Pragma("unroll") for (int k = 0; k < 2; ++k) \
        acc[ai][bj][m][n] = __builtin_amdgcn_mfma_f32_16x16x32_bf16(Bt[n][k], At[m][k], acc[ai][bj][m][n], 0, 0, 0); __builtin_amdgcn_s_setprio(0); } while (0)
#define PG8_WAIT_V(n) asm volatile("s_waitcnt vmcnt(" #n ")" ::: "memory")
#define PG8_WAIT_L(n) asm volatile("s_waitcnt lgkmcnt(" #n ")" ::: "memory")
#define PG8_BAR __builtin_amdgcn_s_barrier()
#define PG8_SCHED __builtin_amdgcn_sched_barrier(0)
    Unit cur, nxt; int ui = 0;
    if (!S.next(0, cur)) return;
    f32x4 acc[2][2][4][2];
#pragma unroll
    for (int a = 0; a < 2; ++a)
#pragma unroll
        for (int b = 0; b < 2; ++b)
#pragma unroll
            for (int m = 0; m < 4; ++m)
#pragma unroll
                for (int n = 0; n < 2; ++n) acc[a][b][m][n] = (f32x4){0.f, 0.f, 0.f, 0.f};
    bf16x8 At[4][2], B0[2][2], B1[2][2];
    const char* cA = (const char*)g.A + (size_t)cur.pm * tstepA; const char* cB = (const char*)g.Bt + (size_t)cur.pn * tstep;
    S.a_ready(cur);
    if constexpr (SP2) {
        PG8_STAGE(PG8_SB(0, 0), cB, voffB); PG8_STAGE(PG8_SB(0, 1), cB + hstep, voffB); PG8_STAGE(PG8_SA(0, 0), cA, voffA); PG8_STAGE(PG8_SA(0, 1), cA + hstepA, voffA);
        if (wr == 1) PG8_BAR;
        PG8_WAIT_V(2); PG8_BAR;
        PG8_STAGE(PG8_SB(1, 0), cB + kstep, voffB); PG8_STAGE(PG8_SA(1, 0), cA + kstep, voffA); PG8_STAGE(PG8_SB(1, 1), cB + hstep + kstep, voffB);
        PG8_WAIT_V(6); PG8_BAR;
    } else {
        PG8_STAGE(PG8_SB(0, 0), cB, voffB); PG8_STAGE(PG8_SA(0, 0), cA, voffA); PG8_STAGE(PG8_SB(0, 1), cB + hstep, voffB); PG8_STAGE(PG8_SA(0, 1), cA + hstepA, voffA);
        if (wr == 1) PG8_BAR;
        PG8_WAIT_V(4); PG8_BAR;
        PG8_STAGE(PG8_SB(1, 0), cB + kstep, voffB); PG8_STAGE(PG8_SA(1, 0), cA + kstep, voffA); PG8_STAGE(PG8_SB(1, 1), cB + hstep + kstep, voffB);
        PG8_WAIT_V(6); PG8_BAR;
    }
    for (;;) {
        const bool has_next = S.next(ui + 1, nxt);
        const char* nA = has_next ? (const char*)g.A + (size_t)nxt.pm * tstepA : cA; const char* nB = has_next ? (const char*)g.Bt + (size_t)nxt.pn * tstep : cB;
        for (int t = 0; t < nt; t += 2) {
            const bool last = (t == nt - 2);
            const char* a1 = cA + (size_t)(t + 1) * kstep;
            const char* a2 = last ? nA : cA + (size_t)(t + 2) * kstep; const char* b2 = last ? nB : cB + (size_t)(t + 2) * kstep;
            const char* a3 = a2 + kstep; const char* b3 = b2 + kstep;
            if (last && has_next) S.a_ready(nxt);
            if constexpr (SP2) {
            PG8_LDB(B0, 0, 0); PG8_LDB(B1, 0, 1); PG8_SCHED; PG8_LDA(At, 0, 0); PG8_STAGE(PG8_SA(1, 1), a1 + hstepA, voffA);
            PG8_WAIT_V(8); PG8_WAIT_L(0); PG8_BAR; PG8_MMA(0, 0, At, B0); PG8_MMA(0, 1, At, B1); PG8_BAR; PG8_SCHED;
            PG8_LDA(At, 0, 1); PG8_STAGE(PG8_SB(0, 0), b2, voffB); PG8_STAGE(PG8_SB(0, 1), b2 + hstep, voffB); PG8_STAGE(PG8_SA(0, 0), a2, voffA);
            PG8_WAIT_V(8); PG8_WAIT_L(0); PG8_BAR; PG8_MMA(1, 0, At, B0); PG8_MMA(1, 1, At, B1); PG8_BAR; PG8_SCHED;
            PG8_LDB(B0, 1, 0); PG8_LDB(B1, 1, 1); PG8_SCHED; PG8_LDA(At, 1, 0); PG8_STAGE(PG8_SA(0, 1), a2 + hstepA, voffA);
            PG8_WAIT_V(8); PG8_WAIT_L(0); PG8_BAR; PG8_MMA(0, 0, At, B0); PG8_MMA(0, 1, At, B1); PG8_BAR; PG8_SCHED;
            PG8_LDA(At, 1, 1); PG8_STAGE(PG8_SB(1, 0), b3, voffB); PG8_STAGE(PG8_SB(1, 1), b3 + hstep, voffB); PG8_STAGE(PG8_SA(1, 0), a3, voffA);
            PG8_WAIT_V(8); PG8_WAIT_L(0); PG8_BAR; PG8_MMA(1, 0, At, B0); PG8_MMA(1, 1, At, B1); PG8_BAR; PG8_SCHED;
            } else {
            PG8_LDB(B0, 0, 0); PG8_SCHED; PG8_LDA(At, 0, 0); PG8_STAGE(PG8_SA(1, 1), a1 + hstepA, voffA);
            PG8_WAIT_L(8); PG8_BAR; PG8_WAIT_L(0); PG8_MMA(0, 0, At, B0); PG8_BAR; PG8_SCHED;
            PG8_LDB(B1, 0, 1); PG8_STAGE(PG8_SB(0, 0), b2, voffB);
            PG8_BAR; PG8_WAIT_L(0); PG8_MMA(0, 1, At, B1); PG8_BAR;
            PG8_LDA(At, 0, 1); PG8_STAGE(PG8_SA(0, 0), a2, voffA);
            PG8_BAR; PG8_WAIT_L(0); PG8_MMA(1, 0, At, B0); PG8_BAR; PG8_SCHED;
            PG8_STAGE(PG8_SB(0, 1), b2 + hstep, voffB);
            PG8_WAIT_V(6); PG8_BAR; PG8_MMA(1, 1, At, B1); PG8_BAR;
            PG8_LDB(B0, 1, 0); PG8_SCHED; PG8_LDA(At, 1, 0); PG8_STAGE(PG8_SA(0, 1), a2 + hstepA, voffA);
            PG8_WAIT_L(8); PG8_BAR; PG8_WAIT_L(0); PG8_MMA(0, 0, At, B0); PG8_BAR; PG8_SCHED;
            PG8_LDB(B1, 1, 1); PG8_STAGE(PG8_SB(1, 0), b3, voffB);
            PG8_BAR; PG8_WAIT_L(0); PG8_MMA(0, 1, At, B1); PG8_BAR;
            PG8_LDA(At, 1, 1); PG8_STAGE(PG8_SA(1, 0), a3, voffA);
            PG8_BAR; PG8_WAIT_L(0); PG8_MMA(1, 0, At, B0); PG8_BAR; PG8_SCHED;
            PG8_STAGE(PG8_SB(1, 1), b3 + hstep, voffB);
            PG8_WAIT_V(6); PG8_BAR; PG8_MMA(1, 1, At, B1); PG8_BAR;
            }
        }
        if constexpr (ALIGN_EPI) { if (wr == 0) PG8_BAR; }
        if constexpr (!Epi::AFTER_DRAIN) { E(acc, cur, wr, wc, fr, fq); S.done(cur); }
        if (!has_next) break;
        if (!E.keep(cur)) {
#pragma unroll
        for (int a = 0; a < 2; ++a)
#pragma unroll
            for (int b = 0; b < 2; ++b)
#pragma unroll
                for (int m = 0; m < 4; ++m)
#pragma unroll
                    for (int n = 0; n < 2; ++n) acc[a][b][m][n] = (f32x4){0.f, 0.f, 0.f, 0.f};
        }
        cur = nxt; cA = nA; cB = nB; ++ui;
        if constexpr (ALIGN_EPI) { if (wr == 1) PG8_BAR; }
    }
    PG8_WAIT_V(0);
    if constexpr (!ALIGN_EPI) { if (wr == 0) PG8_BAR; }
    PG8_BAR;
    if constexpr (Epi::AFTER_DRAIN) { E.fused(acc, cur, wr, wc, fr, fq, lds, wid, lane); S.done(cur); }
#undef PG8_SA
#undef PG8_SB
#undef PG8_STAGE
#undef PG8_LDA
#undef PG8_LDB
#undef PG8_MMA
#undef PG8_WAIT_V
#undef PG8_WAIT_L
#undef PG8_BAR
#undef PG8_SCHED
}
}

#define LAS __attribute__((address_space(3)))
#ifndef PH_MASK
#define PH_MASK 0xFFF
#endif
#ifndef DUP_PH
#define DUP_PH -1
#endif
typedef unsigned short bf16_t;
typedef short bf16x8 __attribute__((ext_vector_type(8)));
typedef short s16x4 __attribute__((ext_vector_type(4)));
typedef short v4i16_t __attribute__((ext_vector_type(4)));
typedef float f32x2 __attribute__((ext_vector_type(2)));
typedef float f32x4 __attribute__((ext_vector_type(4)));
typedef float f32x16 __attribute__((ext_vector_type(16)));
typedef unsigned u32x2 __attribute__((ext_vector_type(2)));
typedef unsigned u32x4 __attribute__((ext_vector_type(4)));
typedef __bf16 bf16x2_t __attribute__((ext_vector_type(2)));

constexpr int DM = 1024, NIN = 12288, TCMAX = 32768, NCHUNK = 3, NSEQ = 36, NTHR = 512, NPROMPT = 16384;
__device__ __forceinline__ int chunk_row0(int c) { return c * 32768; }
__device__ __forceinline__ int chunk_rows(int c) { return c == 2 ? 16384 : 32768; }
__device__ __forceinline__ int seq_len_of(int g) { return g < NPROMPT ? 4096 : 2048; }
__device__ __forceinline__ int seq_of(int g) { return g < NPROMPT ? (g >> 12) : 4 + ((g - NPROMPT) >> 11); }
constexpr int COL_A_Q = 0, COL_A_K = 512, COL_A_V = 1024, COL_B_Q = 1536, COL_B_K = 2048, COL_B_V = 2560, COL_C_Q = 3072, COL_C_K = 4608,
              COL_C_V = 6144, COL_Z = 7680, COL_G = 9216;
constexpr float EPS = 1e-6f, LOG2E = 1.4426950408889634f, NEGBIG = -1e30f;

constexpr size_t WS_WIN = 0;
constexpr size_t WS_WBR = WS_WIN + (size_t)NIN * DM * 2;
constexpr size_t WS_WOUT = WS_WBR + 3072ull * 512 * 2;
constexpr size_t WS_MOD = WS_WOUT + (size_t)DM * DM * 2;
constexpr size_t WS_COSA = WS_MOD + 2ull * NSEQ * 3072 * 4;
constexpr size_t WS_SINA = WS_COSA + 4096ull * 32 * 4;
constexpr size_t WS_COSC = WS_SINA + 4096ull * 32 * 4;
constexpr size_t WS_SINC = WS_COSC + 4096ull * 64 * 4;
constexpr size_t WS_LAM = WS_SINC + 4096ull * 64 * 4;
constexpr size_t WS_GAIN = WS_LAM + 256;
constexpr size_t WS_BAR = WS_GAIN + 2 * 6 * 128 * 4;
constexpr size_t WS_P = WS_BAR + 16384;
constexpr size_t WS_T = WS_P + (size_t)TCMAX * NIN * 2;
constexpr size_t WS_OC = WS_T + 3ull * TCMAX * 512 * 2;
constexpr size_t WS_LSE = WS_OC + (size_t)TCMAX * 1536 * 2;
constexpr size_t WS_END = WS_LSE + (size_t)TCMAX * 12 * 4;

constexpr int LDS_BYTES = 159744;
constexpr int XCH_OFF = 131072;
constexpr int NPHASE = 2 + 15 + 1 + 15;

struct Params { const float* in[22]; float* out; unsigned char* ws; int ph_lo, ph_hi; };

__device__ __forceinline__ unsigned pk2(float lo, float hi) { f32x2 v = {lo, hi}; bf16x2_t b = __builtin_convertvector(v, bf16x2_t); return __builtin_bit_cast(unsigned, b); }
__device__ __forceinline__ float bflo(unsigned u) { return __uint_as_float(u << 16); }
__device__ __forceinline__ float bfhi(unsigned u) { return __uint_as_float(u & 0xffff0000u); }
__device__ __forceinline__ float wave_sum(float v) {
#pragma unroll
    for (int o = 32; o >= 1; o >>= 1) v += __shfl_xor(v, o);
    return v;
}
__device__ __forceinline__ float fast_exp2(float x) { return __builtin_amdgcn_exp2f(x); }
__device__ __forceinline__ float sigmoidf_(float x) { return __builtin_amdgcn_rcpf(1.f + __builtin_amdgcn_exp2f(x * -1.4426950408889634f)); }
__device__ __forceinline__ float siluf_(float x) { return x * sigmoidf_(x); }

__host__ __device__ __forceinline__ int tile_type(int pn) {
    if (pn < 4) return 1; if (pn < 6) return 0; if (pn < 10) return 2; if (pn < 12) return 0; if (pn < 24) return 3; if (pn < 30) return 0; if (pn < 36) return 4; return 5;
}
__device__ __forceinline__ int phys_row(int col) {
    const int pn = col >> 8, lc = col & 255, ty = tile_type(pn);
    if (ty == 1 || ty == 2) { const int wc = (lc >> 6) & 3, bj = (lc >> 5) & 1, rest = lc & 31; return (pn << 8) + 128 * bj + 32 * wc + rest; }
    if (ty == 3) { const int hh = lc >> 7, bj = (lc >> 6) & 1, w0 = (lc >> 5) & 1, rest = lc & 31; return (pn << 8) + 128 * bj + 32 * (2 * hh + w0) + rest; }
    return col;
}

__device__ __forceinline__ void transpose_item(const float* __restrict__ W, int K, int N, bf16_t* Bt, int kt, int nt, bool perm, LAS float* tile) {
    const int t = otid(), k0 = kt * 64, n0 = nt * 64;
#pragma unroll
    for (int i = 0; i < 8; ++i) { const int k = i * 8 + (t >> 6), n = t & 63; tile[k * 65 + n] = W[(size_t)(k0 + k) * N + n0 + n]; }
    __syncthreads();
    const int n = t >> 3, kk = (t & 7) * 8;
    u32x4 w;
    w.x = pk2(tile[(kk + 0) * 65 + n], tile[(kk + 1) * 65 + n]); w.y = pk2(tile[(kk + 2) * 65 + n], tile[(kk + 3) * 65 + n]);
    w.z = pk2(tile[(kk + 4) * 65 + n], tile[(kk + 5) * 65 + n]); w.w = pk2(tile[(kk + 6) * 65 + n], tile[(kk + 7) * 65 + n]);
    const int col = n0 + n, row = perm ? phys_row(col) : col;
    *(u32x4*)(Bt + (size_t)row * K + k0 + kk) = w;
    __syncthreads();
}

__device__ __forceinline__ void mod_item(const Params& p, int item, LAS float* sc) {
    const int l = item / 48, cb = item % 48, t = otid();
    const float* cp = p.in[2]; const float* cs = p.in[3];
    for (int i = t; i < NSEQ * 1024; i += NTHR) { const int s = i >> 10, k = i & 1023; const float c = (s < 4) ? cp[s * 1024 + k] : cs[(s - 4) * 1024 + k]; sc[i] = siluf_(c); }
    __syncthreads();
    const int col = t & 63, ks = t >> 6;
    const float* w = p.in[5] + (size_t)l * 1024 * 3072 + cb * 64 + col;
    float acc[NSEQ];
#pragma unroll
    for (int s = 0; s < NSEQ; ++s) acc[s] = 0.f;
    for (int k = ks * 128; k < ks * 128 + 128; ++k) {
        const float wv = w[(size_t)k * 3072];
#pragma unroll
        for (int s = 0; s < NSEQ; ++s) acc[s] += sc[s * 1024 + k] * wv;
    }
    __syncthreads();
#pragma unroll
    for (int s = 0; s < NSEQ; ++s) sc[(ks * NSEQ + s) * 64 + col] = acc[s];
    __syncthreads();
    float* mod = (float*)(p.ws + WS_MOD) + (size_t)l * NSEQ * 3072;
    const float* b = p.in[6] + (size_t)l * 3072;
    for (int i = t; i < NSEQ * 64; i += NTHR) {
        const int s = i >> 6, c = i & 63; float v = 0.f;
#pragma unroll
        for (int q = 0; q < 8; ++q) v += sc[(q * NSEQ + s) * 64 + c];
        mod[s * 3072 + cb * 64 + c] = v + b[cb * 64 + c];
    }
    __syncthreads();
}

__device__ __forceinline__ void phase_prew(const Params& p, LAS unsigned char* lds, int l) {
    LAS float* scr = (LAS float*)lds;
    const int G = gridDim.x, bid = blockIdx.x;
    constexpr int N_WIN = 16 * 192, N_WBR = 3 * 8 * 16, N_WOUT = 16 * 16, PER_L = N_WIN + N_WBR + N_WOUT;
    for (int item = bid; item < PER_L; item += G) {
        int it = item;
        if (it < N_WIN) { transpose_item(p.in[7] + (size_t)l * DM * NIN, DM, NIN, (bf16_t*)(p.ws + WS_WIN), it & 15, it >> 4, true, scr); }
        else if (it < N_WIN + N_WBR) { it -= N_WIN; const int br = it >> 7, r = it & 127;
            transpose_item(p.in[20] + ((size_t)l * 3 + br) * 512 * 1024, 512, 1024, (bf16_t*)(p.ws + WS_WBR) + (size_t)br * 1024 * 512, r & 7, r >> 3, false, scr); }
        else { it -= N_WIN + N_WBR; transpose_item(p.in[21] + (size_t)l * DM * DM, DM, DM, (bf16_t*)(p.ws + WS_WOUT), it & 15, it >> 4, false, scr); }
    }
}

__device__ __forceinline__ void phase_pre(const Params& p, LAS unsigned char* lds) {
    LAS float* scr = (LAS float*)lds;
    const int G = gridDim.x, bid = blockIdx.x, t = otid();
    for (int item = bid; item < 96; item += G) mod_item(p, item, scr);
    const int gt = bid * NTHR + t, gn = G * NTHR;
    float* cosA = (float*)(p.ws + WS_COSA); float* sinA = (float*)(p.ws + WS_SINA); float* cosC = (float*)(p.ws + WS_COSC); float* sinC = (float*)(p.ws + WS_SINC);
    for (int i = gt; i < 4096 * 96; i += gn) {
        int pos, j; float inv; float* cd; float* sd;
        if (i < 4096 * 32) { pos = i >> 5; j = i & 31; inv = exp2f(-(float)j * (13.287712379549449f / 32.f)); cd = cosA + i; sd = sinA + i; }
        else { const int i2 = i - 4096 * 32; pos = i2 >> 6; j = i2 & 63; inv = exp2f(-(float)j * (13.287712379549449f / 64.f)); cd = cosC + i2; sd = sinC + i2; }
        double x = (double)pos * (double)inv * 0.15915494309189535;
        x -= floor(x);
        const float r = (float)(x * 6.283185307179586);
        *cd = __cosf(r); *sd = __sinf(r);
    }
    if (bid == 1) {
        float* gt = (float*)(p.ws + WS_GAIN);
        for (int i = t; i < 2 * 6 * 128; i += NTHR) {
            const int l = i / 768, w = (i % 768) >> 7, d = i & 127; float v = 0.f;
            if (w == 0) { if (d < 64) v = p.in[8][l * 64 + d]; } else if (w == 1) { if (d < 64) v = p.in[9][l * 64 + d]; }
            else if (w == 2) { if (d < 64) v = p.in[15][l * 64 + d]; } else if (w == 3) { if (d < 64) v = p.in[16][l * 64 + d]; }
            else if (w == 4) v = p.in[18][l * 128 + d]; else v = p.in[19][l * 128 + d];
            gt[i] = v;
        }
    }
    if (bid == 0 && t < 2) {
        const int l = t; float a = 0.f, b = 0.f;
        for (int i = 0; i < 64; ++i) { a += p.in[10][l * 64 + i] * p.in[11][l * 64 + i]; b += p.in[12][l * 64 + i] * p.in[13][l * 64 + i]; }
        const float lam_init = 0.8f - 0.6f * expf(-0.3f * (float)l);
        float* L = (float*)(p.ws + WS_LAM);
        L[l] = expf(a) - expf(b) + lam_init; L[2 + l] = 1.f - lam_init;
    }
}

__device__ __forceinline__ void phase_h(const Params& p, int c, int l, bf16_t* H) {
    const int wave = otid() >> 6, lane = otid() & 63;
    const int row0 = chunk_row0(c), n = chunk_rows(c);
    const float* lng = p.in[4] + l * DM;
    const float* mod_l = (const float*)(p.ws + WS_MOD) + (size_t)l * NSEQ * 3072;
    for (int row = blockIdx.x * 8 + wave; row < n; row += gridDim.x * 8) {
        const int g = row0 + row;
        const float* xr = (l == 0) ? ((g < NPROMPT) ? p.in[0] + (size_t)g * DM : p.in[1] + (size_t)(g - NPROMPT) * DM) : p.out + (size_t)g * DM;
        f32x4 v[4]; float ss = 0.f;
#pragma unroll
        for (int j = 0; j < 4; ++j) { v[j] = *(const f32x4*)(xr + j * 256 + lane * 4); ss += v[j][0] * v[j][0] + v[j][1] * v[j][1] + v[j][2] * v[j][2] + v[j][3] * v[j][3]; }
        ss = wave_sum(ss);
        const float rstd = rsqrtf(ss * (1.f / 1024.f) + EPS);
        const float* md = mod_l + (size_t)seq_of(g) * 3072;
#pragma unroll
        for (int j = 0; j < 4; ++j) {
            const int col = j * 256 + lane * 4;
            const f32x4 gg = *(const f32x4*)(lng + col), sh = *(const f32x4*)(md + col), sc = *(const f32x4*)(md + 1024 + col);
            const f32x4 h = v[j] * rstd * gg * (sc + 1.0f) + sh;
            u32x2 o; o.x = pk2(h[0], h[1]); o.y = pk2(h[2], h[3]);
            *(u32x2*)(H + (size_t)row * DM + col) = o;
        }
    }
}

__device__ __forceinline__ u32x4 pack8(const f32x4& a, const f32x4& b) { u32x4 w; w.x = pk2(a[0], a[1]); w.y = pk2(a[2], a[3]); w.z = pk2(b[0], b[1]); w.w = pk2(b[2], b[3]); return w; }
__device__ __forceinline__ float dot4(const f32x4& a) { return a[0] * a[0] + a[1] * a[1] + a[2] * a[2] + a[3] * a[3]; }

struct EpiIn {
    static constexpr bool PERM = true, AFTER_DRAIN = false;
    bf16_t* P; const float* cosA; const float* sinA; const float* cosC; const float* sinC;
    const float* gtab; int row0; LAS float* xch;
    __device__ __forceinline__ bool keep(const pg8::Unit&) const { return false; }
    __device__ __forceinline__ static void piece(f32x4 a, f32x4 b, float rs, const float* glo, const float* ghi, const float* cp, const float* sp, bool rope, u32x2& pa, u32x2& pb) {
        a = a * rs * *(const f32x4*)glo; b = b * rs * *(const f32x4*)ghi;
        if (rope) { const f32x4 c = *(const f32x4*)cp, sn = *(const f32x4*)sp; const f32x4 na = a * c - b * sn, nb = b * c + a * sn; a = na; b = nb; }
        pa.x = pk2(a[0], a[1]); pa.y = pk2(a[2], a[3]); pb.x = pk2(b[0], b[1]); pb.y = pk2(b[2], b[3]);
    }
    __device__ __forceinline__ void operator()(const f32x4 (&acc)[2][2][4][2], const pg8::Unit& u, int wr, int wc, int fr, int fq) const {
        const int pn = u.pn, ty = tile_type(pn);
        const int rl0 = wr * 64 + fr;
        const size_t rowg0 = (size_t)u.pm * 256 + rl0;
        if (ty == 1 || ty == 2) {
            const bool isq = (ty == 1) ? (pn < 2) : (pn < 8);
            const float* g = gtab + ((ty == 1 ? 0 : 2) + (isq ? 0 : 1)) * 128 + 8 * fq;
            const float qs = isq ? 0.125f * LOG2E : 1.f;
            bf16_t* pb = P + rowg0 * NIN + pn * 256 + 64 * wc + 8 * fq;
#pragma unroll
            for (int ai = 0; ai < 2; ++ai)
#pragma unroll
                for (int m = 0; m < 4; ++m) {
                    float ss = dot4(acc[ai][0][m][0]) + dot4(acc[ai][0][m][1]) + dot4(acc[ai][1][m][0]) + dot4(acc[ai][1][m][1]);
                    ss += __shfl_xor(ss, 16); ss += __shfl_xor(ss, 32);
                    const float rs = rsqrtf(ss * (1.f / 64.f) + EPS) * qs;
                    const int roff = ai * 128 + m * 16;
                    const int gq = row0 + (int)rowg0 + roff; const int pos = gq & (seq_len_of(gq) - 1);
                    const float* cp = cosA + pos * 32 + 8 * fq; const float* sp = sinA + pos * 32 + 8 * fq;
                    u32x2 pa0, pb0, pa1, pb1;
                    piece(acc[ai][0][m][0], acc[ai][1][m][0], rs, g, g + 32, cp, sp, ty == 1, pa0, pb0);
                    piece(acc[ai][0][m][1], acc[ai][1][m][1], rs, g + 4, g + 36, cp + 4, sp + 4, ty == 1, pa1, pb1);
                    *(u32x4*)(pb + (size_t)roff * NIN) = (u32x4){pa0.x, pa0.y, pa1.x, pa1.y};
                    *(u32x4*)(pb + (size_t)roff * NIN + 32) = (u32x4){pb0.x, pb0.y, pb1.x, pb1.y};
                    __builtin_amdgcn_sched_barrier(0);
                }
        } else if (ty == 3) {
            const bool isq = pn < 18;
            const float qs = isq ? 0.08838834764831845f * LOG2E : 1.f;
            const int hh = wc >> 1, w0 = wc & 1;
#pragma unroll
            for (int ai = 0; ai < 2; ++ai)
#pragma unroll
                for (int m = 0; m < 4; ++m) {
                    float ss = dot4(acc[ai][0][m][0]) + dot4(acc[ai][0][m][1]) + dot4(acc[ai][1][m][0]) + dot4(acc[ai][1][m][1]);
                    ss += __shfl_xor(ss, 16); ss += __shfl_xor(ss, 32);
                    if (fq == 0) xch[(ai * 128 + m * 16 + rl0) * 4 + wc] = ss;
                    __builtin_amdgcn_sched_barrier(0);
                }
            __syncthreads();
            const int dlo = 32 * w0 + 8 * fq;
            const float* g = gtab + (isq ? 4 : 5) * 128 + dlo;
            bf16_t* pb = P + rowg0 * NIN + pn * 256 + 128 * hh + dlo;
#pragma unroll
            for (int ai = 0; ai < 2; ++ai)
#pragma unroll
                for (int m = 0; m < 4; ++m) {
                    const int roff = ai * 128 + m * 16;
                    const f32x2 t2 = *(LAS const f32x2*)(xch + (roff + rl0) * 4 + 2 * hh);
                    const float rs = rsqrtf((t2[0] + t2[1]) * (1.f / 128.f) + EPS) * qs;
                    const int gq = row0 + (int)rowg0 + roff; const int pos = gq & (seq_len_of(gq) - 1);
                    const float* cp = cosC + pos * 64 + dlo; const float* sp = sinC + pos * 64 + dlo;
                    u32x2 pa0, pb0, pa1, pb1;
                    piece(acc[ai][0][m][0], acc[ai][1][m][0], rs, g, g + 64, cp, sp, true, pa0, pb0);
                    piece(acc[ai][0][m][1], acc[ai][1][m][1], rs, g + 4, g + 68, cp + 4, sp + 4, true, pa1, pb1);
                    *(u32x4*)(pb + (size_t)roff * NIN) = (u32x4){pa0.x, pa0.y, pa1.x, pa1.y};
                    *(u32x4*)(pb + (size_t)roff * NIN + 64) = (u32x4){pb0.x, pb0.y, pb1.x, pb1.y};
                    __builtin_amdgcn_sched_barrier(0);
                }
        } else {
            bf16_t* pb = P + rowg0 * NIN + pn * 256 + 32 * wc + 8 * fq;
#pragma unroll
            for (int ai = 0; ai < 2; ++ai)
#pragma unroll
                for (int m = 0; m < 4; ++m)
#pragma unroll
                    for (int bj = 0; bj < 2; ++bj) {
                        f32x4 v0 = acc[ai][bj][m][0], v1 = acc[ai][bj][m][1];
                        if (ty == 4) {
#pragma unroll
                            for (int e = 0; e < 4; ++e) { v0[e] = siluf_(v0[e]); v1[e] = siluf_(v1[e]); }
                        } else if (ty == 5) {
#pragma unroll
                            for (int e = 0; e < 4; ++e) { v0[e] = sigmoidf_(v0[e]); v1[e] = sigmoidf_(v1[e]); }
                        }
                        *(u32x4*)(pb + (size_t)(ai * 128 + m * 16) * NIN + bj * 128) = pack8(v0, v1);
                        __builtin_amdgcn_sched_barrier(0);
                    }
        }
    }
};

struct BrOrder {
    int G, c, ntile;
    __device__ __forceinline__ bool next(int i, pg8::Unit& u) const {
        const int tk = i / 3, br = i - 3 * tk, tile = c + tk * G; if (tile >= ntile) return false;
        u.pm = (tile >> 2) + br * (TCMAX / 256); u.pn = (tile & 3) + br * 4; return true;
    }
    __device__ __forceinline__ void a_ready(const pg8::Unit&) const {}
    __device__ __forceinline__ void done(const pg8::Unit&) const {}
};

struct EpiBr {
    static constexpr bool PERM = true, AFTER_DRAIN = false;
    bf16_t* P;
    __device__ __forceinline__ bool keep(const pg8::Unit& u) const { return (u.pm >> 7) < 2; }
    __device__ __forceinline__ void operator()(f32x4 (&acc)[2][2][4][2], const pg8::Unit& u, int wr, int wc, int fr, int fq) const {
        const int br = u.pm >> 7, pm = u.pm & 127, pn = u.pn & 3;
        const size_t row0 = (size_t)pm * 256 + wr * 64 + fr; const int col0 = pn * 256 + 32 * wc + 8 * fq;
#pragma unroll
        for (int ai = 0; ai < 2; ++ai)
#pragma unroll
            for (int m = 0; m < 4; ++m)
#pragma unroll
                for (int bj = 0; bj < 2; ++bj) {
                    const size_t row = row0 + ai * 128 + m * 16; const int col = col0 + bj * 128;
                    const u32x4 sg = *(const u32x4*)(P + row * NIN + COL_G + br * 1024 + col);
                    f32x4 f0 = {bflo(sg.x), bfhi(sg.x), bflo(sg.y), bfhi(sg.y)}, f1 = {bflo(sg.z), bfhi(sg.z), bflo(sg.w), bfhi(sg.w)};
                    if (br < 2) {
                        const u32x4 sn = *(const u32x4*)(P + row * NIN + COL_G + (br + 1) * 1024 + col);
                        f0[0] *= __builtin_amdgcn_rcpf(bflo(sn.x)); f0[1] *= __builtin_amdgcn_rcpf(bfhi(sn.x)); f0[2] *= __builtin_amdgcn_rcpf(bflo(sn.y)); f0[3] *= __builtin_amdgcn_rcpf(bfhi(sn.y));
                        f1[0] *= __builtin_amdgcn_rcpf(bflo(sn.z)); f1[1] *= __builtin_amdgcn_rcpf(bfhi(sn.z)); f1[2] *= __builtin_amdgcn_rcpf(bflo(sn.w)); f1[3] *= __builtin_amdgcn_rcpf(bfhi(sn.w));
                        acc[ai][bj][m][0] *= f0; acc[ai][bj][m][1] *= f1;
                    } else {
                        *(u32x4*)(P + row * NIN + col) = pack8(acc[ai][bj][m][0] * f0, acc[ai][bj][m][1] * f1);
                    }
                    __builtin_amdgcn_sched_barrier(0);
                }
    }
};

struct EpiOut {
    static constexpr bool PERM = true, AFTER_DRAIN = false;
    const float* xp; const float* xs; float* out; const float* mod_l; int row0, layer;
    __device__ __forceinline__ bool keep(const pg8::Unit&) const { return false; }
    __device__ __forceinline__ void operator()(const f32x4 (&acc)[2][2][4][2], const pg8::Unit& u, int wr, int wc, int fr, int fq) const {
        const int g0 = row0 + u.pm * 256 + wr * 64 + fr; const int col0 = u.pn * 256 + 32 * wc + 8 * fq;
#pragma unroll
        for (int ai = 0; ai < 2; ++ai)
#pragma unroll
            for (int m = 0; m < 4; ++m) {
                const int g = g0 + ai * 128 + m * 16;
                const float* gt = mod_l + (size_t)seq_of(g) * 3072 + 2048;
                const float* xr = (layer == 0) ? ((g < NPROMPT) ? xp + (size_t)g * DM : xs + (size_t)(g - NPROMPT) * DM) : out + (size_t)g * DM;
                float* orow = out + (size_t)g * DM;
#pragma unroll
                for (int bj = 0; bj < 2; ++bj) {
                    const int col = col0 + bj * 128;
                    const f32x4 g0v = *(const f32x4*)(gt + col), g1v = *(const f32x4*)(gt + col + 4);
                    const f32x4 x0 = *(const f32x4*)(xr + col), x1 = *(const f32x4*)(xr + col + 4);
                    *(f32x4*)(orow + col) = x0 + g0v * acc[ai][bj][m][0];
                    *(f32x4*)(orow + col + 4) = x1 + g1v * acc[ai][bj][m][1];
                }
            }
    }
};

struct AttnCtx { const bf16_t* P; bf16_t* T; bf16_t* OC; float* LSE; const float* subln; const float* rpb; float lam, oml; int row0, n; };

__device__ __forceinline__ int crow(int i, int h) { return (i & 3) + 8 * (i >> 2) + 4 * h; }
__device__ __forceinline__ s16x4 vtr(LAS const unsigned char* p) { return __builtin_bit_cast(s16x4, __builtin_amdgcn_ds_read_tr16_b64_v4i16((LAS v4i16_t*)p)); }
#define MFMA32(a, b, c) __builtin_amdgcn_mfma_f32_32x32x16_bf16((a), (b), (c), 0, 0, 0)
#define DS_TR16(dst, addr, off) asm volatile("ds_read_b64_tr_b16 %0, %1 offset:%c2" : "=&v"(dst) : "v"(addr), "i"(off) : "memory")
#define DS_RD128(dst, addr, off) asm volatile("ds_read_b128 %0, %1 offset:%c2" : "=&v"(dst) : "v"(addr), "i"(off) : "memory")
#define LGKM0() asm volatile("s_waitcnt lgkmcnt(0)" ::: "memory")
#define SBAR() __builtin_amdgcn_sched_barrier(0)
__device__ __forceinline__ float max3f(float a, float b, float c) { float r; asm("v_max3_f32 %0, %1, %2, %3" : "=v"(r) : "v"(a), "v"(b), "v"(c)); return r; }
__device__ __forceinline__ void wait_vm(int n) {
    switch (n) {
#define WV(k) case k: asm volatile("s_waitcnt vmcnt(" #k ")" ::: "memory"); break;
        WV(1) WV(2) WV(3) WV(4) WV(5) WV(6) WV(7) WV(8) WV(9) WV(10) WV(12) WV(14) WV(15) WV(16) WV(18) WV(20)
#undef WV
        default: asm volatile("s_waitcnt vmcnt(0)" ::: "memory"); break;
    }
}

template <int DQK, int DV, int MODE>
__device__ __forceinline__ void attn_item(LAS unsigned char* lds, int item, const AttnCtx& cx) {
    constexpr int KP = DQK * 2 + 16, VP = DV * 2 + 64, KBY = 64 * KP, VBY = 64 * VP, HB = KBY + VBY;
    constexpr int NQF = DQK / 16, NDV = DV / 32, NKP = DQK / 32, NVP = DV / 32, KPR = DQK / 8, VPR = DV / 8;
    const int tid = otid(), lane = tid & 63, wave = __builtin_amdgcn_readfirstlane(tid >> 6), hf = wave >> 2, wq = wave & 3, r = lane & 31, h = lane >> 5, th = tid & 255;
    const bf16_t* __restrict__ P = cx.P;
    int head, tok0, seqbase, qcol, kcol, vcol, ntiles, qtok, S;
    int na_rows = 0, na_rs0 = 0, na_rq = 0, na_cq = 0, na_rsq = 0, na_csq = 0;
    int c_dlog = 0, c_rho = 0, c_l0 = 0, c_L = 0, c_lq = 0;
    if (MODE == 0) {
        head = item & 3; tok0 = (item >> 2) * 128; S = seq_len_of(cx.row0 + tok0); seqbase = ((cx.row0 + tok0) & ~(S - 1)) - cx.row0;
        qcol = COL_A_Q + head * 128 + hf * 64; kcol = COL_A_K + head * 128 + hf * 64; vcol = COL_A_V + head * 128; ntiles = S >> 6;
        qtok = tok0 + 32 * wq + r;
    } else if (MODE == 1) {
        const int unit = item * 2 + hf; head = unit & 7; tok0 = (unit >> 3) * 128; S = seq_len_of(cx.row0 + tok0); seqbase = ((cx.row0 + tok0) & ~(S - 1)) - cx.row0;
        qcol = COL_B_Q + head * 64; kcol = COL_B_K + head * 64; vcol = COL_B_V + head * 64; ntiles = 9;
        qtok = tok0 + 32 * wq + r;
        na_rows = S >> 6; const int r0 = (tok0 - seqbase) >> 6; na_rs0 = min(max(r0 - 4, 0), na_rows - 8);
        na_rq = r0 + (wq >> 1); na_cq = 32 * (wq & 1) + r; na_rsq = min(max(na_rq - 4, 0), na_rows - 8); na_csq = min(max(na_cq - 8, 0), 48);
    } else {
        const int unit = item * 2 + hf; head = unit % 12; const int blk = unit / 12; tok0 = blk * 128; S = seq_len_of(cx.row0 + tok0); seqbase = ((cx.row0 + tok0) & ~(S - 1)) - cx.row0;
        qcol = COL_C_Q + head * 128; kcol = COL_C_K + head * 128; vcol = COL_C_V + head * 128; ntiles = 4;
        c_dlog = 2 * (head >> 2); const int b = (tok0 - seqbase) >> 7; c_rho = b & ((1 << c_dlog) - 1); c_l0 = (b >> c_dlog) * 128; c_L = S >> c_dlog;
        c_lq = c_l0 + 32 * wq + r; qtok = seqbase + (c_lq << c_dlog) + c_rho;
    }
    auto ktok = [&](int j, int kr) -> int {
        if (MODE == 0) return seqbase + 64 * j + kr;
        if (MODE == 1) return seqbase + min(na_rs0 + j, na_rows - 1) * 64 + kr;
        const int lk = min(max(c_l0 - 64 + 64 * j + kr, 0), c_L - 1); return seqbase + (lk << c_dlog) + c_rho;
    };
    const bool loadV = !(MODE == 0 && hf == 1);
    constexpr int NST = (MODE == 0) ? 4 : ((MODE == 1) ? 3 : 2);
    constexpr bool LAGOK = (MODE != 2);
    constexpr int DIST = LAGOK ? NST - 2 : NST - 1;
    const bool lag = LAGOK && (hf == 1);
    constexpr int SB = (MODE == 0) ? (2 * KBY + VBY) : (2 * HB);
    constexpr int KCH = KBY / 1024, VCH = VBY / 1024, LPWMAX = (KCH + VCH + 3) / 4;
    static_assert(KBY % 1024 == 0 && VBY % 1024 == 0 && NST * SB + (MODE == 1 ? 4096 : 0) <= LDS_BYTES - 16, "attention LDS ring");
    const int koff = (MODE == 0) ? hf * KBY : hf * HB, voff = (MODE == 0) ? 2 * KBY : hf * HB + KBY;
    const int nchh = KCH + (loadV ? VCH : 0);
    const int n_w = (nchh - wq + 3) >> 2;
    auto issue = [&](int j) {
        const int sbase = (j % NST) * SB;
#pragma unroll
        for (int i = 0; i < LPWMAX; ++i) {
            const int cid = wq + 4 * i;
            if (cid < nchh) {
                const bool isv = cid >= KCH; const int lc = isv ? cid - KCH : cid;
                const int pc = lc * 64 + lane, ppr = isv ? VP / 16 : KP / 16, row = pc / ppr, cp = pc - row * ppr;
                if (cp < (isv ? DV / 8 : DQK / 8)) {
                    const bf16_t* src = P + (size_t)ktok(j, row) * NIN + (isv ? vcol : kcol) + cp * 8;
                    __builtin_amdgcn_global_load_lds((const unsigned*)src, (LAS unsigned*)(lds + sbase + (isv ? voff : koff) + lc * 1024), 16, 0, 0);
                }
            }
        }
    };
    LAS float* biasL = (LAS float*)(lds + NST * SB) + hf * 512;
#pragma unroll
    for (int j0 = 0; j0 < DIST; ++j0) if (j0 < ntiles) issue(j0);
    bf16x8 qf[NQF];
#pragma unroll
    for (int ks = 0; ks < NQF; ++ks) qf[ks] = *(const bf16x8*)(P + (size_t)qtok * NIN + qcol + 16 * ks + 8 * h);
    if (MODE == 1) { for (int i = th; i < 465; i += 256) biasL[i] = cx.rpb[head * 465 + i] * LOG2E; }
    f32x16 O[NDV];
#pragma unroll
    for (int d = 0; d < NDV; ++d)
#pragma unroll
        for (int i = 0; i < 16; ++i) O[d][i] = 0.f;
    float mhat = 0.f; bool first = true;
    f32x16 negm, Lacc;
#pragma unroll
    for (int i = 0; i < 16; ++i) { negm[i] = 0.f; Lacc[i] = 0.f; }
    const bf16x8 ones8 = {(short)0x3F80, (short)0x3F80, (short)0x3F80, (short)0x3F80, (short)0x3F80, (short)0x3F80, (short)0x3F80, (short)0x3F80};
    constexpr float THR = 6.f;
#pragma unroll
    for (int ks = 0; ks < NQF; ++ks) asm volatile("" : "+v"(qf[ks]));
    if (MODE == 1) __syncthreads();
    const int q4 = (lane & 15) >> 2, p4 = lane & 3, rblk = (lane >> 4) & 1;
    bf16x8 pa[2][2];
    s16x4 vlo[2][4], vhi[2][4];
#define V_ISSUE(va, b, d) do { _Pragma("unroll") for (int k4 = 0; k4 < 4; ++k4) { DS_TR16(vlo[b][k4], va, (16 * k4) * VP + (d) * 64); DS_TR16(vhi[b][k4], va, (16 * k4 + 8) * VP + (d) * 64); } } while (0)
    auto do_pv = [&](unsigned va, bool preissued) {
        if (!preissued) V_ISSUE(va, 0, 0);
#pragma unroll
        for (int k4 = 0; k4 < 4; ++k4) Lacc = MFMA32(ones8, pa[k4 >> 1][k4 & 1], Lacc);
#pragma unroll
        for (int d = 0; d < NDV; ++d) {
            LGKM0(); SBAR();
#pragma unroll
            for (int k4 = 0; k4 < 4; ++k4) {
                const bf16x8 vf = __builtin_shufflevector(vlo[d & 1][k4], vhi[d & 1][k4], 0, 1, 2, 3, 4, 5, 6, 7);
                O[d] = MFMA32(vf, pa[k4 >> 1][k4 & 1], O[d]);
            }
            SBAR();
            if (d + 1 < NDV) V_ISSUE(va, (d + 1) & 1, d + 1);
        }
    };
    bool pv_pending = false; unsigned pv_va = 0u;
    for (int j = 0; j < ntiles; ++j) {
        wait_vm(n_w * min(DIST - 1, ntiles - 1 - j));
        __builtin_amdgcn_s_barrier();
        SBAR();
        if (j + DIST < ntiles) issue(j + DIST);
        if (pv_pending) { do_pv(pv_va, false); pv_pending = false; }
        bool active = true;
        if (MODE == 1) { const int rk = na_rs0 + j; active = (rk >= na_rsq) && (rk < na_rsq + 8); }
        if (MODE == 2) { const int lk0 = c_l0 - 64 + 64 * j; active = ((wq < 2) ? (j <= 2) : (j >= 1)) && (lk0 + 63 >= 0) && (lk0 < c_L); }
        if (active) {
            LAS const unsigned char* Kb = lds + (j % NST) * SB + koff;
            LAS const unsigned char* Vb = lds + (j % NST) * SB + voff;
            f32x16 s0, s1;
            const unsigned kaddr = (unsigned)(size_t)Kb + r * KP + 16 * h;
            const unsigned vaddr = (unsigned)(size_t)Vb + (4 * h + q4) * VP + (16 * rblk + 4 * p4) * 2;
            bf16x8 kfr[2][4];
#define K_ISSUE(b, kb) do { DS_RD128(kfr[b][0], kaddr, (2 * (kb)) * 32); DS_RD128(kfr[b][1], kaddr, 32 * KP + (2 * (kb)) * 32); \
                            DS_RD128(kfr[b][2], kaddr, (2 * (kb) + 1) * 32); DS_RD128(kfr[b][3], kaddr, 32 * KP + (2 * (kb) + 1) * 32); } while (0)
            K_ISSUE(0, 0);
#pragma unroll
            for (int kb = 0; kb < NQF / 2; ++kb) {
                LGKM0(); SBAR();
                if (kb == 0) { s0 = MFMA32(kfr[0][0], qf[0], negm); s1 = MFMA32(kfr[0][1], qf[0], negm); }
                else { s0 = MFMA32(kfr[kb & 1][0], qf[2 * kb], s0); s1 = MFMA32(kfr[kb & 1][1], qf[2 * kb], s1); }
                s0 = MFMA32(kfr[kb & 1][2], qf[2 * kb + 1], s0); s1 = MFMA32(kfr[kb & 1][3], qf[2 * kb + 1], s1);
                SBAR();
                if (kb + 1 < NQF / 2) K_ISSUE((kb + 1) & 1, kb + 1); else if (!lag) V_ISSUE(vaddr, 0, 0);
            }
            if (MODE == 1) {
                const int rk = na_rs0 + j; const int bbase = (rk - na_rq + 7) * 31 + 15 - na_cq;
#pragma unroll
                for (int i = 0; i < 16; ++i) {
                    const int ck0 = crow(i, h), ck1 = ck0 + 32;
                    const bool v0 = (ck0 >= na_csq) && (ck0 < na_csq + 16), v1 = (ck1 >= na_csq) && (ck1 < na_csq + 16);
                    const float b0 = biasL[v0 ? bbase + ck0 : 0], b1 = biasL[v1 ? bbase + ck1 : 0];
                    s0[i] = v0 ? s0[i] + b0 : NEGBIG; s1[i] = v1 ? s1[i] + b1 : NEGBIG;
                }
            }
            if (MODE == 2) {
                const int lk0 = c_l0 - 64 + 64 * j;
#pragma unroll
                for (int i = 0; i < 16; ++i) {
                    const int lka = lk0 + crow(i, h), lkb = lka + 32;
                    const bool v0 = (lka >= 0) && (lka < c_L) && (abs(lka - c_lq) <= 64), v1 = (lkb >= 0) && (lkb < c_L) && (abs(lkb - c_lq) <= 64);
                    s0[i] = v0 ? s0[i] : NEGBIG; s1[i] = v1 ? s1[i] : NEGBIG;
                }
            }
            float mx = max3f(s0[0], s1[0], s0[1]);
            mx = max3f(mx, s1[1], s0[2]);
#pragma unroll
            for (int i = 2; i < 15; ++i) mx = max3f(mx, s1[i], s0[i + 1]);
            mx = fmaxf(mx, s1[15]);
            { auto rr = __builtin_amdgcn_permlane32_swap(__float_as_uint(mx), __float_as_uint(mx), false, false); mx = max3f(__uint_as_float(rr[0]), __uint_as_float(rr[1]), __uint_as_float(rr[0])); }
            if (first || __builtin_amdgcn_ballot_w64(mx > THR) != 0ull) {
                const float delta = first ? mx : fmaxf(mx, 0.f), alpha = fast_exp2(-delta);
#pragma unroll
                for (int i = 0; i < 16; ++i) { s0[i] -= delta; s1[i] -= delta; }
                if (!first) {
#pragma unroll
                    for (int d = 0; d < NDV; ++d)
#pragma unroll
                        for (int i = 0; i < 16; ++i) O[d][i] *= alpha;
#pragma unroll
                    for (int i = 0; i < 16; ++i) Lacc[i] *= alpha;
                }
                mhat += delta;
#pragma unroll
                for (int i = 0; i < 16; ++i) negm[i] = -mhat;
                first = false;
            }
#pragma unroll
            for (int i = 0; i < 16; ++i) { s0[i] = fast_exp2(s0[i]); s1[i] = fast_exp2(s1[i]); }
            { u32x4 w;
              w.x = pk2(s0[0], s0[1]); w.y = pk2(s0[2], s0[3]); w.z = pk2(s0[4], s0[5]); w.w = pk2(s0[6], s0[7]); pa[0][0] = __builtin_bit_cast(bf16x8, w);
              w.x = pk2(s0[8], s0[9]); w.y = pk2(s0[10], s0[11]); w.z = pk2(s0[12], s0[13]); w.w = pk2(s0[14], s0[15]); pa[0][1] = __builtin_bit_cast(bf16x8, w);
              w.x = pk2(s1[0], s1[1]); w.y = pk2(s1[2], s1[3]); w.z = pk2(s1[4], s1[5]); w.w = pk2(s1[6], s1[7]); pa[1][0] = __builtin_bit_cast(bf16x8, w);
              w.x = pk2(s1[8], s1[9]); w.y = pk2(s1[10], s1[11]); w.z = pk2(s1[12], s1[13]); w.w = pk2(s1[14], s1[15]); pa[1][1] = __builtin_bit_cast(bf16x8, w); }
            if (!lag) do_pv(vaddr, true); else { pv_pending = true; pv_va = vaddr; }
#undef K_ISSUE
        }
    }
    if (pv_pending) do_pv(pv_va, false);
#undef V_ISSUE
    const float lt = Lacc[0];
    const float inv = 1.f / lt;
    __syncthreads();
    if (MODE == 0) {
        LAS float* X = (LAS float*)lds;
        if (hf == 1) {
#pragma unroll
            for (int d = 0; d < NDV; ++d)
#pragma unroll
                for (int g4 = 0; g4 < 4; ++g4) {
                    f32x4 v = {O[d][4 * g4] * inv, O[d][4 * g4 + 1] * inv, O[d][4 * g4 + 2] * inv, O[d][4 * g4 + 3] * inv};
                    *(LAS f32x4*)(X + (32 * wq + r) * 132 + 32 * d + 8 * g4 + 4 * h) = v;
                }
        }
        __syncthreads();
        if (hf == 0) {
            float ss = 0.f;
#pragma unroll
            for (int d = 0; d < NDV; ++d)
#pragma unroll
                for (int g4 = 0; g4 < 4; ++g4) {
                    const f32x4 o2 = *(LAS const f32x4*)(X + (32 * wq + r) * 132 + 32 * d + 8 * g4 + 4 * h);
#pragma unroll
                    for (int e = 0; e < 4; ++e) { const float o = O[d][4 * g4 + e] * inv - cx.lam * o2[e]; O[d][4 * g4 + e] = o; ss += o * o; }
                }
            ss += __shfl_xor(ss, 32);
            const float rstd = rsqrtf(ss * (1.f / 128.f) + EPS) * cx.oml;
#pragma unroll
            for (int d = 0; d < NDV; ++d)
#pragma unroll
                for (int g4 = 0; g4 < 4; ++g4) {
                    const int dv = 32 * d + 8 * g4 + 4 * h;
                    const f32x4 gn = *(const f32x4*)(cx.subln + dv);
                    const u32x2 sz = *(const u32x2*)(P + (size_t)qtok * NIN + COL_Z + head * 128 + dv);
                    u32x2 o;
                    o.x = pk2(O[d][4 * g4] * rstd * gn[0] * bflo(sz.x), O[d][4 * g4 + 1] * rstd * gn[1] * bfhi(sz.x));
                    o.y = pk2(O[d][4 * g4 + 2] * rstd * gn[2] * bflo(sz.y), O[d][4 * g4 + 3] * rstd * gn[3] * bfhi(sz.y));
                    *(u32x2*)(cx.T + (size_t)qtok * 512 + head * 128 + dv) = o;
                }
        }
        __syncthreads();
    } else if (MODE == 1) {
#pragma unroll
        for (int d = 0; d < NDV; ++d)
#pragma unroll
            for (int g4 = 0; g4 < 4; ++g4) {
                const int dv = 32 * d + 8 * g4 + 4 * h;
                const u32x2 sz = *(const u32x2*)(P + (size_t)qtok * NIN + COL_Z + 512 + head * 64 + dv);
                u32x2 o;
                o.x = pk2(O[d][4 * g4] * inv * bflo(sz.x), O[d][4 * g4 + 1] * inv * bfhi(sz.x));
                o.y = pk2(O[d][4 * g4 + 2] * inv * bflo(sz.y), O[d][4 * g4 + 3] * inv * bfhi(sz.y));
                *(u32x2*)(cx.T + (size_t)TCMAX * 512 + (size_t)qtok * 512 + head * 64 + dv) = o;
            }
    } else {
#pragma unroll
        for (int d = 0; d < NDV; ++d)
#pragma unroll
            for (int g4 = 0; g4 < 4; ++g4) {
                const int dv = 32 * d + 8 * g4 + 4 * h;
                u32x2 o; o.x = pk2(O[d][4 * g4] * inv, O[d][4 * g4 + 1] * inv); o.y = pk2(O[d][4 * g4 + 2] * inv, O[d][4 * g4 + 3] * inv);
                *(u32x2*)(cx.OC + (size_t)qtok * 1536 + head * 128 + dv) = o;
            }
        if (h == 0) cx.LSE[(size_t)qtok * 12 + head] = mhat + __log2f(lt);
    }
}

__device__ __forceinline__ void phase_attn(LAS unsigned char* lds, const AttnCtx& cx) {
    const int G = gridDim.x, c = blockIdx.x, nb = cx.n >> 7;
    for (int it = c; it < nb * 4; it += G) attn_item<64, 128, 0>(lds, it, cx);
    for (int it = c; it < nb * 6; it += G) attn_item<128, 128, 2>(lds, it, cx);
    for (int it = c; it < nb * 4; it += G) attn_item<64, 64, 1>(lds, it, cx);
}

__device__ __forceinline__ void phase_cmix(const bf16_t* __restrict__ P, const bf16_t* __restrict__ OC, const float* __restrict__ LSE, bf16_t* T2, int n) {
#pragma unroll 4
    for (int idx = blockIdx.x * NTHR + otid(); idx < n * 64; idx += gridDim.x * NTHR) {
        const int tok = idx >> 6, c8 = idx & 63, hh = c8 >> 4, dv = (c8 & 15) * 8;
        const float l0 = LSE[(size_t)tok * 12 + hh], l1 = LSE[(size_t)tok * 12 + 4 + hh], l2 = LSE[(size_t)tok * 12 + 8 + hh];
        const float mx = fmaxf(l0, fmaxf(l1, l2));
        float w0 = fast_exp2(l0 - mx), w1 = fast_exp2(l1 - mx), w2 = fast_exp2(l2 - mx);
        const float iw = 1.f / (w0 + w1 + w2); w0 *= iw; w1 *= iw; w2 *= iw;
        const u32x4 a = *(const u32x4*)(OC + (size_t)tok * 1536 + hh * 128 + dv), b = *(const u32x4*)(OC + (size_t)tok * 1536 + (4 + hh) * 128 + dv),
                    c = *(const u32x4*)(OC + (size_t)tok * 1536 + (8 + hh) * 128 + dv), z = *(const u32x4*)(P + (size_t)tok * NIN + COL_Z + 1024 + hh * 128 + dv);
        u32x4 o;
        o.x = pk2((w0 * bflo(a.x) + w1 * bflo(b.x) + w2 * bflo(c.x)) * bflo(z.x), (w0 * bfhi(a.x) + w1 * bfhi(b.x) + w2 * bfhi(c.x)) * bfhi(z.x));
        o.y = pk2((w0 * bflo(a.y) + w1 * bflo(b.y) + w2 * bflo(c.y)) * bflo(z.y), (w0 * bfhi(a.y) + w1 * bfhi(b.y) + w2 * bfhi(c.y)) * bfhi(z.y));
        o.z = pk2((w0 * bflo(a.z) + w1 * bflo(b.z) + w2 * bflo(c.z)) * bflo(z.z), (w0 * bfhi(a.z) + w1 * bfhi(b.z) + w2 * bfhi(c.z)) * bfhi(z.z));
        o.w = pk2((w0 * bflo(a.w) + w1 * bflo(b.w) + w2 * bflo(c.w)) * bflo(z.w), (w0 * bfhi(a.w) + w1 * bfhi(b.w) + w2 * bfhi(c.w)) * bfhi(z.w));
        *(u32x4*)(T2 + (size_t)tok * 512 + hh * 128 + dv) = o;
    }
}

#define XB_TMO      128
#define XB_XCNT(j)  (256  + 64 * (j))
#define XB_XSUB(j)  (1280 + 64 * (j))
#define XB_XGEN(j)  (2304 + 64 * (j))
#define XB_TOP      3328
#define XB_TOPGEN   3392
#define XCD_BAR_WORDS 3456
#define XB_SPIN_CAP (1u << 18)

__device__ __forceinline__ unsigned xb_ld(unsigned* p)              { return __hip_atomic_load(p, __ATOMIC_RELAXED, __HIP_MEMORY_SCOPE_AGENT); }
__device__ __forceinline__ unsigned xb_add(unsigned* p, unsigned v) { return __hip_atomic_fetch_add(p, v, __ATOMIC_RELAXED, __HIP_MEMORY_SCOPE_AGENT); }
__device__ __forceinline__ unsigned xb_xcc_id() { return (unsigned)__builtin_amdgcn_s_getreg((3 << 11) | 20) & 0xFu; }
#define XB_SPIN(cond, bar) do { unsigned _sp = 0; while (cond) { __builtin_amdgcn_s_sleep(1); \
    if ((++_sp & 255u) == 0u) { if (xb_ld(&(bar)[XB_TMO])) break; if (_sp > XB_SPIN_CAP) { atomicAdd(&(bar)[XB_TMO], 1u); break; } } } } while (0)

struct XcdBarrier {
    unsigned* bar; unsigned x;
    volatile LAS unsigned* st;
};

__device__ __forceinline__ XcdBarrier xcd_barrier_post(unsigned* bar, volatile LAS unsigned* st) {
    XcdBarrier b; b.bar = bar; b.x = xb_xcc_id(); b.st = st;
    if (threadIdx.x == 0) (void)xb_add(&bar[XB_XCNT(b.x)], 1u);
    return b;
}
__device__ __forceinline__ void xcd_barrier_complete(unsigned* bar, unsigned x, unsigned& nloc, unsigned& nx) {
    const unsigned G = gridDim.x * gridDim.y * gridDim.z;
    unsigned sum, cnt, mine, sp = 0u;
    for (;;) {
        sum = 0u; cnt = 0u; mine = 0u;
#pragma unroll
        for (unsigned j = 0; j < 16; ++j) { const unsigned c = xb_ld(&bar[XB_XCNT(j)]); sum += c; cnt += (c > 0u) ? 1u : 0u; mine = (j == x) ? c : mine; }
        if (sum == G) break;
        __builtin_amdgcn_s_sleep(1);
        if ((++sp & 255u) == 0u) { if (xb_ld(&bar[XB_TMO])) break; if (sp > XB_SPIN_CAP) { atomicAdd(&bar[XB_TMO], 1u); break; } }
    }
    nloc = mine > 0u ? mine : 1u; nx = cnt > 0u ? cnt : 1u;
}

__device__ __forceinline__ void xcd_barrier(const XcdBarrier& b) {
    asm volatile("s_waitcnt vmcnt(0)" ::: "memory");
    __syncthreads();
    if (threadIdx.x == 0) {
        unsigned* bar = b.bar;
        __builtin_amdgcn_s_waitcnt(0);
        unsigned nloc = b.st[0], nx = b.st[1];
        if (nloc == 0u) { xcd_barrier_complete(bar, b.x, nloc, nx); b.st[0] = nloc; b.st[1] = nx; }
        const unsigned old = xb_add(&bar[XB_XSUB(b.x)], 1u);
        const unsigned gen = old / nloc;
        if (old + 1u == (gen + 1u) * nloc) {
            __builtin_amdgcn_fence(__ATOMIC_RELEASE, "agent");
            asm volatile("s_waitcnt vmcnt(0)" ::: "memory");
            const unsigned og = xb_add(&bar[XB_TOP], 1u);
            const unsigned tg = og / nx;
            if (og + 1u == (tg + 1u) * nx) xb_add(&bar[XB_TOPGEN], 1u);
            else XB_SPIN(xb_ld(&bar[XB_TOPGEN]) == tg, bar);
            __builtin_amdgcn_fence(__ATOMIC_ACQUIRE, "agent");
            xb_add(&bar[XB_XGEN(b.x)], 1u);
            asm volatile("s_waitcnt vmcnt(0)" ::: "memory");
        } else {
            XB_SPIN(xb_ld(&bar[XB_XGEN(b.x)]) == gen, bar);
            __builtin_amdgcn_fence(__ATOMIC_ACQUIRE, "agent");
            asm volatile("s_waitcnt vmcnt(0)" ::: "memory");
        }
    }
    __syncthreads();
}

#ifndef ONE_LAUNCH
#define ONE_LAUNCH 1
#endif

__global__ void __launch_bounds__(NTHR, 2) mega(Params p) {
    extern __shared__ __attribute__((aligned(16))) unsigned char lds_raw[];
    LAS unsigned char* lds = (LAS unsigned char*)lds_raw;
    unsigned char* ws = p.ws;
    volatile LAS unsigned* bst = (volatile LAS unsigned*)(lds + LDS_BYTES - 16);
    if (threadIdx.x < 2) bst[threadIdx.x] = 0u;
    __syncthreads();
    XcdBarrier bar; bar.bar = (unsigned*)(ws + WS_BAR); bar.x = 0; bar.st = bst;
    if (p.ph_hi - p.ph_lo > 1) bar = xcd_barrier_post((unsigned*)(ws + WS_BAR), bst);
    bf16_t* P = (bf16_t*)(ws + WS_P); bf16_t* T = (bf16_t*)(ws + WS_T); bf16_t* H = T; bf16_t* OC = (bf16_t*)(ws + WS_OC); float* LSE = (float*)(ws + WS_LSE);
    for (int ph = p.ph_lo; ph < p.ph_hi; ++ph) {
        if (ph > p.ph_lo) { if (ph == 1) cg::this_grid().sync(); else xcd_barrier(bar); }
        if (ph == 0) { phase_pre(p, lds); phase_prew(p, lds, 0); continue; }
        if (ph == 1) { phase_h(p, 0, 0, H); continue; }
        if (ph == 17) { phase_prew(p, lds, 1); phase_h(p, 0, 1, H); continue; }
        const int l = (ph > 17) ? 1 : 0, q = ph - (l ? 18 : 2), c = q / 5, k = q - c * 5;
        const int row0 = chunk_row0(c), n = chunk_rows(c);
        const float* mod_l = (const float*)(ws + WS_MOD) + (size_t)l * NSEQ * 3072;
        if (k == 0) {
            pg8::Gemm g{H, (const bf16_t*)(ws + WS_WIN), n, NIN, DM, DM};
            pg8::StaticOrder So; So.init(n, NIN, (int)gridDim.x, (int)blockIdx.x);
            EpiIn E{P, (const float*)(ws + WS_COSA), (const float*)(ws + WS_SINA), (const float*)(ws + WS_COSC), (const float*)(ws + WS_SINC),
                    (const float*)(ws + WS_GAIN) + l * 6 * 128, row0, (LAS float*)(lds + XCH_OFF)};
            pg8::gemm_phase<EpiIn, pg8::StaticOrder, true, true>(lds, g, So, E);
        } else if (k == 1) {
            const float* L = (const float*)(ws + WS_LAM);
            AttnCtx cx{P, T, OC, LSE, p.in[14] + l * 128, p.in[17] + (size_t)l * 8 * 465, L[l], L[2 + l], row0, n};
            phase_attn(lds, cx);
        } else if (k == 2) {
            phase_cmix(P, OC, LSE, T + (size_t)2 * TCMAX * 512, n);
        } else if (k == 3) {
            pg8::Gemm g{T, (const bf16_t*)(ws + WS_WBR), 3 * TCMAX, 3072, 512, 512};
            BrOrder So{(int)gridDim.x, (int)blockIdx.x, (n >> 8) * 4};
            EpiBr E{P};
            pg8::gemm_phase<EpiBr, BrOrder, true, true>(lds, g, So, E);
        } else {
            pg8::Gemm g{P, (const bf16_t*)(ws + WS_WOUT), n, DM, DM, NIN};
            pg8::StaticOrder So; So.init(n, DM, (int)gridDim.x, (int)blockIdx.x);
            EpiOut E{p.in[0], p.in[1], p.out, mod_l, row0, l};
            pg8::gemm_phase<EpiOut, pg8::StaticOrder, true, true>(lds, g, So, E);
            if (c < 2) phase_h(p, c + 1, l, H);
        }
    }
}

extern "C" void kernel_launch(void* const* d_in, const int* in_sizes, int n_in, void* d_out, int out_size, void* d_ws, size_t ws_size, hipStream_t stream) {
    static int grid = 0;
    if (grid == 0) {
        if (n_in != 22 || ws_size < WS_END) { fprintf(stderr, "kernel_launch: unexpected n_in %d / ws_size %zu (need %zu)\n", n_in, ws_size, (size_t)WS_END); grid = -1; return; }
        int dev = 0, cus = 0, per_cu = 0;
        (void)hipGetDevice(&dev); (void)hipDeviceGetAttribute(&cus, hipDeviceAttributeMultiprocessorCount, dev);
        if (hipFuncSetAttribute((const void*)mega, hipFuncAttributeMaxDynamicSharedMemorySize, LDS_BYTES) != hipSuccess) { fprintf(stderr, "kernel_launch: hipFuncSetAttribute failed\n"); grid = -1; return; }
        (void)hipOccupancyMaxActiveBlocksPerMultiprocessor(&per_cu, (const void*)mega, NTHR, LDS_BYTES);
        if (per_cu < 1) { fprintf(stderr, "kernel_launch: occupancy query says %d blocks per CU\n", per_cu); per_cu = 1; }
        (void)hipGetLastError();
        grid = cus;
    }
    if (grid < 0) return;
    Params p{};
    for (int i = 0; i < 22; ++i) p.in[i] = (const float*)d_in[i];
    p.out = (float*)d_out; p.ws = (unsigned char*)d_ws;
#if ONE_LAUNCH
    if (hipMemsetAsync((char*)d_ws + WS_BAR, 0, 16384, stream) != hipSuccess) { fprintf(stderr, "kernel_launch: memset failed\n"); return; }
    p.ph_lo = 0; p.ph_hi = NPHASE;
    void* args[] = {&p};
    hipError_t e = hipLaunchCooperativeKernel((const void*)mega, dim3(grid), dim3(NTHR), args, LDS_BYTES, stream);
    if (e != hipSuccess) fprintf(stderr, "cooperative launch failed: %s (grid %d)\n", hipGetErrorString(e), grid);
#else
    for (int ph = 0; ph < NPHASE; ++ph) {
        p.ph_lo = ph; p.ph_hi = ph + 1;
        hipLaunchKernelGGL(mega, dim3(grid), dim3(NTHR), LDS_BYTES, stream, p);
    }
#endif
}
```

```cpp
#include <hip/hip_runtime.h>
#include <hip/hip_cooperative_groups.h>
#include <cstdio>
#include <cstdint>
namespace cg = cooperative_groups;
__device__ __forceinline__ int otid() { int t = threadIdx.x; asm volatile("" : "+v"(t)); return t; }
namespace pg8 {
#define PG8_LAS __attribute__((address_space(3)))
typedef unsigned short bf16_t;
typedef short bf16x8 __attribute__((ext_vector_type(8)));
typedef float f32x4 __attribute__((ext_vector_type(4)));
typedef unsigned u32x4 __attribute__((ext_vector_type(4)));
constexpr int BM = 256, BK = 64, HALF = 128, HTB = HALF * BK * 2  , STAGE_BYTES = 8 * HTB, NXCD = 8, WGM = 4;

__host__ __device__ __forceinline__ int lds_byte(int r, int c) { const int st = (r >> 4) * 2 + (c >> 5), rr = r & 15, cc = c & 31, ob = rr * 64 + cc * 2; return st * 1024 + (ob ^ (((ob >> 9) & 1) << 5)); }
__host__ __device__ __forceinline__ void stage_rc(int b, int& R, int& C) { const int st = b / 1024, sb = b % 1024, swz = sb ^ (((sb >> 9) & 1) << 5); R = (st >> 1) * 16 + swz / 64; C = (st & 1) * 32 + (swz % 64) / 2; }
__host__ __device__ __forceinline__ int perm32(int rho) { const int n = rho >> 4, i = rho & 15; return 8 * (i >> 2) + 4 * n + (i & 3); }

struct Unit { int pm, pn; };
struct Gemm { const bf16_t* A; const bf16_t* Bt; int M, N, K, lda; };

struct StaticOrder {
    int nM, nN, nwg, G, c;
    __host__ __device__ void init(int M, int N, int G_, int c_) { nM = M / BM; nN = N / BM; nwg = nM * nN; G = G_; c = c_; }
    __host__ __device__ bool next(int i, Unit& u) const {
        const long L = (long)i * G + c; if (L >= nwg) return false;
        int wgid = (int)L; { const int q = nwg / NXCD, r = nwg % NXCD, xcd = wgid % NXCD, off = wgid / NXCD; wgid = (xcd < r ? xcd * (q + 1) : r * (q + 1) + (xcd - r) * q) + off; }
        const int nig = WGM * nN, gid = wgid / nig, fm = gid * WGM, gsz = (nM - fm) < WGM ? (nM - fm) : WGM;
        u.pm = fm + ((wgid % nig) % gsz); u.pn = (wgid % nig) / gsz; return true;
    }
    __device__ __forceinline__ void a_ready(const Unit&) const {}
    __device__ __forceinline__ void done(const Unit&) const {}
};

__device__ __forceinline__ unsigned cvt_pk_bf16(float lo, float hi) { unsigned r; asm volatile("v_cvt_pk_bf16_f32 %0, %1, %2" : "=v"(r) : "v"(lo), "v"(hi)); return r; }

template <class Epi, class Sched, bool ALIGN_EPI = false, bool SP2 = false>
__device__ __forceinline__ void gemm_phase(PG8_LAS unsigned char* lds, const Gemm g, const Sched& S, const Epi& E) {
    const int tid = otid(), wid = __builtin_amdgcn_readfirstlane(tid >> 6), lane = tid & 63, wr = wid >> 2, wc = wid & 3, fr = lane & 15, fq = lane >> 4;
    const int K = g.K, nt = K / BK;
    unsigned voffA[2], voffB[2];
#pragma unroll
    for (int i = 0; i < 2; ++i) { int R, C; stage_rc(tid * 16 + i * 8192, R, C); const int Rb = Epi::PERM ? ((R & ~31) + perm32(R & 31)) : R;
        voffA[i] = (unsigned)(R * g.lda + C) * 2u; voffB[i] = (unsigned)(Rb * K + C) * 2u; }
    const size_t kstep = (size_t)(BK * 2);
    const size_t hstep = (size_t)HALF * K * 2;
    const size_t tstep = 2 * hstep;
    const size_t hstepA = (size_t)HALF * g.lda * 2, tstepA = 2 * hstepA;
    const unsigned ldsw = (unsigned)wid * 1024u;
    const int aoff = lds_byte(wr * 64 + fr, fq * 8), boff = lds_byte(wc * 32 + fr, fq * 8);
#define PG8_SA(b, h) (((b) * 2 + (h)) * HTB)
#define PG8_SB(b, h) ((4 + (b) * 2 + (h)) * HTB)
#define PG8_STAGE(bufoff, gbase, voff) do { _Pragma("unroll") for (int _i = 0; _i < 2; ++_i) \
        __builtin_amdgcn_global_load_lds((const unsigned*)((const char*)(gbase) + (voff)[_i]), (PG8_LAS unsigned*)(lds + (bufoff) + ldsw + _i * 8192), 16, 0, 0); } while (0)
#define PG8_LDA(dst, b, h) do { _Pragma("unroll") for (int m = 0; m < 4; ++m) _Pragma("unroll") for (int k = 0; k < 2; ++k) dst[m][k] = *(const PG8_LAS bf16x8*)(lds + PG8_SA(b, h) + aoff + m * 2048 + k * 1024); } while (0)
#define PG8_LDB(dst, b, h) do { _Pragma("unroll") for (int n = 0; n < 2; ++n) _Pragma("unroll") for (int k = 0; k < 2; ++k) dst[n][k] = *(const PG8_LAS bf16x8*)(lds + PG8_SB(b, h) + boff + n * 2048 + k * 1024); } while (0)
#define PG8_MMA(ai, bj, At, Bt) do { __builtin_amdgcn_s_setprio(1); _Pragma("unroll") for (int m = 0; m < 4; ++m) _Pragma("unroll") for (int n = 0; n < 2; ++n) _Pragma("unroll") for (int k = 0; k < 2; ++k) \
        acc[ai][bj][m][n] = __builtin_amdgcn_mfma_f32_16x16x32_bf16(Bt[n][k], At[m][k], acc[ai][bj][m][n], 0, 0, 0); __builtin_amdgcn_s_setprio(0); } while (0)
#define PG8_WAIT_V(n) asm volatile("s_waitcnt vmcnt(" #n ")" ::: "memory")
#define PG8_WAIT_L(n) asm volatile("s_waitcnt lgkmcnt(" #n ")" ::: "memory")
#define PG8_BAR __builtin_amdgcn_s_barrier()
#define PG8_SCHED __builtin_amdgcn_sched_barrier(0)
    Unit cur, nxt; int ui = 0;
    if (!S.next(0, cur)) return;
    f32x4 acc[2][2][4][2];
#pragma unroll
    for (int a = 0; a < 2; ++a)
#pragma unroll
        for (int b = 0; b < 2; ++b)
#pragma unroll
            for (int m = 0; m < 4; ++m)
#pragma unroll
                for (int n = 0; n < 2; ++n) acc[a][b][m][n] = (f32x4){0.f, 0.f, 0.f, 0.f};
    bf16x8 At[4][2], B0[2][2], B1[2][2];
    const char* cA = (const char*)g.A + (size_t)cur.pm * tstepA; const char* cB = (const char*)g.Bt + (size_t)cur.pn * tstep;
    S.a_ready(cur);
    if constexpr (SP2) {
        PG8_STAGE(PG8_SB(0, 0), cB, voffB); PG8_STAGE(PG8_SB(0, 1), cB + hstep, voffB); PG8_STAGE(PG8_SA(0, 0), cA, voffA); PG8_STAGE(PG8_SA(0, 1), cA + hstepA, voffA);
        if (wr == 1) PG8_BAR;
        PG8_WAIT_V(2); PG8_BAR;
        PG8_STAGE(PG8_SB(1, 0), cB + kstep, voffB); PG8_STAGE(PG8_SA(1, 0), cA + kstep, voffA); PG8_STAGE(PG8_SB(1, 1), cB + hstep + kstep, voffB);
        PG8_WAIT_V(6); PG8_BAR;
    } else {
        PG8_STAGE(PG8_SB(0, 0), cB, voffB); PG8_STAGE(PG8_SA(0, 0), cA, voffA); PG8_STAGE(PG8_SB(0, 1), cB + hstep, voffB); PG8_STAGE(PG8_SA(0, 1), cA + hstepA, voffA);
        if (wr == 1) PG8_BAR;
        PG8_WAIT_V(4); PG8_BAR;
        PG8_STAGE(PG8_SB(1, 0), cB + kstep, voffB); PG8_STAGE(PG8_SA(1, 0), cA + kstep, voffA); PG8_STAGE(PG8_SB(1, 1), cB + hstep + kstep, voffB);
        PG8_WAIT_V(6); PG8_BAR;
    }
    for (;;) {
        const bool has_next = S.next(ui + 1, nxt);
        const char* nA = has_next ? (const char*)g.A + (size_t)nxt.pm * tstepA : cA; const char* nB = has_next ? (const char*)g.Bt + (size_t)nxt.pn * tstep : cB;
        for (int t = 0; t < nt; t += 2) {
            const bool last = (t == nt - 2);
            const char* a1 = cA + (size_t)(t + 1) * kstep;
            const char* a2 = last ? nA : cA + (size_t)(t + 2) * kstep; const char* b2 = last ? nB : cB + (size_t)(t + 2) * kstep;
            const char* a3 = a2 + kstep; const char* b3 = b2 + kstep;
            if (last && has_next) S.a_ready(nxt);
            if constexpr (SP2) {
            PG8_LDB(B0, 0, 0); PG8_LDB(B1, 0, 1); PG8_SCHED; PG8_LDA(At, 0, 0); PG8_STAGE(PG8_SA(1, 1), a1 + hstepA, voffA);
            PG8_WAIT_V(8); PG8_WAIT_L(0); PG8_BAR; PG8_MMA(0, 0, At, B0); PG8_MMA(0, 1, At, B1); PG8_BAR; PG8_SCHED;
            PG8_LDA(At, 0, 1); PG8_STAGE(PG8_SB(0, 0), b2, voffB); PG8_STAGE(PG8_SB(0, 1), b2 + hstep, voffB); PG8_STAGE(PG8_SA(0, 0), a2, voffA);
            PG8_WAIT_V(8); PG8_WAIT_L(0); PG8_BAR; PG8_MMA(1, 0, At, B0); PG8_MMA(1, 1, At, B1); PG8_BAR; PG8_SCHED;
            PG8_LDB(B0, 1, 0); PG8_LDB(B1, 1, 1); PG8_SCHED; PG8_LDA(At, 1, 0); PG8_STAGE(PG8_SA(0, 1), a2 + hstepA, voffA);
            PG8_WAIT_V(8); PG8_WAIT_L(0); PG8_BAR; PG8_MMA(0, 0, At, B0); PG8_MMA(0, 1, At, B1); PG8_BAR; PG8_SCHED;
            PG8_LDA(At, 1, 1); PG8_STAGE(PG8_SB(1, 0), b3, voffB); PG8_STAGE(PG8_SB(1, 1), b3 + hstep, voffB); PG8_STAGE(PG8_SA(1, 0), a3, voffA);
            PG8_WAIT_V(8); PG8_WAIT_L(0); PG8_BAR; PG8_MMA(1, 0, At, B0); PG8_MMA(1, 1, At, B1); PG8_BAR; PG8_SCHED;
            } else {
            PG8_LDB(B0, 0, 0); PG8_SCHED; PG8_LDA(At, 0, 0); PG8_STAGE(PG8_SA(1, 1), a1 + hstepA, voffA);
            PG8_WAIT_L(8); PG8_BAR; PG8_WAIT_L(0); PG8_MMA(0, 0, At, B0); PG8_BAR; PG8_SCHED;
            PG8_LDB(B1, 0, 1); PG8_STAGE(PG8_SB(0, 0), b2, voffB);
            PG8_BAR; PG8_WAIT_L(0); PG8_MMA(0, 1, At, B1); PG8_BAR;
            PG8_LDA(At, 0, 1); PG8_STAGE(PG8_SA(0, 0), a2, voffA);
            PG8_BAR; PG8_WAIT_L(0); PG8_MMA(1, 0, At, B0); PG8_BAR; PG8_SCHED;
            PG8_STAGE(PG8_SB(0, 1), b2 + hstep, voffB);
            PG8_WAIT_V(6); PG8_BAR; PG8_MMA(1, 1, At, B1); PG8_BAR;
            PG8_LDB(B0, 1, 0); PG8_SCHED; PG8_LDA(At, 1, 0); PG8_STAGE(PG8_SA(0, 1), a2 + hstepA, voffA);
            PG8_WAIT_L(8); PG8_BAR; PG8_WAIT_L(0); PG8_MMA(0, 0, At, B0); PG8_BAR; PG8_SCHED;
            PG8_LDB(B1, 1, 1); PG8_STAGE(PG8_SB(1, 0), b3, voffB);
            PG8_BAR; PG8_WAIT_L(0); PG8_MMA(0, 1, At, B1); PG8_BAR;
            PG8_LDA(At, 1, 1); PG8_STAGE(PG8_SA(1, 0), a3, voffA);
            PG8_BAR; PG8_WAIT_L(0); PG8_MMA(1, 0, At, B0); PG8_BAR; PG8_SCHED;
            PG8_STAGE(PG8_SB(1, 1), b3 + hstep, voffB);
            PG8_WAIT_V(6); PG8_BAR; PG8_MMA(1, 1, At, B1); PG8_BAR;
            }
        }
        if constexpr (ALIGN_EPI) { if (wr == 0) PG8_BAR; }
        if constexpr (!Epi::AFTER_DRAIN) { E(acc, cur, wr, wc, fr, fq); S.done(cur); }
        if (!has_next) break;
        if (!E.keep(cur)) {
#pragma unroll
        for (int a = 0; a < 2; ++a)
#pragma unroll
            for (int b = 0; b < 2; ++b)
#pragma unroll
                for (int m = 0; m < 4; ++m)
#pragma unroll
                    for (int n = 0; n < 2; ++n) acc[a][b][m][n] = (f32x4){0.f, 0.f, 0.f, 0.f};
        }
        cur = nxt; cA = nA; cB = nB; ++ui;
        if constexpr (ALIGN_EPI) { if (wr == 1) PG8_BAR; }
    }
    PG8_WAIT_V(0);
    if constexpr (!ALIGN_EPI) { if (wr == 0) PG8_BAR; }
    PG8_BAR;
    if constexpr (Epi::AFTER_DRAIN) { E.fused(acc, cur, wr, wc, fr, fq, lds, wid, lane); S.done(cur); }
#undef PG8_SA
#undef PG8_SB
#undef PG8_STAGE
#undef PG8_LDA
#undef PG8_LDB
#undef PG8_MMA
#undef PG8_WAIT_V
#undef PG8_WAIT_L
#undef PG8_BAR
#undef PG8_SCHED
}
}

#define LAS __attribute__((address_space(3)))
#ifndef PH_MASK
#define PH_MASK 0xFFF
#endif
#ifndef DUP_PH
#define DUP_PH -1
#endif
typedef unsigned short bf16_t;
typedef short bf16x8 __attribute__((ext_vector_type(8)));
typedef short s16x4 __attribute__((ext_vector_type(4)));
typedef short v4i16_t __attribute__((ext_vector_type(4)));
typedef float f32x2 __attribute__((ext_vector_type(2)));
typedef float f32x4 __attribute__((ext_vector_type(4)));
typedef float f32x16 __attribute__((ext_vector_type(16)));
typedef unsigned u32x2 __attribute__((ext_vector_type(2)));
typedef unsigned u32x4 __attribute__((ext_vector_type(4)));
typedef __bf16 bf16x2_t __attribute__((ext_vector_type(2)));

constexpr int DM = 1024, NIN = 12288, TCMAX = 32768, NCHUNK = 3, NSEQ = 36, NTHR = 512, NPROMPT = 16384;
__device__ __forceinline__ int chunk_row0(int c) { return c * 32768; }
__device__ __forceinline__ int chunk_rows(int c) { return c == 2 ? 16384 : 32768; }
__device__ __forceinline__ int seq_len_of(int g) { return g < NPROMPT ? 4096 : 2048; }
__device__ __forceinline__ int seq_of(int g) { return g < NPROMPT ? (g >> 12) : 4 + ((g - NPROMPT) >> 11); }
constexpr int COL_A_Q = 0, COL_A_K = 512, COL_A_V = 1024, COL_B_Q = 1536, COL_B_K = 2048, COL_B_V = 2560, COL_C_Q = 3072, COL_C_K = 4608,
              COL_C_V = 6144, COL_Z = 7680, COL_G = 9216;
constexpr float EPS = 1e-6f, LOG2E = 1.4426950408889634f, NEGBIG = -1e30f;

constexpr size_t WS_WIN = 0;
constexpr size_t WS_WBR = WS_WIN + (size_t)NIN * DM * 2;
constexpr size_t WS_WOUT = WS_WBR + 3072ull * 512 * 2;
constexpr size_t WS_MOD = WS_WOUT + (size_t)DM * DM * 2;
constexpr size_t WS_COSA = WS_MOD + 2ull * NSEQ * 3072 * 4;
constexpr size_t WS_SINA = WS_COSA + 4096ull * 32 * 4;
constexpr size_t WS_COSC = WS_SINA + 4096ull * 32 * 4;
constexpr size_t WS_SINC = WS_COSC + 4096ull * 64 * 4;
constexpr size_t WS_LAM = WS_SINC + 4096ull * 64 * 4;
constexpr size_t WS_GAIN = WS_LAM + 256;
constexpr size_t WS_BAR = WS_GAIN + 2 * 6 * 128 * 4;
constexpr size_t WS_P = WS_BAR + 16384;
constexpr size_t WS_T = WS_P + (size_t)TCMAX * NIN * 2;
constexpr size_t WS_OC = WS_T + 3ull * TCMAX * 512 * 2;
constexpr size_t WS_LSE = WS_OC + (size_t)TCMAX * 1536 * 2;
constexpr size_t WS_END = WS_LSE + (size_t)TCMAX * 12 * 4;

constexpr int LDS_BYTES = 159744;
constexpr int XCH_OFF = 131072;
constexpr int NPHASE = 2 + 15 + 1 + 15;

struct Params { const float* in[22]; float* out; unsigned char* ws; int ph_lo, ph_hi; };

__device__ __forceinline__ unsigned pk2(float lo, float hi) { f32x2 v = {lo, hi}; bf16x2_t b = __builtin_convertvector(v, bf16x2_t); return __builtin_bit_cast(unsigned, b); }
__device__ __forceinline__ float bflo(unsigned u) { return __uint_as_float(u << 16); }
__device__ __forceinline__ float bfhi(unsigned u) { return __uint_as_float(u & 0xffff0000u); }
__device__ __forceinline__ float wave_sum(float v) {
#pragma unroll
    for (int o = 32; o >= 1; o >>= 1) v += __shfl_xor(v, o);
    return v;
}
__device__ __forceinline__ float fast_exp2(float x) { return __builtin_amdgcn_exp2f(x); }
__device__ __forceinline__ float sigmoidf_(float x) { return __builtin_amdgcn_rcpf(1.f + __builtin_amdgcn_exp2f(x * -1.4426950408889634f)); }
__device__ __forceinline__ float siluf_(float x) { return x * sigmoidf_(x); }

__host__ __device__ __forceinline__ int tile_type(int pn) {
    if (pn < 4) return 1; if (pn < 6) return 0; if (pn < 10) return 2; if (pn < 12) return 0; if (pn < 24) return 3; if (pn < 30) return 0; if (pn < 36) return 4; return 5;
}
__device__ __forceinline__ int phys_row(int col) {
    const int pn = col >> 8, lc = col & 255, ty = tile_type(pn);
    if (ty == 1 || ty == 2) { const int wc = (lc >> 6) & 3, bj = (lc >> 5) & 1, rest = lc & 31; return (pn << 8) + 128 * bj + 32 * wc + rest; }
    if (ty == 3) { const int hh = lc >> 7, bj = (lc >> 6) & 1, w0 = (lc >> 5) & 1, rest = lc & 31; return (pn << 8) + 128 * bj + 32 * (2 * hh + w0) + rest; }
    return col;
}

__device__ __forceinline__ void transpose_item(const float* __restrict__ W, int K, int N, bf16_t* Bt, int kt, int nt, bool perm, LAS float* tile) {
    const int t = otid(), k0 = kt * 64, n0 = nt * 64;
#pragma unroll
    for (int i = 0; i < 8; ++i) { const int k = i * 8 + (t >> 6), n = t & 63; tile[k * 65 + n] = W[(size_t)(k0 + k) * N + n0 + n]; }
    __syncthreads();
    const int n = t >> 3, kk = (t & 7) * 8;
    u32x4 w;
    w.x = pk2(tile[(kk + 0) * 65 + n], tile[(kk + 1) * 65 + n]); w.y = pk2(tile[(kk + 2) * 65 + n], tile[(kk + 3) * 65 + n]);
    w.z = pk2(tile[(kk + 4) * 65 + n], tile[(kk + 5) * 65 + n]); w.w = pk2(tile[(kk + 6) * 65 + n], tile[(kk + 7) * 65 + n]);
    const int col = n0 + n, row = perm ? phys_row(col) : col;
    *(u32x4*)(Bt + (size_t)row * K + k0 + kk) = w;
    __syncthreads();
}

__device__ __forceinline__ void mod_item(const Params& p, int item, LAS float* sc) {
    const int l = item / 48, cb = item % 48, t = otid();
    const float* cp = p.in[2]; const float* cs = p.in[3];
    for (int i = t; i < NSEQ * 1024; i += NTHR) { const int s = i >> 10, k = i & 1023; const float c = (s < 4) ? cp[s * 1024 + k] : cs[(s - 4) * 1024 + k]; sc[i] = siluf_(c); }
    __syncthreads();
    const int col = t & 63, ks = t >> 6;
    const float* w = p.in[5] + (size_t)l * 1024 * 3072 + cb * 64 + col;
    float acc[NSEQ];
#pragma unroll
    for (int s = 0; s < NSEQ; ++s) acc[s] = 0.f;
    for (int k = ks * 128; k < ks * 128 + 128; ++k) {
        const float wv = w[(size_t)k * 3072];
#pragma unroll
        for (int s = 0; s < NSEQ; ++s) acc[s] += sc[s * 1024 + k] * wv;
    }
    __syncthreads();
#pragma unroll
    for (int s = 0; s < NSEQ; ++s) sc[(ks * NSEQ + s) * 64 + col] = acc[s];
    __syncthreads();
    float* mod = (float*)(p.ws + WS_MOD) + (size_t)l * NSEQ * 3072;
    const float* b = p.in[6] + (size_t)l * 3072;
    for (int i = t; i < NSEQ * 64; i += NTHR) {
        const int s = i >> 6, c = i & 63; float v = 0.f;
#pragma unroll
        for (int q = 0; q < 8; ++q) v += sc[(q * NSEQ + s) * 64 + c];
        mod[s * 3072 + cb * 64 + c] = v + b[cb * 64 + c];
    }
    __syncthreads();
}

__device__ __forceinline__ void phase_prew(const Params& p, LAS unsigned char* lds, int l) {
    LAS float* scr = (LAS float*)lds;
    const int G = gridDim.x, bid = blockIdx.x;
    constexpr int N_WIN = 16 * 192, N_WBR = 3 * 8 * 16, N_WOUT = 16 * 16, PER_L = N_WIN + N_WBR + N_WOUT;
    for (int item = bid; item < PER_L; item += G) {
        int it = item;
        if (it < N_WIN) { transpose_item(p.in[7] + (size_t)l * DM * NIN, DM, NIN, (bf16_t*)(p.ws + WS_WIN), it & 15, it >> 4, true, scr); }
        else if (it < N_WIN + N_WBR) { it -= N_WIN; const int br = it >> 7, r = it & 127;
            transpose_item(p.in[20] + ((size_t)l * 3 + br) * 512 * 1024, 512, 1024, (bf16_t*)(p.ws + WS_WBR) + (size_t)br * 1024 * 512, r & 7, r >> 3, false, scr); }
        else { it -= N_WIN + N_WBR; transpose_item(p.in[21] + (size_t)l * DM * DM, DM, DM, (bf16_t*)(p.ws + WS_WOUT), it & 15, it >> 4, false, scr); }
    }
}

__device__ __forceinline__ void phase_pre(const Params& p, LAS unsigned char* lds) {
    LAS float* scr = (LAS float*)lds;
    const int G = gridDim.x, bid = blockIdx.x, t = otid();
    for (int item = bid; item < 96; item += G) mod_item(p, item, scr);
    const int gt = bid * NTHR + t, gn = G * NTHR;
    float* cosA = (float*)(p.ws + WS_COSA); float* sinA = (float*)(p.ws + WS_SINA); float* cosC = (float*)(p.ws + WS_COSC); float* sinC = (float*)(p.ws + WS_SINC);
    for (int i = gt; i < 4096 * 96; i += gn) {
        int pos, j; float inv; float* cd; float* sd;
        if (i < 4096 * 32) { pos = i >> 5; j = i & 31; inv = exp2f(-(float)j * (13.287712379549449f / 32.f)); cd = cosA + i; sd = sinA + i; }
        else { const int i2 = i - 4096 * 32; pos = i2 >> 6; j = i2 & 63; inv = exp2f(-(float)j * (13.287712379549449f / 64.f)); cd = cosC + i2; sd = sinC + i2; }
        double x = (double)pos * (double)inv * 0.15915494309189535;
        x -= floor(x);
        const float r = (float)(x * 6.283185307179586);
        *cd = __cosf(r); *sd = __sinf(r);
    }
    if (bid == 1) {
        float* gt = (float*)(p.ws + WS_GAIN);
        for (int i = t; i < 2 * 6 * 128; i += NTHR) {
            const int l = i / 768, w = (i % 768) >> 7, d = i & 127; float v = 0.f;
            if (w == 0) { if (d < 64) v = p.in[8][l * 64 + d]; } else if (w == 1) { if (d < 64) v = p.in[9][l * 64 + d]; }
            else if (w == 2) { if (d < 64) v = p.in[15][l * 64 + d]; } else if (w == 3) { if (d < 64) v = p.in[16][l * 64 + d]; }
            else if (w == 4) v = p.in[18][l * 128 + d]; else v = p.in[19][l * 128 + d];
            gt[i] = v;
        }
    }
    if (bid == 0 && t < 2) {
        const int l = t; float a = 0.f, b = 0.f;
        for (int i = 0; i < 64; ++i) { a += p.in[10][l * 64 + i] * p.in[11][l * 64 + i]; b += p.in[12][l * 64 + i] * p.in[13][l * 64 + i]; }
        const float lam_init = 0.8f - 0.6f * expf(-0.3f * (float)l);
        float* L = (float*)(p.ws + WS_LAM);
        L[l] = expf(a) - expf(b) + lam_init; L[2 + l] = 1.f - lam_init;
    }
}

__device__ __forceinline__ void phase_h(const Params& p, int c, int l, bf16_t* H) {
    const int wave = otid() >> 6, lane = otid() & 63;
    const int row0 = chunk_row0(c), n = chunk_rows(c);
    const float* lng = p.in[4] + l * DM;
    const float* mod_l = (const float*)(p.ws + WS_MOD) + (size_t)l * NSEQ * 3072;
    for (int row = blockIdx.x * 8 + wave; row < n; row += gridDim.x * 8) {
        const int g = row0 + row;
        const float* xr = (l == 0) ? ((g < NPROMPT) ? p.in[0] + (size_t)g * DM : p.in[1] + (size_t)(g - NPROMPT) * DM) : p.out + (size_t)g * DM;
        f32x4 v[4]; float ss = 0.f;
#pragma unroll
        for (int j = 0; j < 4; ++j) { v[j] = *(const f32x4*)(xr + j * 256 + lane * 4); ss += v[j][0] * v[j][0] + v[j][1] * v[j][1] + v[j][2] * v[j][2] + v[j][3] * v[j][3]; }
        ss = wave_sum(ss);
        const float rstd = rsqrtf(ss * (1.f / 1024.f) + EPS);
        const float* md = mod_l + (size_t)seq_of(g) * 3072;
#pragma unroll
        for (int j = 0; j < 4; ++j) {
            const int col = j * 256 + lane * 4;
            const f32x4 gg = *(const f32x4*)(lng + col), sh = *(const f32x4*)(md + col), sc = *(const f32x4*)(md + 1024 + col);
            const f32x4 h = v[j] * rstd * gg * (sc + 1.0f) + sh;
            u32x2 o; o.x = pk2(h[0], h[1]); o.y = pk2(h[2], h[3]);
            *(u32x2*)(H + (size_t)row * DM + col) = o;
        }
    }
}

__device__ __forceinline__ u32x4 pack8(const f32x4& a, const f32x4& b) { u32x4 w; w.x = pk2(a[0], a[1]); w.y = pk2(a[2], a[3]); w.z = pk2(b[0], b[1]); w.w = pk2(b[2], b[3]); return w; }
__device__ __forceinline__ float dot4(const f32x4& a) { return a[0] * a[0] + a[1] * a[1] + a[2] * a[2] + a[3] * a[3]; }

struct EpiIn {
    static constexpr bool PERM = true, AFTER_DRAIN = false;
    bf16_t* P; const float* cosA; const float* sinA; const float* cosC; const float* sinC;
    const float* gtab; int row0; LAS float* xch;
    __device__ __forceinline__ bool keep(const pg8::Unit&) const { return false; }
    __device__ __forceinline__ static void piece(f32x4 a, f32x4 b, float rs, const float* glo, const float* ghi, const float* cp, const float* sp, bool rope, u32x2& pa, u32x2& pb) {
        a = a * rs * *(const f32x4*)glo; b = b * rs * *(const f32x4*)ghi;
        if (rope) { const f32x4 c = *(const f32x4*)cp, sn = *(const f32x4*)sp; const f32x4 na = a * c - b * sn, nb = b * c + a * sn; a = na; b = nb; }
        pa.x = pk2(a[0], a[1]); pa.y = pk2(a[2], a[3]); pb.x = pk2(b[0], b[1]); pb.y = pk2(b[2], b[3]);
    }
    __device__ __forceinline__ void operator()(const f32x4 (&acc)[2][2][4][2], const pg8::Unit& u, int wr, int wc, int fr, int fq) const {
        const int pn = u.pn, ty = tile_type(pn);
        const int rl0 = wr * 64 + fr;
        const size_t rowg0 = (size_t)u.pm * 256 + rl0;
        if (ty == 1 || ty == 2) {
            const bool isq = (ty == 1) ? (pn < 2) : (pn < 8);
            const float* g = gtab + ((ty == 1 ? 0 : 2) + (isq ? 0 : 1)) * 128 + 8 * fq;
            const float qs = isq ? 0.125f * LOG2E : 1.f;
            bf16_t* pb = P + rowg0 * NIN + pn * 256 + 64 * wc + 8 * fq;
#pragma unroll
            for (int ai = 0; ai < 2; ++ai)
#pragma unroll
                for (int m = 0; m < 4; ++m) {
                    float ss = dot4(acc[ai][0][m][0]) + dot4(acc[ai][0][m][1]) + dot4(acc[ai][1][m][0]) + dot4(acc[ai][1][m][1]);
                    ss += __shfl_xor(ss, 16); ss += __shfl_xor(ss, 32);
                    const float rs = rsqrtf(ss * (1.f / 64.f) + EPS) * qs;
                    const int roff = ai * 128 + m * 16;
                    const int gq = row0 + (int)rowg0 + roff; const int pos = gq & (seq_len_of(gq) - 1);
                    const float* cp = cosA + pos * 32 + 8 * fq; const float* sp = sinA + pos * 32 + 8 * fq;
                    u32x2 pa0, pb0, pa1, pb1;
                    piece(acc[ai][0][m][0], acc[ai][1][m][0], rs, g, g + 32, cp, sp, ty == 1, pa0, pb0);
                    piece(acc[ai][0][m][1], acc[ai][1][m][1], rs, g + 4, g + 36, cp + 4, sp + 4, ty == 1, pa1, pb1);
                    *(u32x4*)(pb + (size_t)roff * NIN) = (u32x4){pa0.x, pa0.y, pa1.x, pa1.y};
                    *(u32x4*)(pb + (size_t)roff * NIN + 32) = (u32x4){pb0.x, pb0.y, pb1.x, pb1.y};
                    __builtin_amdgcn_sched_barrier(0);
                }
        } else if (ty == 3) {
            const bool isq = pn < 18;
            const float qs = isq ? 0.08838834764831845f * LOG2E : 1.f;
            const int hh = wc >> 1, w0 = wc & 1;
#pragma unroll
            for (int ai = 0; ai < 2; ++ai)
#pragma unroll
                for (int m = 0; m < 4; ++m) {
                    float ss = dot4(acc[ai][0][m][0]) + dot4(acc[ai][0][m][1]) + dot4(acc[ai][1][m][0]) + dot4(acc[ai][1][m][1]);
                    ss += __shfl_xor(ss, 16); ss += __shfl_xor(ss, 32);
                    if (fq == 0) xch[(ai * 128 + m * 16 + rl0) * 4 + wc] = ss;
                    __builtin_amdgcn_sched_barrier(0);
                }
            __syncthreads();
            const int dlo = 32 * w0 + 8 * fq;
            const float* g = gtab + (isq ? 4 : 5) * 128 + dlo;
            bf16_t* pb = P + rowg0 * NIN + pn * 256 + 128 * hh + dlo;
#pragma unroll
            for (int ai = 0; ai < 2; ++ai)
#pragma unroll
                for (int m = 0; m < 4; ++m) {
                    const int roff = ai * 128 + m * 16;
                    const f32x2 t2 = *(LAS const f32x2*)(xch + (roff + rl0) * 4 + 2 * hh);
                    const float rs = rsqrtf((t2[0] + t2[1]) * (1.f / 128.f) + EPS) * qs;
                    const int gq = row0 + (int)rowg0 + roff; const int pos = gq & (seq_len_of(gq) - 1);
                    const float* cp = cosC + pos * 64 + dlo; const float* sp = sinC + pos * 64 + dlo;
                    u32x2 pa0, pb0, pa1, pb1;
                    piece(acc[ai][0][m][0], acc[ai][1][m][0], rs, g, g + 64, cp, sp, true, pa0, pb0);
                    piece(acc[ai][0][m][1], acc[ai][1][m][1], rs, g + 4, g + 68, cp + 4, sp + 4, true, pa1, pb1);
                    *(u32x4*)(pb + (size_t)roff * NIN) = (u32x4){pa0.x, pa0.y, pa1.x, pa1.y};
                    *(u32x4*)(pb + (size_t)roff * NIN + 64) = (u32x4){pb0.x, pb0.y, pb1.x, pb1.y};
                    __builtin_amdgcn_sched_barrier(0);
                }
        } else {
            bf16_t* pb = P + rowg0 * NIN + pn * 256 + 32 * wc + 8 * fq;
#pragma unroll
            for (int ai = 0; ai < 2; ++ai)
#pragma unroll
                for (int m = 0; m < 4; ++m)
#pragma unroll
                    for (int bj = 0; bj < 2; ++bj) {
                        f32x4 v0 = acc[ai][bj][m][0], v1 = acc[ai][bj][m][1];
                        if (ty == 4) {
#pragma unroll
                            for (int e = 0; e < 4; ++e) { v0[e] = siluf_(v0[e]); v1[e] = siluf_(v1[e]); }
                        } else if (ty == 5) {
#pragma unroll
                            for (int e = 0; e < 4; ++e) { v0[e] = sigmoidf_(v0[e]); v1[e] = sigmoidf_(v1[e]); }
                        }
                        *(u32x4*)(pb + (size_t)(ai * 128 + m * 16) * NIN + bj * 128) = pack8(v0, v1);
                        __builtin_amdgcn_sched_barrier(0);
                    }
        }
    }
};

struct BrOrder {
    int G, c, ntile;
    __device__ __forceinline__ bool next(int i, pg8::Unit& u) const {
        const int tk = i / 3, br = i - 3 * tk, tile = c + tk * G; if (tile >= ntile) return false;
        u.pm = (tile >> 2) + br * (TCMAX / 256); u.pn = (tile & 3) + br * 4; return true;
    }
    __device__ __forceinline__ void a_ready(const pg8::Unit&) const {}
    __device__ __forceinline__ void done(const pg8::Unit&) const {}
};

struct EpiBr {
    static constexpr bool PERM = true, AFTER_DRAIN = false;
    bf16_t* P;
    __device__ __forceinline__ bool keep(const pg8::Unit& u) const { return (u.pm >> 7) < 2; }
    __device__ __forceinline__ void operator()(f32x4 (&acc)[2][2][4][2], const pg8::Unit& u, int wr, int wc, int fr, int fq) const {
        const int br = u.pm >> 7, pm = u.pm & 127, pn = u.pn & 3;
        const size_t row0 = (size_t)pm * 256 + wr * 64 + fr; const int col0 = pn * 256 + 32 * wc + 8 * fq;
#pragma unroll
        for (int ai = 0; ai < 2; ++ai)
#pragma unroll
            for (int m = 0; m < 4; ++m)
#pragma unroll
                for (int bj = 0; bj < 2; ++bj) {
                    const size_t row = row0 + ai * 128 + m * 16; const int col = col0 + bj * 128;
                    const u32x4 sg = *(const u32x4*)(P + row * NIN + COL_G + br * 1024 + col);
                    f32x4 f0 = {bflo(sg.x), bfhi(sg.x), bflo(sg.y), bfhi(sg.y)}, f1 = {bflo(sg.z), bfhi(sg.z), bflo(sg.w), bfhi(sg.w)};
                    if (br < 2) {
                        const u32x4 sn = *(const u32x4*)(P + row * NIN + COL_G + (br + 1) * 1024 + col);
                        f0[0] *= __builtin_amdgcn_rcpf(bflo(sn.x)); f0[1] *= __builtin_amdgcn_rcpf(bfhi(sn.x)); f0[2] *= __builtin_amdgcn_rcpf(bflo(sn.y)); f0[3] *= __builtin_amdgcn_rcpf(bfhi(sn.y));
                        f1[0] *= __builtin_amdgcn_rcpf(bflo(sn.z)); f1[1] *= __builtin_amdgcn_rcpf(bfhi(sn.z)); f1[2] *= __builtin_amdgcn_rcpf(bflo(sn.w)); f1[3] *= __builtin_amdgcn_rcpf(bfhi(sn.w));
                        acc[ai][bj][m][0] *= f0; acc[ai][bj][m][1] *= f1;
                    } else {
                        *(u32x4*)(P + row * NIN + col) = pack8(acc[ai][bj][m][0] * f0, acc[ai][bj][m][1] * f1);
                    }
                    __builtin_amdgcn_sched_barrier(0);
                }
    }
};

struct EpiOut {
    static constexpr bool PERM = true, AFTER_DRAIN = false;
    const float* xp; const float* xs; float* out; const float* mod_l; int row0, layer;
    __device__ __forceinline__ bool keep(const pg8::Unit&) const { return false; }
    __device__ __forceinline__ void operator()(const f32x4 (&acc)[2][2][4][2], const pg8::Unit& u, int wr, int wc, int fr, int fq) const {
        const int g0 = row0 + u.pm * 256 + wr * 64 + fr; const int col0 = u.pn * 256 + 32 * wc + 8 * fq;
#pragma unroll
        for (int ai = 0; ai < 2; ++ai)
#pragma unroll
            for (int m = 0; m < 4; ++m) {
                const int g = g0 + ai * 128 + m * 16;
                const float* gt = mod_l + (size_t)seq_of(g) * 3072 + 2048;
                const float* xr = (layer == 0) ? ((g < NPROMPT) ? xp + (size_t)g * DM : xs + (size_t)(g - NPROMPT) * DM) : out + (size_t)g * DM;
                float* orow = out + (size_t)g * DM;
#pragma unroll
                for (int bj = 0; bj < 2; ++bj) {
                    const int col = col0 + bj * 128;
                    const f32x4 g0v = *(const f32x4*)(gt + col), g1v = *(const f32x4*)(gt + col + 4);
                    const f32x4 x0 = *(const f32x4*)(xr + col), x1 = *(const f32x4*)(xr + col + 4);
                    *(f32x4*)(orow + col) = x0 + g0v * acc[ai][bj][m][0];
                    *(f32x4*)(orow + col + 4) = x1 + g1v * acc[ai][bj][m][1];
                }
            }
    }
};

struct AttnCtx { const bf16_t* P; bf16_t* T; bf16_t* OC; float* LSE; const float* subln; const float* rpb; const float* lamp; int layer; int row0, n; };

__device__ __forceinline__ int crow(int i, int h) { return (i & 3) + 8 * (i >> 2) + 4 * h; }
__device__ __forceinline__ s16x4 vtr(LAS const unsigned char* p) { return __builtin_bit_cast(s16x4, __builtin_amdgcn_ds_read_tr16_b64_v4i16((LAS v4i16_t*)p)); }
#define MFMA32(a, b, c) __builtin_amdgcn_mfma_f32_32x32x16_bf16((a), (b), (c), 0, 0, 0)
#define DS_TR16(dst, addr, off) asm volatile("ds_read_b64_tr_b16 %0, %1 offset:%c2" : "=&v"(dst) : "v"(addr), "i"(off) : "memory")
#define DS_RD128(dst, addr, off) asm volatile("ds_read_b128 %0, %1 offset:%c2" : "=&v"(dst) : "v"(addr), "i"(off) : "memory")
#define LGKM0() asm volatile("s_waitcnt lgkmcnt(0)" ::: "memory")
#define SBAR() __builtin_amdgcn_sched_barrier(0)
__device__ __forceinline__ float max3f(float a, float b, float c) { float r; asm("v_max3_f32 %0, %1, %2, %3" : "=v"(r) : "v"(a), "v"(b), "v"(c)); return r; }
__device__ __forceinline__ void wait_vm(int n) {
    switch (n) {
#define WV(k) case k: asm volatile("s_waitcnt vmcnt(" #k ")" ::: "memory"); break;
        WV(1) WV(2) WV(3) WV(4) WV(5) WV(6) WV(7) WV(8) WV(9) WV(10) WV(12) WV(14) WV(15) WV(16) WV(18) WV(20)
#undef WV
        default: asm volatile("s_waitcnt vmcnt(0)" ::: "memory"); break;
    }
}

template <int DQK, int DV, int MODE>
__device__ __forceinline__ void attn_item(LAS unsigned char* lds, int item, const AttnCtx& cx) {
    constexpr int KP = DQK * 2 + 16, VP = DV * 2 + 64, KBY = 64 * KP, VBY = 64 * VP, HB = KBY + VBY;
    constexpr int NQF = DQK / 16, NDV = DV / 32, NKP = DQK / 32, NVP = DV / 32, KPR = DQK / 8, VPR = DV / 8;
    const int tid = otid(), lane = tid & 63, wave = __builtin_amdgcn_readfirstlane(tid >> 6), hf = wave >> 2, wq = wave & 3, r = lane & 31, h = lane >> 5, th = tid & 255;
    const bf16_t* __restrict__ P = cx.P;
    int head, tok0, seqbase, qcol, kcol, vcol, ntiles, qtok, S;
    int na_rows = 0, na_rs0 = 0, na_rq = 0, na_cq = 0, na_rsq = 0, na_csq = 0;
    int c_dlog = 0, c_rho = 0, c_l0 = 0, c_L = 0, c_lq = 0;
    if (MODE == 0) {
        head = item & 3; tok0 = (item >> 2) * 128; S = seq_len_of(cx.row0 + tok0); seqbase = ((cx.row0 + tok0) & ~(S - 1)) - cx.row0;
        qcol = COL_A_Q + head * 128 + hf * 64; kcol = COL_A_K + head * 128 + hf * 64; vcol = COL_A_V + head * 128; ntiles = S >> 6;
        qtok = tok0 + 32 * wq + r;
    } else if (MODE == 1) {
        const int unit = item * 2 + hf, nbk = cx.n >> 7; head = unit / nbk; tok0 = (unit - head * nbk) * 128; S = seq_len_of(cx.row0 + tok0); seqbase = ((cx.row0 + tok0) & ~(S - 1)) - cx.row0;
        qcol = COL_B_Q + head * 64; kcol = COL_B_K + head * 64; vcol = COL_B_V + head * 64; ntiles = 9;
        qtok = tok0 + 32 * wq + r;
        na_rows = S >> 6; const int r0 = (tok0 - seqbase) >> 6; na_rs0 = min(max(r0 - 4, 0), na_rows - 8);
        na_rq = r0 + (wq >> 1); na_cq = 32 * (wq & 1) + r; na_rsq = min(max(na_rq - 4, 0), na_rows - 8); na_csq = min(max(na_cq - 8, 0), 48);
    } else {
        const int unit = item * 2 + hf, nbk = cx.n >> 7; head = unit / nbk; const int blk = unit - head * nbk; tok0 = blk * 128; S = seq_len_of(cx.row0 + tok0); seqbase = ((cx.row0 + tok0) & ~(S - 1)) - cx.row0;
        qcol = COL_C_Q + head * 128; kcol = COL_C_K + head * 128; vcol = COL_C_V + head * 128; ntiles = 4;
        c_dlog = 2 * (head >> 2); const int b = (tok0 - seqbase) >> 7; c_rho = b & ((1 << c_dlog) - 1); c_l0 = (b >> c_dlog) * 128; c_L = S >> c_dlog;
        c_lq = c_l0 + 32 * wq + r; qtok = seqbase + (c_lq << c_dlog) + c_rho;
    }
    auto ktok = [&](int j, int kr) -> int {
        if (MODE == 0) return seqbase + 64 * j + kr;
        if (MODE == 1) return seqbase + min(na_rs0 + j, na_rows - 1) * 64 + kr;
        const int lk = min(max(c_l0 - 64 + 64 * j + kr, 0), c_L - 1); return seqbase + (lk << c_dlog) + c_rho;
    };
    const bool loadV = !(MODE == 0 && hf == 1);
#ifndef DMA_MODES
#define DMA_MODES 1
#endif
    constexpr bool DMA = ((DMA_MODES >> MODE) & 1) != 0;
    constexpr int NST = !DMA ? 2 : ((MODE == 0) ? 4 : ((MODE == 1) ? 3 : 2));
    constexpr bool ROT = DMA && (MODE == 0);
    constexpr int DIST = NST - 1, WAHEAD = ROT ? 1 : 0;
    const bool rot = ROT && (hf == 1);
    constexpr int SB = (MODE == 0) ? (2 * KBY + VBY) : (2 * HB);
    constexpr int KCH = KBY / 1024, VCH = VBY / 1024, LPWMAX = (KCH + VCH + 3) / 4;
    static_assert(KBY % 1024 == 0 && VBY % 1024 == 0 && NST * SB + (MODE == 1 ? 4096 : 0) <= LDS_BYTES - 16, "attention LDS ring");
    const int koff = (MODE == 0) ? hf * KBY : hf * HB, voff = (MODE == 0) ? 2 * KBY : hf * HB + KBY;
    const int nchh = KCH + (loadV ? VCH : 0);
    const int n_w = (nchh - wq + 3) >> 2;
    auto issue = [&](int j) {
        const int sbase = (j % NST) * SB;
#pragma unroll
        for (int i = 0; i < LPWMAX; ++i) {
            const int cid = wq + 4 * i;
            if (cid < nchh) {
                const bool isv = cid >= KCH; const int lc = isv ? cid - KCH : cid;
                const int pc = lc * 64 + lane, ppr = isv ? VP / 16 : KP / 16, row = pc / ppr, cp = pc - row * ppr;
                if (cp < (isv ? DV / 8 : DQK / 8)) {
                    const bf16_t* src = P + (size_t)ktok(j, row) * NIN + (isv ? vcol : kcol) + cp * 8;
                    __builtin_amdgcn_global_load_lds((const unsigned*)src, (LAS unsigned*)(lds + sbase + (isv ? voff : koff) + lc * 1024), 16, 0, 0);
                }
            }
        }
    };
    u32x4 kreg[DMA ? 1 : NKP], vreg[DMA ? 1 : NVP];
    auto gload = [&](int j) {
#pragma unroll
        for (int i = 0; i < NKP; ++i) { const int pid = th + 256 * i, row = pid / KPR, cp = pid % KPR; kreg[DMA ? 0 : i] = *(const u32x4*)(P + (size_t)ktok(j, row) * NIN + kcol + cp * 8); }
        if (loadV) {
#pragma unroll
            for (int i = 0; i < NVP; ++i) { const int pid = th + 256 * i, row = pid / VPR, cp = pid % VPR; vreg[DMA ? 0 : i] = *(const u32x4*)(P + (size_t)ktok(j, row) * NIN + vcol + cp * 8); }
        }
    };
    auto lstore = [&](int b) {
        LAS unsigned char* base = lds + b * SB;
#pragma unroll
        for (int i = 0; i < NKP; ++i) { const int pid = th + 256 * i, row = pid / KPR, cp = pid % KPR; *(LAS u32x4*)(base + koff + row * KP + cp * 16) = kreg[DMA ? 0 : i]; }
        if (loadV) {
#pragma unroll
            for (int i = 0; i < NVP; ++i) { const int pid = th + 256 * i, row = pid / VPR, cp = pid % VPR; *(LAS u32x4*)(base + voff + row * VP + cp * 16) = vreg[DMA ? 0 : i]; }
        }
    };
    LAS float* biasL = (LAS float*)(lds + NST * SB) + hf * 512;
    if (DMA) {
#pragma unroll
        for (int j0 = 0; j0 < DIST; ++j0) if (j0 < ntiles) issue(j0);
    } else gload(0);
    bf16x8 qf[NQF];
#pragma unroll
    for (int ks = 0; ks < NQF; ++ks) qf[ks] = *(const bf16x8*)(P + (size_t)qtok * NIN + qcol + 16 * ks + 8 * h);
    if (MODE == 1) { for (int i = th; i < 465; i += 256) biasL[i] = cx.rpb[head * 465 + i] * LOG2E; }
    f32x16 O[NDV];
#pragma unroll
    for (int d = 0; d < NDV; ++d)
#pragma unroll
        for (int i = 0; i < 16; ++i) O[d][i] = 0.f;
    float mhat = 0.f; bool first = true;
    f32x16 negm, Lacc;
#pragma unroll
    for (int i = 0; i < 16; ++i) { negm[i] = 0.f; Lacc[i] = 0.f; }
    const bf16x8 ones8 = {(short)0x3F80, (short)0x3F80, (short)0x3F80, (short)0x3F80, (short)0x3F80, (short)0x3F80, (short)0x3F80, (short)0x3F80};
    constexpr float THR = 6.f;
#pragma unroll
    for (int ks = 0; ks < NQF; ++ks) asm volatile("" : "+v"(qf[ks]));
    if (!DMA) { lstore(0); __syncthreads(); }
    else if (MODE == 1) __syncthreads();
    const int q4 = (lane & 15) >> 2, p4 = lane & 3, rblk = (lane >> 4) & 1;
    bf16x8 pa[2][2];
    s16x4 vlo[2][4], vhi[2][4];
    f32x16 s0, s1;
#define V_ISSUE(va, b, d) do { _Pragma("unroll") for (int k4 = 0; k4 < 4; ++k4) { DS_TR16(vlo[b][k4], va, (16 * k4) * VP + (d) * 64); DS_TR16(vhi[b][k4], va, (16 * k4 + 8) * VP + (d) * 64); } } while (0)
#define K_ISSUE(b, kb) do { DS_RD128(kfr[b][0], kaddr, (2 * (kb)) * 32); DS_RD128(kfr[b][1], kaddr, 32 * KP + (2 * (kb)) * 32); \
                            DS_RD128(kfr[b][2], kaddr, (2 * (kb) + 1) * 32); DS_RD128(kfr[b][3], kaddr, 32 * KP + (2 * (kb) + 1) * 32); } while (0)
    auto vaddr_of = [&](int j) -> unsigned { return (unsigned)(size_t)(lds + (j % NST) * SB + voff) + (4 * h + q4) * VP + (16 * rblk + 4 * p4) * 2; };
    auto do_qk = [&](int j, bool vpre) {
        const unsigned kaddr = (unsigned)(size_t)(lds + (j % NST) * SB + koff) + r * KP + 16 * h;
        const unsigned va = vaddr_of(j);
        bf16x8 kfr[1][4];
        K_ISSUE(0, 0);
#pragma unroll
        for (int kb = 0; kb < NQF / 2; ++kb) {
            LGKM0(); SBAR();
            if (kb == 0) { s0 = MFMA32(kfr[0][0], qf[0], negm); s1 = MFMA32(kfr[0][1], qf[0], negm); }
            else { s0 = MFMA32(kfr[0][0], qf[2 * kb], s0); s1 = MFMA32(kfr[0][1], qf[2 * kb], s1); }
            s0 = MFMA32(kfr[0][2], qf[2 * kb + 1], s0); s1 = MFMA32(kfr[0][3], qf[2 * kb + 1], s1);
            SBAR();
            if (kb + 1 < NQF / 2) K_ISSUE(0, kb + 1); else if (vpre) V_ISSUE(va, 0, 0);
        }
    };
    auto do_soft = [&](int j) {
        if (MODE == 1) {
            const int rk = na_rs0 + j; const int bbase = (rk - na_rq + 7) * 31 + 15 - na_cq;
#pragma unroll
            for (int i = 0; i < 16; ++i) {
                const int ck0 = crow(i, h), ck1 = ck0 + 32;
                const bool v0 = (ck0 >= na_csq) && (ck0 < na_csq + 16), v1 = (ck1 >= na_csq) && (ck1 < na_csq + 16);
                const float b0 = biasL[v0 ? bbase + ck0 : 0], b1 = biasL[v1 ? bbase + ck1 : 0];
                s0[i] = v0 ? s0[i] + b0 : NEGBIG; s1[i] = v1 ? s1[i] + b1 : NEGBIG;
            }
        }
        if (MODE == 2) {
            const int lk0 = c_l0 - 64 + 64 * j;
#pragma unroll
            for (int i = 0; i < 16; ++i) {
                const int lka = lk0 + crow(i, h), lkb = lka + 32;
                const bool v0 = (lka >= 0) && (lka < c_L) && (abs(lka - c_lq) <= 64), v1 = (lkb >= 0) && (lkb < c_L) && (abs(lkb - c_lq) <= 64);
                s0[i] = v0 ? s0[i] : NEGBIG; s1[i] = v1 ? s1[i] : NEGBIG;
            }
        }
        float mx = max3f(s0[0], s1[0], s0[1]);
        mx = max3f(mx, s1[1], s0[2]);
#pragma unroll
        for (int i = 2; i < 15; ++i) mx = max3f(mx, s1[i], s0[i + 1]);
        mx = fmaxf(mx, s1[15]);
        { auto rr = __builtin_amdgcn_permlane32_swap(__float_as_uint(mx), __float_as_uint(mx), false, false); mx = max3f(__uint_as_float(rr[0]), __uint_as_float(rr[1]), __uint_as_float(rr[0])); }
        if (first || __builtin_amdgcn_ballot_w64(mx > THR) != 0ull) {
            const float delta = first ? mx : fmaxf(mx, 0.f), alpha = fast_exp2(-delta);
#pragma unroll
            for (int i = 0; i < 16; ++i) { s0[i] -= delta; s1[i] -= delta; }
            if (!first) {
#pragma unroll
                for (int d = 0; d < NDV; ++d)
#pragma unroll
                    for (int i = 0; i < 16; ++i) O[d][i] *= alpha;
#pragma unroll
                for (int i = 0; i < 16; ++i) Lacc[i] *= alpha;
            }
            mhat += delta;
#pragma unroll
            for (int i = 0; i < 16; ++i) negm[i] = -mhat;
            first = false;
        }
#pragma unroll
        for (int i = 0; i < 16; ++i) { s0[i] = fast_exp2(s0[i]); s1[i] = fast_exp2(s1[i]); }
        u32x4 w;
        w.x = pk2(s0[0], s0[1]); w.y = pk2(s0[2], s0[3]); w.z = pk2(s0[4], s0[5]); w.w = pk2(s0[6], s0[7]); pa[0][0] = __builtin_bit_cast(bf16x8, w);
        w.x = pk2(s0[8], s0[9]); w.y = pk2(s0[10], s0[11]); w.z = pk2(s0[12], s0[13]); w.w = pk2(s0[14], s0[15]); pa[0][1] = __builtin_bit_cast(bf16x8, w);
        w.x = pk2(s1[0], s1[1]); w.y = pk2(s1[2], s1[3]); w.z = pk2(s1[4], s1[5]); w.w = pk2(s1[6], s1[7]); pa[1][0] = __builtin_bit_cast(bf16x8, w);
        w.x = pk2(s1[8], s1[9]); w.y = pk2(s1[10], s1[11]); w.z = pk2(s1[12], s1[13]); w.w = pk2(s1[14], s1[15]); pa[1][1] = __builtin_bit_cast(bf16x8, w);
    };
    auto do_pv = [&](unsigned va) {
#pragma unroll
        for (int k4 = 0; k4 < 4; ++k4) Lacc = MFMA32(ones8, pa[k4 >> 1][k4 & 1], Lacc);
#pragma unroll
        for (int d = 0; d < NDV; ++d) {
            LGKM0(); SBAR();
#pragma unroll
            for (int k4 = 0; k4 < 4; ++k4) {
                const bf16x8 vf = __builtin_shufflevector(vlo[d & 1][k4], vhi[d & 1][k4], 0, 1, 2, 3, 4, 5, 6, 7);
                O[d] = MFMA32(vf, pa[k4 >> 1][k4 & 1], O[d]);
            }
            SBAR();
            if (d + 1 < NDV) V_ISSUE(va, (d + 1) & 1, d + 1);
        }
    };
    for (int j = 0; j < ntiles; ++j) {
        if (DMA) {
            wait_vm(n_w * max(min(DIST - 1 - WAHEAD, ntiles - 1 - j - WAHEAD), 0));
            __builtin_amdgcn_s_barrier();
            SBAR();
            if (j + DIST < ntiles) issue(j + DIST);
        } else if (j + 1 < ntiles) gload(j + 1);
        bool active = true;
        if (MODE == 1) { const int rk = na_rs0 + j; active = (rk >= na_rsq) && (rk < na_rsq + 8); }
        if (MODE == 2) { const int lk0 = c_l0 - 64 + 64 * j; active = ((wq < 2) ? (j <= 2) : (j >= 1)) && (lk0 + 63 >= 0) && (lk0 < c_L); }
        if (active) {
            if (!rot || j == 0) do_qk(j, !rot);
            if (rot) V_ISSUE(vaddr_of(j), 0, 0);
            do_soft(j);
            do_pv(vaddr_of(j));
            if (rot && j + 1 < ntiles) do_qk(j + 1, false);
        }
        if (!DMA) { if (j + 1 < ntiles) lstore((j + 1) & 1); __syncthreads(); }
    }
#undef K_ISSUE
#undef V_ISSUE
    const float lt = Lacc[0];
    const float inv = 1.f / lt;
    __syncthreads();
    if (MODE == 0) {
        LAS float* X = (LAS float*)lds;
        if (hf == 1) {
#pragma unroll
            for (int d = 0; d < NDV; ++d)
#pragma unroll
                for (int g4 = 0; g4 < 4; ++g4) {
                    f32x4 v = {O[d][4 * g4] * inv, O[d][4 * g4 + 1] * inv, O[d][4 * g4 + 2] * inv, O[d][4 * g4 + 3] * inv};
                    *(LAS f32x4*)(X + (32 * wq + r) * 132 + 32 * d + 8 * g4 + 4 * h) = v;
                }
        }
        __syncthreads();
        if (hf == 0) {
            float ss = 0.f;
            const float lam = cx.lamp[cx.layer], oml = cx.lamp[2 + cx.layer];
#pragma unroll
            for (int d = 0; d < NDV; ++d)
#pragma unroll
                for (int g4 = 0; g4 < 4; ++g4) {
                    const f32x4 o2 = *(LAS const f32x4*)(X + (32 * wq + r) * 132 + 32 * d + 8 * g4 + 4 * h);
#pragma unroll
                    for (int e = 0; e < 4; ++e) { const float o = O[d][4 * g4 + e] * inv - lam * o2[e]; O[d][4 * g4 + e] = o; ss += o * o; }
                }
            ss += __shfl_xor(ss, 32);
            const float rstd = rsqrtf(ss * (1.f / 128.f) + EPS) * oml;
#pragma unroll
            for (int d = 0; d < NDV; ++d)
#pragma unroll
                for (int g4 = 0; g4 < 4; ++g4) {
                    const int dv = 32 * d + 8 * g4 + 4 * h;
                    const f32x4 gn = *(const f32x4*)(cx.subln + dv);
                    const u32x2 sz = *(const u32x2*)(P + (size_t)qtok * NIN + COL_Z + head * 128 + dv);
                    u32x2 o;
                    o.x = pk2(O[d][4 * g4] * rstd * gn[0] * bflo(sz.x), O[d][4 * g4 + 1] * rstd * gn[1] * bfhi(sz.x));
                    o.y = pk2(O[d][4 * g4 + 2] * rstd * gn[2] * bflo(sz.y), O[d][4 * g4 + 3] * rstd * gn[3] * bfhi(sz.y));
                    *(u32x2*)(cx.T + (size_t)qtok * 512 + head * 128 + dv) = o;
                }
        }
        __syncthreads();
    } else if (MODE == 1) {
#pragma unroll
        for (int d = 0; d < NDV; ++d)
#pragma unroll
            for (int g4 = 0; g4 < 4; ++g4) {
                const int dv = 32 * d + 8 * g4 + 4 * h;
                const u32x2 sz = *(const u32x2*)(P + (size_t)qtok * NIN + COL_Z + 512 + head * 64 + dv);
                u32x2 o;
                o.x = pk2(O[d][4 * g4] * inv * bflo(sz.x), O[d][4 * g4 + 1] * inv * bfhi(sz.x));
                o.y = pk2(O[d][4 * g4 + 2] * inv * bflo(sz.y), O[d][4 * g4 + 3] * inv * bfhi(sz.y));
                *(u32x2*)(cx.T + (size_t)TCMAX * 512 + (size_t)qtok * 512 + head * 64 + dv) = o;
            }
    } else {
#pragma unroll
        for (int d = 0; d < NDV; ++d)
#pragma unroll
            for (int g4 = 0; g4 < 4; ++g4) {
                const int dv = 32 * d + 8 * g4 + 4 * h;
                u32x2 o; o.x = pk2(O[d][4 * g4] * inv, O[d][4 * g4 + 1] * inv); o.y = pk2(O[d][4 * g4 + 2] * inv, O[d][4 * g4 + 3] * inv);
                *(u32x2*)(cx.OC + (size_t)qtok * 1536 + head * 128 + dv) = o;
            }
        if (h == 0) cx.LSE[(size_t)qtok * 12 + head] = mhat + __log2f(lt);
    }
}

__device__ __forceinline__ void phase_attn(LAS unsigned char* lds, const AttnCtx& cx) {
    const int G = gridDim.x, nb = cx.n >> 7;
    const int c = (G % 8 == 0) ? (int)(blockIdx.x & 7) * (G >> 3) + (int)(blockIdx.x >> 3) : (int)blockIdx.x;
    const int npb = (cx.row0 < NPROMPT) ? (NPROMPT - cx.row0) >> 7 : 0;
    for (int rep = 0; rep < (DUP_PH == 20 ? 2 : 1); ++rep)
    for (int it = c; it < nb * 4; it += G) {
        int tb, head;
        if (it < npb * 4) { const int sq = it >> 7, rem = it & 127; head = rem >> 5; tb = sq * 32 + (rem & 31); }
        else { const int i2 = it - npb * 4, sq = i2 >> 6, rem = i2 & 63; head = rem >> 4; tb = npb + sq * 16 + (rem & 15); }
        attn_item<64, 128, 0>(lds, tb * 4 + head, cx);
    }
    for (int rep = 0; rep < (DUP_PH == 21 ? 2 : 1); ++rep)
    for (int it = c; it < nb * 6; it += G) attn_item<128, 128, 2>(lds, it, cx);
    for (int rep = 0; rep < (DUP_PH == 22 ? 2 : 1); ++rep)
    for (int it = c; it < nb * 4; it += G) attn_item<64, 64, 1>(lds, it, cx);
}

__device__ __forceinline__ void phase_cmix(const bf16_t* __restrict__ P, const bf16_t* __restrict__ OC, const float* __restrict__ LSE, bf16_t* T2, int n) {
#pragma unroll 4
    for (int idx = blockIdx.x * NTHR + otid(); idx < n * 64; idx += gridDim.x * NTHR) {
        const int tok = idx >> 6, c8 = idx & 63, hh = c8 >> 4, dv = (c8 & 15) * 8;
        const float l0 = LSE[(size_t)tok * 12 + hh], l1 = LSE[(size_t)tok * 12 + 4 + hh], l2 = LSE[(size_t)tok * 12 + 8 + hh];
        const float mx = fmaxf(l0, fmaxf(l1, l2));
        float w0 = fast_exp2(l0 - mx), w1 = fast_exp2(l1 - mx), w2 = fast_exp2(l2 - mx);
        const float iw = 1.f / (w0 + w1 + w2); w0 *= iw; w1 *= iw; w2 *= iw;
        const u32x4 a = *(const u32x4*)(OC + (size_t)tok * 1536 + hh * 128 + dv), b = *(const u32x4*)(OC + (size_t)tok * 1536 + (4 + hh) * 128 + dv),
                    c = *(const u32x4*)(OC + (size_t)tok * 1536 + (8 + hh) * 128 + dv), z = *(const u32x4*)(P + (size_t)tok * NIN + COL_Z + 1024 + hh * 128 + dv);
        u32x4 o;
        o.x = pk2((w0 * bflo(a.x) + w1 * bflo(b.x) + w2 * bflo(c.x)) * bflo(z.x), (w0 * bfhi(a.x) + w1 * bfhi(b.x) + w2 * bfhi(c.x)) * bfhi(z.x));
        o.y = pk2((w0 * bflo(a.y) + w1 * bflo(b.y) + w2 * bflo(c.y)) * bflo(z.y), (w0 * bfhi(a.y) + w1 * bfhi(b.y) + w2 * bfhi(c.y)) * bfhi(z.y));
        o.z = pk2((w0 * bflo(a.z) + w1 * bflo(b.z) + w2 * bflo(c.z)) * bflo(z.z), (w0 * bfhi(a.z) + w1 * bfhi(b.z) + w2 * bfhi(c.z)) * bfhi(z.z));
        o.w = pk2((w0 * bflo(a.w) + w1 * bflo(b.w) + w2 * bflo(c.w)) * bflo(z.w), (w0 * bfhi(a.w) + w1 * bfhi(b.w) + w2 * bfhi(c.w)) * bfhi(z.w));
        *(u32x4*)(T2 + (size_t)tok * 512 + hh * 128 + dv) = o;
    }
}

#define XB_TMO      128
#define XB_XCNT(j)  (256  + 64 * (j))
#define XB_XSUB(j)  (1280 + 64 * (j))
#define XB_XGEN(j)  (2304 + 64 * (j))
#define XB_TOP      3328
#define XB_TOPGEN   3392
#define XCD_BAR_WORDS 3456
#define XB_SPIN_CAP (1u << 18)

__device__ __forceinline__ unsigned xb_ld(unsigned* p)              { return __hip_atomic_load(p, __ATOMIC_RELAXED, __HIP_MEMORY_SCOPE_AGENT); }
__device__ __forceinline__ unsigned xb_add(unsigned* p, unsigned v) { return __hip_atomic_fetch_add(p, v, __ATOMIC_RELAXED, __HIP_MEMORY_SCOPE_AGENT); }
__device__ __forceinline__ unsigned xb_xcc_id() { return (unsigned)__builtin_amdgcn_s_getreg((3 << 11) | 20) & 0xFu; }
#define XB_SPIN(cond, bar) do { unsigned _sp = 0; while (cond) { __builtin_amdgcn_s_sleep(1); \
    if ((++_sp & 255u) == 0u) { if (xb_ld(&(bar)[XB_TMO])) break; if (_sp > XB_SPIN_CAP) { atomicAdd(&(bar)[XB_TMO], 1u); break; } } } } while (0)

struct XcdBarrier {
    unsigned* bar; unsigned x;
    volatile LAS unsigned* st;
};

__device__ __forceinline__ XcdBarrier xcd_barrier_post(unsigned* bar, volatile LAS unsigned* st) {
    XcdBarrier b; b.bar = bar; b.x = xb_xcc_id(); b.st = st;
    if (threadIdx.x == 0) (void)xb_add(&bar[XB_XCNT(b.x)], 1u);
    return b;
}
__device__ __forceinline__ void xcd_barrier_complete(unsigned* bar, unsigned x, unsigned& nloc, unsigned& nx) {
    const unsigned G = gridDim.x * gridDim.y * gridDim.z;
    unsigned sum, cnt, mine, sp = 0u;
    for (;;) {
        sum = 0u; cnt = 0u; mine = 0u;
#pragma unroll
        for (unsigned j = 0; j < 16; ++j) { const unsigned c = xb_ld(&bar[XB_XCNT(j)]); sum += c; cnt += (c > 0u) ? 1u : 0u; mine = (j == x) ? c : mine; }
        if (sum == G) break;
        __builtin_amdgcn_s_sleep(1);
        if ((++sp & 255u) == 0u) { if (xb_ld(&bar[XB_TMO])) break; if (sp > XB_SPIN_CAP) { atomicAdd(&bar[XB_TMO], 1u); break; } }
    }
    nloc = mine > 0u ? mine : 1u; nx = cnt > 0u ? cnt : 1u;
}

__device__ __forceinline__ void xcd_barrier(const XcdBarrier& b) {
    asm volatile("s_waitcnt vmcnt(0)" ::: "memory");
    __syncthreads();
    if (threadIdx.x == 0) {
        unsigned* bar = b.bar;
        __builtin_amdgcn_s_waitcnt(0);
        unsigned nloc = b.st[0], nx = b.st[1];
        if (nloc == 0u) { xcd_barrier_complete(bar, b.x, nloc, nx); b.st[0] = nloc; b.st[1] = nx; }
        const unsigned old = xb_add(&bar[XB_XSUB(b.x)], 1u);
        const unsigned gen = old / nloc;
        if (old + 1u == (gen + 1u) * nloc) {
            __builtin_amdgcn_fence(__ATOMIC_RELEASE, "agent");
            asm volatile("s_waitcnt vmcnt(0)" ::: "memory");
            const unsigned og = xb_add(&bar[XB_TOP], 1u);
            const unsigned tg = og / nx;
            if (og + 1u == (tg + 1u) * nx) xb_add(&bar[XB_TOPGEN], 1u);
            else XB_SPIN(xb_ld(&bar[XB_TOPGEN]) == tg, bar);
            __builtin_amdgcn_fence(__ATOMIC_ACQUIRE, "agent");
            xb_add(&bar[XB_XGEN(b.x)], 1u);
            asm volatile("s_waitcnt vmcnt(0)" ::: "memory");
        } else {
            XB_SPIN(xb_ld(&bar[XB_XGEN(b.x)]) == gen, bar);
            __builtin_amdgcn_fence(__ATOMIC_ACQUIRE, "agent");
            asm volatile("s_waitcnt vmcnt(0)" ::: "memory");
        }
    }
    __syncthreads();
}

#ifndef ONE_LAUNCH
#define ONE_LAUNCH 1
#endif

__global__ void __launch_bounds__(NTHR, 2) mega(Params p) {
    extern __shared__ __attribute__((aligned(16))) unsigned char lds_raw[];
    LAS unsigned char* lds = (LAS unsigned char*)lds_raw;
    unsigned char* ws = p.ws;
    volatile LAS unsigned* bst = (volatile LAS unsigned*)(lds + LDS_BYTES - 16);
    if (threadIdx.x < 2) bst[threadIdx.x] = 0u;
    __syncthreads();
    XcdBarrier bar; bar.bar = (unsigned*)(ws + WS_BAR); bar.x = 0; bar.st = bst;
    if (p.ph_hi - p.ph_lo > 1) bar = xcd_barrier_post((unsigned*)(ws + WS_BAR), bst);
    bf16_t* P = (bf16_t*)(ws + WS_P); bf16_t* T = (bf16_t*)(ws + WS_T); bf16_t* H = T; bf16_t* OC = (bf16_t*)(ws + WS_OC); float* LSE = (float*)(ws + WS_LSE);
    for (int ph = p.ph_lo; ph < p.ph_hi; ++ph) {
        if (ph > p.ph_lo) { if (ph == 1) cg::this_grid().sync(); else xcd_barrier(bar); }
        if (ph == 0) { phase_pre(p, lds); phase_prew(p, lds, 0); continue; }
        if (ph == 1) { phase_h(p, 0, 0, H); continue; }
        if (ph == 17) { phase_prew(p, lds, 1); phase_h(p, 0, 1, H); continue; }
        const int l = (ph > 17) ? 1 : 0, q = ph - (l ? 18 : 2), c = q / 5, k = q - c * 5;
        const int row0 = chunk_row0(c), n = chunk_rows(c);
        const float* mod_l = (const float*)(ws + WS_MOD) + (size_t)l * NSEQ * 3072;
        if (k == 0) {
            pg8::Gemm g{H, (const bf16_t*)(ws + WS_WIN), n, NIN, DM, DM};
            pg8::StaticOrder So; So.init(n, NIN, (int)gridDim.x, (int)blockIdx.x);
            EpiIn E{P, (const float*)(ws + WS_COSA), (const float*)(ws + WS_SINA), (const float*)(ws + WS_COSC), (const float*)(ws + WS_SINC),
                    (const float*)(ws + WS_GAIN) + l * 6 * 128, row0, (LAS float*)(lds + XCH_OFF)};
            pg8::gemm_phase<EpiIn, pg8::StaticOrder, true, true>(lds, g, So, E);
        } else if (k == 1) {
            const float* L = (const float*)(ws + WS_LAM);
            AttnCtx cx{P, T, OC, LSE, p.in[14] + l * 128, p.in[17] + (size_t)l * 8 * 465, L, l, row0, n};
            phase_attn(lds, cx);
        } else if (k == 2) {
            phase_cmix(P, OC, LSE, T + (size_t)2 * TCMAX * 512, n);
        } else if (k == 3) {
            pg8::Gemm g{T, (const bf16_t*)(ws + WS_WBR), 3 * TCMAX, 3072, 512, 512};
            BrOrder So{(int)gridDim.x, (int)blockIdx.x, (n >> 8) * 4};
            EpiBr E{P};
            pg8::gemm_phase<EpiBr, BrOrder, true, true>(lds, g, So, E);
        } else {
            pg8::Gemm g{P, (const bf16_t*)(ws + WS_WOUT), n, DM, DM, NIN};
            pg8::StaticOrder So; So.init(n, DM, (int)gridDim.x, (int)blockIdx.x);
            EpiOut E{p.in[0], p.in[1], p.out, mod_l, row0, l};
            pg8::gemm_phase<EpiOut, pg8::StaticOrder, true, true>(lds, g, So, E);
            if (c < 2) phase_h(p, c + 1, l, H);
        }
    }
}

extern "C" void kernel_launch(void* const* d_in, const int* in_sizes, int n_in, void* d_out, int out_size, void* d_ws, size_t ws_size, hipStream_t stream) {
    static int grid = 0;
    if (grid == 0) {
        if (n_in != 22 || ws_size < WS_END) { fprintf(stderr, "kernel_launch: unexpected n_in %d / ws_size %zu (need %zu)\n", n_in, ws_size, (size_t)WS_END); grid = -1; return; }
        int dev = 0, cus = 0, per_cu = 0;
        (void)hipGetDevice(&dev); (void)hipDeviceGetAttribute(&cus, hipDeviceAttributeMultiprocessorCount, dev);
        if (hipFuncSetAttribute((const void*)mega, hipFuncAttributeMaxDynamicSharedMemorySize, LDS_BYTES) != hipSuccess) { fprintf(stderr, "kernel_launch: hipFuncSetAttribute failed\n"); grid = -1; return; }
        (void)hipOccupancyMaxActiveBlocksPerMultiprocessor(&per_cu, (const void*)mega, NTHR, LDS_BYTES);
        if (per_cu < 1) { fprintf(stderr, "kernel_launch: occupancy query says %d blocks per CU\n", per_cu); per_cu = 1; }
        (void)hipGetLastError();
        grid = cus;
    }
    if (grid < 0) return;
    Params p{};
    for (int i = 0; i < 22; ++i) p.in[i] = (const float*)d_in[i];
    p.out = (float*)d_out; p.ws = (unsigned char*)d_ws;
#if ONE_LAUNCH
    if (hipMemsetAsync((char*)d_ws + WS_BAR, 0, 16384, stream) != hipSuccess) { fprintf(stderr, "kernel_launch: memset failed\n"); return; }
    p.ph_lo = 0; p.ph_hi = NPHASE;
    void* args[] = {&p};
    hipError_t e = hipLaunchCooperativeKernel((const void*)mega, dim3(grid), dim3(NTHR), args, LDS_BYTES, stream);
    if (e != hipSuccess) fprintf(stderr, "cooperative launch failed: %s (grid %d)\n", hipGetErrorString(e), grid);
#else
    for (int ph = 0; ph < NPHASE; ++ph) {
        p.ph_lo = ph; p.ph_hi = ph + 1;
        hipLaunchKernelGGL(mega, dim3(grid), dim3(NTHR), LDS_BYTES, stream, p);
    }
#endif
}
```

```cpp
#include <hip/hip_runtime.h>
#include <hip/hip_cooperative_groups.h>
#include <cstdio>
#include <cstdint>
namespace cg = cooperative_groups;
__device__ __forceinline__ int otid() { int t = threadIdx.x; asm volatile("" : "+v"(t)); return t; }
namespace pg8 {
#define PG8_LAS __attribute__((address_space(3)))
typedef unsigned short bf16_t;
typedef short bf16x8 __attribute__((ext_vector_type(8)));
typedef float f32x4 __attribute__((ext_vector_type(4)));
typedef unsigned u32x4 __attribute__((ext_vector_type(4)));
constexpr int BM = 256, BK = 64, HALF = 128, HTB = HALF * BK * 2  , STAGE_BYTES = 8 * HTB, NXCD = 8, WGM = 4;

__host__ __device__ __forceinline__ int lds_byte(int r, int c) { const int st = (r >> 4) * 2 + (c >> 5), rr = r & 15, cc = c & 31, ob = rr * 64 + cc * 2; return st * 1024 + (ob ^ (((ob >> 9) & 1) << 5)); }
__host__ __device__ __forceinline__ void stage_rc(int b, int& R, int& C) { const int st = b / 1024, sb = b % 1024, swz = sb ^ (((sb >> 9) & 1) << 5); R = (st >> 1) * 16 + swz / 64; C = (st & 1) * 32 + (swz % 64) / 2; }
__host__ __device__ __forceinline__ int perm32(int rho) { const int n = rho >> 4, i = rho & 15; return 8 * (i >> 2) + 4 * n + (i & 3); }

struct Unit { int pm, pn; };
struct Gemm { const bf16_t* A; const bf16_t* Bt; int M, N, K, lda; };

struct StaticOrder {
    int nM, nN, nwg, G, c;
    __host__ __device__ void init(int M, int N, int G_, int c_) { nM = M / BM; nN = N / BM; nwg = nM * nN; G = G_; c = c_; }
    __host__ __device__ bool next(int i, Unit& u) const {
        const long L = (long)i * G + c; if (L >= nwg) return false;
        int wgid = (int)L; { const int q = nwg / NXCD, r = nwg % NXCD, xcd = wgid % NXCD, off = wgid / NXCD; wgid = (xcd < r ? xcd * (q + 1) : r * (q + 1) + (xcd - r) * q) + off; }
        const int nig = WGM * nN, gid = wgid / nig, fm = gid * WGM, gsz = (nM - fm) < WGM ? (nM - fm) : WGM;
        u.pm = fm + ((wgid % nig) % gsz); u.pn = (wgid % nig) / gsz; return true;
    }
    __device__ __forceinline__ void a_ready(const Unit&) const {}
    __device__ __forceinline__ void done(const Unit&) const {}
};

__device__ __forceinline__ unsigned cvt_pk_bf16(float lo, float hi) { unsigned r; asm volatile("v_cvt_pk_bf16_f32 %0, %1, %2" : "=v"(r) : "v"(lo), "v"(hi)); return r; }

template <class Epi, class Sched, bool ALIGN_EPI = false, bool SP2 = false>
__device__ __forceinline__ void gemm_phase(PG8_LAS unsigned char* lds, const Gemm g, const Sched& S, const Epi& E) {
    const int tid = otid(), wid = __builtin_amdgcn_readfirstlane(tid >> 6), lane = tid & 63, wr = wid >> 2, wc = wid & 3, fr = lane & 15, fq = lane >> 4;
    const int K = g.K, nt = K / BK;
    unsigned voffA[2], voffB[2];
#pragma unroll
    for (int i = 0; i < 2; ++i) { int R, C; stage_rc(tid * 16 + i * 8192, R, C); const int Rb = Epi::PERM ? ((R & ~31) + perm32(R & 31)) : R;
        voffA[i] = (unsigned)(R * g.lda + C) * 2u; voffB[i] = (unsigned)(Rb * K + C) * 2u; }
    const size_t kstep = (size_t)(BK * 2);
    const size_t hstep = (size_t)HALF * K * 2;
    const size_t tstep = 2 * hstep;
    const size_t hstepA = (size_t)HALF * g.lda * 2, tstepA = 2 * hstepA;
    const unsigned ldsw = (unsigned)wid * 1024u;
    const int aoff = lds_byte(wr * 64 + fr, fq * 8), boff = lds_byte(wc * 32 + fr, fq * 8);
#define PG8_SA(b, h) (((b) * 2 + (h)) * HTB)
#define PG8_SB(b, h) ((4 + (b) * 2 + (h)) * HTB)
#define PG8_STAGE(bufoff, gbase, voff) do { _Pragma("unroll") for (int _i = 0; _i < 2; ++_i) \
        __builtin_amdgcn_global_load_lds((const unsigned*)((const char*)(gbase) + (voff)[_i]), (PG8_LAS unsigned*)(lds + (bufoff) + ldsw + _i * 8192), 16, 0, 0); } while (0)
#define PG8_LDA(dst, b, h) do { _Pragma("unroll") for (int m = 0; m < 4; ++m) _Pragma("unroll") for (int k = 0; k < 2; ++k) dst[m][k] = *(const PG8_LAS bf16x8*)(lds + PG8_SA(b, h) + aoff + m * 2048 + k * 1024); } while (0)
#define PG8_LDB(dst, b, h) do { _Pragma("unroll") for (int n = 0; n < 2; ++n) _Pragma("unroll") for (int k = 0; k < 2; ++k) dst[n][k] = *(const PG8_LAS bf16x8*)(lds + PG8_SB(b, h) + boff + n * 2048 + k * 1024); } while (0)
#define PG8_MMA(ai, bj, At, Bt) do { __builtin_amdgcn_s_setprio(1); _Pragma("unroll") for (int m = 0; m < 4; ++m) _Pragma("unroll") for (int n = 0; n < 2; ++n) _Pragma("unroll") for (int k = 0; k < 2; ++k) \
        acc[ai][bj][m][n] = __builtin_amdgcn_mfma_f32_16x16x32_bf16(Bt[n][k], At[m][k], acc[ai][bj][m][n], 0, 0, 0); __builtin_amdgcn_s_setprio(0); } while (0)
#define PG8_WAIT_V(n) asm volatile("s_waitcnt vmcnt(" #n ")" ::: "memory")
#define PG8_WAIT_L(n) asm volatile("s_waitcnt lgkmcnt(" #n ")" ::: "memory")
#define PG8_BAR __builtin_amdgcn_s_barrier()
#define PG8_SCHED __builtin_amdgcn_sched_barrier(0)
    Unit cur, nxt; int ui = 0;
    if (!S.next(0, cur)) return;
    f32x4 acc[2][2][4][2];
#pragma unroll
    for (int a = 0; a < 2; ++a)
#pragma unroll
        for (int b = 0; b < 2; ++b)
#pragma unroll
            for (int m = 0; m < 4; ++m)
#pragma unroll
                for (int n = 0; n < 2; ++n) acc[a][b][m][n] = (f32x4){0.f, 0.f, 0.f, 0.f};
    bf16x8 At[4][2], B0[2][2], B1[2][2];
    const char* cA = (const char*)g.A + (size_t)cur.pm * tstepA; const char* cB = (const char*)g.Bt + (size_t)cur.pn * tstep;
    S.a_ready(cur);
    if constexpr (SP2) {
        PG8_STAGE(PG8_SB(0, 0), cB, voffB); PG8_STAGE(PG8_SB(0, 1), cB + hstep, voffB); PG8_STAGE(PG8_SA(0, 0), cA, voffA); PG8_STAGE(PG8_SA(0, 1), cA + hstepA, voffA);
        if (wr == 1) PG8_BAR;
        PG8_WAIT_V(2); PG8_BAR;
        PG8_STAGE(PG8_SB(1, 0), cB + kstep, voffB); PG8_STAGE(PG8_SA(1, 0), cA + kstep, voffA); PG8_STAGE(PG8_SB(1, 1), cB + hstep + kstep, voffB);
        PG8_WAIT_V(6); PG8_BAR;
    } else {
        PG8_STAGE(PG8_SB(0, 0), cB, voffB); PG8_STAGE(PG8_SA(0, 0), cA, voffA); PG8_STAGE(PG8_SB(0, 1), cB + hstep, voffB); PG8_STAGE(PG8_SA(0, 1), cA + hstepA, voffA);
        if (wr == 1) PG8_BAR;
        PG8_WAIT_V(4); PG8_BAR;
        PG8_STAGE(PG8_SB(1, 0), cB + kstep, voffB); PG8_STAGE(PG8_SA(1, 0), cA + kstep, voffA); PG8_STAGE(PG8_SB(1, 1), cB + hstep + kstep, voffB);
        PG8_WAIT_V(6); PG8_BAR;
    }
    for (;;) {
        const bool has_next = S.next(ui + 1, nxt);
        const char* nA = has_next ? (const char*)g.A + (size_t)nxt.pm * tstepA : cA; const char* nB = has_next ? (const char*)g.Bt + (size_t)nxt.pn * tstep : cB;
        for (int t = 0; t < nt; t += 2) {
            const bool last = (t == nt - 2);
            const char* a1 = cA + (size_t)(t + 1) * kstep;
            const char* a2 = last ? nA : cA + (size_t)(t + 2) * kstep; const char* b2 = last ? nB : cB + (size_t)(t + 2) * kstep;
            const char* a3 = a2 + kstep; const char* b3 = b2 + kstep;
            if (last && has_next) S.a_ready(nxt);
            if constexpr (SP2) {
            PG8_LDB(B0, 0, 0); PG8_LDB(B1, 0, 1); PG8_SCHED; PG8_LDA(At, 0, 0); PG8_STAGE(PG8_SA(1, 1), a1 + hstepA, voffA);
            PG8_WAIT_V(8); PG8_WAIT_L(0); PG8_BAR; PG8_MMA(0, 0, At, B0); PG8_MMA(0, 1, At, B1); PG8_BAR; PG8_SCHED;
            PG8_LDA(At, 0, 1); PG8_STAGE(PG8_SB(0, 0), b2, voffB); PG8_STAGE(PG8_SB(0, 1), b2 + hstep, voffB); PG8_STAGE(PG8_SA(0, 0), a2, voffA);
            PG8_WAIT_V(8); PG8_WAIT_L(0); PG8_BAR; PG8_MMA(1, 0, At, B0); PG8_MMA(1, 1, At, B1); PG8_BAR; PG8_SCHED;
            PG8_LDB(B0, 1, 0); PG8_LDB(B1, 1, 1); PG8_SCHED; PG8_LDA(At, 1, 0); PG8_STAGE(PG8_SA(0, 1), a2 + hstepA, voffA);
            PG8_WAIT_V(8); PG8_WAIT_L(0); PG8_BAR; PG8_MMA(0, 0, At, B0); PG8_MMA(0, 1, At, B1); PG8_BAR; PG8_SCHED;
            PG8_LDA(At, 1, 1); PG8_STAGE(PG8_SB(1, 0), b3, voffB); PG8_STAGE(PG8_SB(1, 1), b3 + hstep, voffB); PG8_STAGE(PG8_SA(1, 0), a3, voffA);
            PG8_WAIT_V(8); PG8_WAIT_L(0); PG8_BAR; PG8_MMA(1, 0, At, B0); PG8_MMA(1, 1, At, B1); PG8_BAR; PG8_SCHED;
            } else {
            PG8_LDB(B0, 0, 0); PG8_SCHED; PG8_LDA(At, 0, 0); PG8_STAGE(PG8_SA(1, 1), a1 + hstepA, voffA);
            PG8_WAIT_L(8); PG8_BAR; PG8_WAIT_L(0); PG8_MMA(0, 0, At, B0); PG8_BAR; PG8_SCHED;
            PG8_LDB(B1, 0, 1); PG8_STAGE(PG8_SB(0, 0), b2, voffB);
            PG8_BAR; PG8_WAIT_L(0); PG8_MMA(0, 1, At, B1); PG8_BAR;
            PG8_LDA(At, 0, 1); PG8_STAGE(PG8_SA(0, 0), a2, voffA);
            PG8_BAR; PG8_WAIT_L(0); PG8_MMA(1, 0, At, B0); PG8_BAR; PG8_SCHED;
            PG8_STAGE(PG8_SB(0, 1), b2 + hstep, voffB);
            PG8_WAIT_V(6); PG8_BAR; PG8_MMA(1, 1, At, B1); PG8_BAR;
            PG8_LDB(B0, 1, 0); PG8_SCHED; PG8_LDA(At, 1, 0); PG8_STAGE(PG8_SA(0, 1), a2 + hstepA, voffA);
            PG8_WAIT_L(8); PG8_BAR; PG8_WAIT_L(0); PG8_MMA(0, 0, At, B0); PG8_BAR; PG8_SCHED;
            PG8_LDB(B1, 1, 1); PG8_STAGE(PG8_SB(1, 0), b3, voffB);
            PG8_BAR; PG8_WAIT_L(0); PG8_MMA(0, 1, At, B1); PG8_BAR;
            PG8_LDA(At, 1, 1); PG8_STAGE(PG8_SA(1, 0), a3, voffA);
            PG8_BAR; PG8_WAIT_L(0); PG8_MMA(1, 0, At, B0); PG8_BAR; PG8_SCHED;
            PG8_STAGE(PG8_SB(1, 1), b3 + hstep, voffB);
            PG8_WAIT_V(6); PG8_BAR; PG8_MMA(1, 1, At, B1); PG8_BAR;
            }
        }
        if constexpr (ALIGN_EPI) { if (wr == 0) PG8_BAR; }
        if constexpr (!Epi::AFTER_DRAIN) { E(acc, cur, wr, wc, fr, fq); S.done(cur); }
        if (!has_next) break;
        if (!E.keep(cur)) {
#pragma unroll
        for (int a = 0; a < 2; ++a)
#pragma unroll
            for (int b = 0; b < 2; ++b)
#pragma unroll
                for (int m = 0; m < 4; ++m)
#pragma unroll
                    for (int n = 0; n < 2; ++n) acc[a][b][m][n] = (f32x4){0.f, 0.f, 0.f, 0.f};
        }
        cur = nxt; cA = nA; cB = nB; ++ui;
        if constexpr (ALIGN_EPI) { if (wr == 1) PG8_BAR; }
    }
    PG8_WAIT_V(0);
    if constexpr (!ALIGN_EPI) { if (wr == 0) PG8_BAR; }
    PG8_BAR;
    if constexpr (Epi::AFTER_DRAIN) { E.fused(acc, cur, wr, wc, fr, fq, lds, wid, lane); S.done(cur); }
#undef PG8_SA
#undef PG8_SB
#undef PG8_STAGE
#undef PG8_LDA
#undef PG8_LDB
#undef PG8_MMA
#undef PG8_WAIT_V
#undef PG8_WAIT_L
#undef PG8_BAR
#undef PG8_SCHED
}
}

#define LAS __attribute__((address_space(3)))
#ifndef PH_MASK
#define PH_MASK 0xFFF
#endif
#ifndef DUP_PH
#define DUP_PH -1
#endif
typedef unsigned short bf16_t;
typedef short bf16x8 __attribute__((ext_vector_type(8)));
typedef short s16x4 __attribute__((ext_vector_type(4)));
typedef short v4i16_t __attribute__((ext_vector_type(4)));
typedef float f32x2 __attribute__((ext_vector_type(2)));
typedef float f32x4 __attribute__((ext_vector_type(4)));
typedef float f32x16 __attribute__((ext_vector_type(16)));
typedef unsigned u32x2 __attribute__((ext_vector_type(2)));
typedef unsigned u32x4 __attribute__((ext_vector_type(4)));
typedef __bf16 bf16x2_t __attribute__((ext_vector_type(2)));

constexpr int DM = 1024, NIN = 12288, TCMAX = 32768, NCHUNK = 3, NSEQ = 36, NTHR = 512, NPROMPT = 16384;
__device__ __forceinline__ int chunk_row0(int c) { return c * 32768; }
__device__ __forceinline__ int chunk_rows(int c) { return c == 2 ? 16384 : 32768; }
__device__ __forceinline__ int seq_len_of(int g) { return g < NPROMPT ? 4096 : 2048; }
__device__ __forceinline__ int seq_of(int g) { return g < NPROMPT ? (g >> 12) : 4 + ((g - NPROMPT) >> 11); }
constexpr int COL_A_Q = 0, COL_A_K = 512, COL_A_V = 1024, COL_B_Q = 1536, COL_B_K = 2048, COL_B_V = 2560, COL_C_Q = 3072, COL_C_K = 4608,
              COL_C_V = 6144, COL_Z = 7680, COL_G = 9216;
constexpr float EPS = 1e-6f, LOG2E = 1.4426950408889634f, NEGBIG = -1e30f;

constexpr size_t WS_WIN = 0;
constexpr size_t WS_WBR = WS_WIN + (size_t)NIN * DM * 2;
constexpr size_t WS_WOUT = WS_WBR + 3072ull * 512 * 2;
constexpr size_t WS_MOD = WS_WOUT + (size_t)DM * DM * 2;
constexpr size_t WS_COSA = WS_MOD + 2ull * NSEQ * 3072 * 4;
constexpr size_t WS_SINA = WS_COSA + 4096ull * 32 * 4;
constexpr size_t WS_COSC = WS_SINA + 4096ull * 32 * 4;
constexpr size_t WS_SINC = WS_COSC + 4096ull * 64 * 4;
constexpr size_t WS_LAM = WS_SINC + 4096ull * 64 * 4;
constexpr size_t WS_GAIN = WS_LAM + 256;
constexpr size_t WS_BAR = WS_GAIN + 2 * 6 * 128 * 4;
constexpr size_t WS_P = WS_BAR + 16384;
constexpr size_t WS_T = WS_P + (size_t)TCMAX * NIN * 2;
constexpr size_t WS_OC = WS_T + 3ull * TCMAX * 512 * 2;
constexpr size_t WS_LSE = WS_OC + (size_t)TCMAX * 1536 * 2;
constexpr size_t WS_END = WS_LSE + (size_t)TCMAX * 12 * 4;

constexpr int LDS_BYTES = 159744;
constexpr int XCH_OFF = 131072;
constexpr int NPHASE = 2 + 15 + 1 + 15;

struct Params { const float* in[22]; float* out; unsigned char* ws; int ph_lo, ph_hi; };

__device__ __forceinline__ unsigned pk2(float lo, float hi) { f32x2 v = {lo, hi}; bf16x2_t b = __builtin_convertvector(v, bf16x2_t); return __builtin_bit_cast(unsigned, b); }
__device__ __forceinline__ float bflo(unsigned u) { return __uint_as_float(u << 16); }
__device__ __forceinline__ float bfhi(unsigned u) { return __uint_as_float(u & 0xffff0000u); }
__device__ __forceinline__ float wave_sum(float v) {
#pragma unroll
    for (int o = 32; o >= 1; o >>= 1) v += __shfl_xor(v, o);
    return v;
}
__device__ __forceinline__ float fast_exp2(float x) { return __builtin_amdgcn_exp2f(x); }
__device__ __forceinline__ float sigmoidf_(float x) { return __builtin_amdgcn_rcpf(1.f + __builtin_amdgcn_exp2f(x * -1.4426950408889634f)); }
__device__ __forceinline__ float siluf_(float x) { return x * sigmoidf_(x); }

__host__ __device__ __forceinline__ int tile_type(int pn) {
    if (pn < 4) return 1; if (pn < 6) return 0; if (pn < 10) return 2; if (pn < 12) return 0; if (pn < 24) return 3; if (pn < 30) return 0; if (pn < 36) return 4; return 5;
}
__device__ __forceinline__ int phys_row(int col) {
    const int pn = col >> 8, lc = col & 255, ty = tile_type(pn);
    if (ty == 1 || ty == 2) { const int wc = (lc >> 6) & 3, bj = (lc >> 5) & 1, rest = lc & 31; return (pn << 8) + 128 * bj + 32 * wc + rest; }
    if (ty == 3) { const int hh = lc >> 7, bj = (lc >> 6) & 1, w0 = (lc >> 5) & 1, rest = lc & 31; return (pn << 8) + 128 * bj + 32 * (2 * hh + w0) + rest; }
    return col;
}

__device__ __forceinline__ void transpose_item(const float* __restrict__ W, int K, int N, bf16_t* Bt, int kt, int nt, bool perm, LAS float* tile) {
    const int t = otid(), k0 = kt * 64, n0 = nt * 64;
#pragma unroll
    for (int i = 0; i < 8; ++i) { const int k = i * 8 + (t >> 6), n = t & 63; tile[k * 65 + n] = W[(size_t)(k0 + k) * N + n0 + n]; }
    __syncthreads();
    const int n = t >> 3, kk = (t & 7) * 8;
    u32x4 w;
    w.x = pk2(tile[(kk + 0) * 65 + n], tile[(kk + 1) * 65 + n]); w.y = pk2(tile[(kk + 2) * 65 + n], tile[(kk + 3) * 65 + n]);
    w.z = pk2(tile[(kk + 4) * 65 + n], tile[(kk + 5) * 65 + n]); w.w = pk2(tile[(kk + 6) * 65 + n], tile[(kk + 7) * 65 + n]);
    const int col = n0 + n, row = perm ? phys_row(col) : col;
    *(u32x4*)(Bt + (size_t)row * K + k0 + kk) = w;
    __syncthreads();
}

__device__ __forceinline__ void mod_item(const Params& p, int item, LAS float* sc) {
    const int l = item / 48, cb = item % 48, t = otid();
    const float* cp = p.in[2]; const float* cs = p.in[3];
    for (int i = t; i < NSEQ * 1024; i += NTHR) { const int s = i >> 10, k = i & 1023; const float c = (s < 4) ? cp[s * 1024 + k] : cs[(s - 4) * 1024 + k]; sc[i] = siluf_(c); }
    __syncthreads();
    const int col = t & 63, ks = t >> 6;
    const float* w = p.in[5] + (size_t)l * 1024 * 3072 + cb * 64 + col;
    float acc[NSEQ];
#pragma unroll
    for (int s = 0; s < NSEQ; ++s) acc[s] = 0.f;
    for (int k = ks * 128; k < ks * 128 + 128; ++k) {
        const float wv = w[(size_t)k * 3072];
#pragma unroll
        for (int s = 0; s < NSEQ; ++s) acc[s] += sc[s * 1024 + k] * wv;
    }
    __syncthreads();
#pragma unroll
    for (int s = 0; s < NSEQ; ++s) sc[(ks * NSEQ + s) * 64 + col] = acc[s];
    __syncthreads();
    float* mod = (float*)(p.ws + WS_MOD) + (size_t)l * NSEQ * 3072;
    const float* b = p.in[6] + (size_t)l * 3072;
    for (int i = t; i < NSEQ * 64; i += NTHR) {
        const int s = i >> 6, c = i & 63; float v = 0.f;
#pragma unroll
        for (int q = 0; q < 8; ++q) v += sc[(q * NSEQ + s) * 64 + c];
        mod[s * 3072 + cb * 64 + c] = v + b[cb * 64 + c];
    }
    __syncthreads();
}

__device__ __forceinline__ void phase_prew(const Params& p, LAS unsigned char* lds, int l) {
    LAS float* scr = (LAS float*)lds;
    const int G = gridDim.x, bid = blockIdx.x;
    constexpr int N_WIN = 16 * 192, N_WBR = 3 * 8 * 16, N_WOUT = 16 * 16, PER_L = N_WIN + N_WBR + N_WOUT;
    for (int item = bid; item < PER_L; item += G) {
        int it = item;
        if (it < N_WIN) { transpose_item(p.in[7] + (size_t)l * DM * NIN, DM, NIN, (bf16_t*)(p.ws + WS_WIN), it & 15, it >> 4, true, scr); }
        else if (it < N_WIN + N_WBR) { it -= N_WIN; const int br = it >> 7, r = it & 127;
            transpose_item(p.in[20] + ((size_t)l * 3 + br) * 512 * 1024, 512, 1024, (bf16_t*)(p.ws + WS_WBR) + (size_t)br * 1024 * 512, r & 7, r >> 3, false, scr); }
        else { it -= N_WIN + N_WBR; transpose_item(p.in[21] + (size_t)l * DM * DM, DM, DM, (bf16_t*)(p.ws + WS_WOUT), it & 15, it >> 4, false, scr); }
    }
}

__device__ __forceinline__ void phase_pre(const Params& p, LAS unsigned char* lds) {
    LAS float* scr = (LAS float*)lds;
    const int G = gridDim.x, bid = blockIdx.x, t = otid();
    for (int item = bid; item < 96; item += G) mod_item(p, item, scr);
    const int gt = bid * NTHR + t, gn = G * NTHR;
    float* cosA = (float*)(p.ws + WS_COSA); float* sinA = (float*)(p.ws + WS_SINA); float* cosC = (float*)(p.ws + WS_COSC); float* sinC = (float*)(p.ws + WS_SINC);
    for (int i = gt; i < 4096 * 96; i += gn) {
        int pos, j; float inv; float* cd; float* sd;
        if (i < 4096 * 32) { pos = i >> 5; j = i & 31; inv = exp2f(-(float)j * (13.287712379549449f / 32.f)); cd = cosA + i; sd = sinA + i; }
        else { const int i2 = i - 4096 * 32; pos = i2 >> 6; j = i2 & 63; inv = exp2f(-(float)j * (13.287712379549449f / 64.f)); cd = cosC + i2; sd = sinC + i2; }
        double x = (double)pos * (double)inv * 0.15915494309189535;
        x -= floor(x);
        const float r = (float)(x * 6.283185307179586);
        *cd = __cosf(r); *sd = __sinf(r);
    }
    if (bid == 1) {
        float* gt = (float*)(p.ws + WS_GAIN);
        for (int i = t; i < 2 * 6 * 128; i += NTHR) {
            const int l = i / 768, w = (i % 768) >> 7, d = i & 127; float v = 0.f;
            if (w == 0) { if (d < 64) v = p.in[8][l * 64 + d]; } else if (w == 1) { if (d < 64) v = p.in[9][l * 64 + d]; }
            else if (w == 2) { if (d < 64) v = p.in[15][l * 64 + d]; } else if (w == 3) { if (d < 64) v = p.in[16][l * 64 + d]; }
            else if (w == 4) v = p.in[18][l * 128 + d]; else v = p.in[19][l * 128 + d];
            gt[i] = v;
        }
    }
    if (bid == 0 && t < 2) {
        const int l = t; float a = 0.f, b = 0.f;
        for (int i = 0; i < 64; ++i) { a += p.in[10][l * 64 + i] * p.in[11][l * 64 + i]; b += p.in[12][l * 64 + i] * p.in[13][l * 64 + i]; }
        const float lam_init = 0.8f - 0.6f * expf(-0.3f * (float)l);
        float* L = (float*)(p.ws + WS_LAM);
        L[l] = expf(a) - expf(b) + lam_init; L[2 + l] = 1.f - lam_init;
    }
}

__device__ __forceinline__ void phase_h(const Params& p, int c, int l, bf16_t* H) {
    const int wave = otid() >> 6, lane = otid() & 63;
    const int row0 = chunk_row0(c), n = chunk_rows(c);
    const float* lng = p.in[4] + l * DM;
    const float* mod_l = (const float*)(p.ws + WS_MOD) + (size_t)l * NSEQ * 3072;
    for (int row = blockIdx.x * 8 + wave; row < n; row += gridDim.x * 8) {
        const int g = row0 + row;
        const float* xr = (l == 0) ? ((g < NPROMPT) ? p.in[0] + (size_t)g * DM : p.in[1] + (size_t)(g - NPROMPT) * DM) : p.out + (size_t)g * DM;
        f32x4 v[4]; float ss = 0.f;
#pragma unroll
        for (int j = 0; j < 4; ++j) { v[j] = *(const f32x4*)(xr + j * 256 + lane * 4); ss += v[j][0] * v[j][0] + v[j][1] * v[j][1] + v[j][2] * v[j][2] + v[j][3] * v[j][3]; }
        ss = wave_sum(ss);
        const float rstd = rsqrtf(ss * (1.f / 1024.f) + EPS);
        const float* md = mod_l + (size_t)seq_of(g) * 3072;
#pragma unroll
        for (int j = 0; j < 4; ++j) {
            const int col = j * 256 + lane * 4;
            const f32x4 gg = *(const f32x4*)(lng + col), sh = *(const f32x4*)(md + col), sc = *(const f32x4*)(md + 1024 + col);
            const f32x4 h = v[j] * rstd * gg * (sc + 1.0f) + sh;
            u32x2 o; o.x = pk2(h[0], h[1]); o.y = pk2(h[2], h[3]);
            *(u32x2*)(H + (size_t)row * DM + col) = o;
        }
    }
}

__device__ __forceinline__ u32x4 pack8(const f32x4& a, const f32x4& b) { u32x4 w; w.x = pk2(a[0], a[1]); w.y = pk2(a[2], a[3]); w.z = pk2(b[0], b[1]); w.w = pk2(b[2], b[3]); return w; }
__device__ __forceinline__ float dot4(const f32x4& a) { return a[0] * a[0] + a[1] * a[1] + a[2] * a[2] + a[3] * a[3]; }

struct EpiIn {
    static constexpr bool PERM = true, AFTER_DRAIN = false;
    bf16_t* P; const float* cosA; const float* sinA; const float* cosC; const float* sinC;
    const float* gtab; int row0; LAS float* xch;
    __device__ __forceinline__ bool keep(const pg8::Unit&) const { return false; }
    template <bool ROPE>
    __device__ __forceinline__ static void piece(f32x4 a, f32x4 b, float rs, const float* glo, const float* ghi, const float* cp, const float* sp, u32x2& pa, u32x2& pb) {
        a = a * rs * *(const f32x4*)glo; b = b * rs * *(const f32x4*)ghi;
        if (ROPE) { const f32x4 c = *(const f32x4*)cp, sn = *(const f32x4*)sp; const f32x4 na = a * c - b * sn, nb = b * c + a * sn; a = na; b = nb; }
        pa.x = pk2(a[0], a[1]); pa.y = pk2(a[2], a[3]); pb.x = pk2(b[0], b[1]); pb.y = pk2(b[2], b[3]);
    }
    template <bool ROPE>
    __device__ __forceinline__ void head64(const f32x4 (&acc)[2][2][4][2], const float* g, float qs, bf16_t* pb, int gq0, int fq) const {
#pragma unroll
        for (int ai = 0; ai < 2; ++ai)
#pragma unroll
            for (int m = 0; m < 4; ++m) {
                float ss = dot4(acc[ai][0][m][0]) + dot4(acc[ai][0][m][1]) + dot4(acc[ai][1][m][0]) + dot4(acc[ai][1][m][1]);
                ss += __shfl_xor(ss, 16); ss += __shfl_xor(ss, 32);
                const float rs = rsqrtf(ss * (1.f / 64.f) + EPS) * qs;
                const int roff = ai * 128 + m * 16;
                const int gq = gq0 + roff; const int pos = gq & (seq_len_of(gq) - 1);
                const float* cp = cosA + pos * 32 + 8 * fq; const float* sp = sinA + pos * 32 + 8 * fq;
                u32x2 pa0, pb0, pa1, pb1;
                piece<ROPE>(acc[ai][0][m][0], acc[ai][1][m][0], rs, g, g + 32, cp, sp, pa0, pb0);
                piece<ROPE>(acc[ai][0][m][1], acc[ai][1][m][1], rs, g + 4, g + 36, cp + 4, sp + 4, pa1, pb1);
                *(u32x4*)(pb + (size_t)roff * NIN) = (u32x4){pa0.x, pa0.y, pa1.x, pa1.y};
                *(u32x4*)(pb + (size_t)roff * NIN + 32) = (u32x4){pb0.x, pb0.y, pb1.x, pb1.y};
            }
    }
    template <int ACT>
    __device__ __forceinline__ void plain(const f32x4 (&acc)[2][2][4][2], bf16_t* pb) const {
#pragma unroll
        for (int ai = 0; ai < 2; ++ai)
#pragma unroll
            for (int m = 0; m < 4; ++m)
#pragma unroll
                for (int bj = 0; bj < 2; ++bj) {
                    f32x4 v0 = acc[ai][bj][m][0], v1 = acc[ai][bj][m][1];
                    if (ACT == 4) {
#pragma unroll
                        for (int e = 0; e < 4; ++e) { v0[e] = siluf_(v0[e]); v1[e] = siluf_(v1[e]); }
                    } else if (ACT == 5) {
#pragma unroll
                        for (int e = 0; e < 4; ++e) { v0[e] = sigmoidf_(v0[e]); v1[e] = sigmoidf_(v1[e]); }
                    }
                    *(u32x4*)(pb + (size_t)(ai * 128 + m * 16) * NIN + bj * 128) = pack8(v0, v1);
                }
    }
    __device__ __forceinline__ void operator()(const f32x4 (&acc)[2][2][4][2], const pg8::Unit& u, int wr, int wc, int fr, int fq) const {
        const int pn = u.pn, ty = tile_type(pn);
        const int rl0 = wr * 64 + fr;
        const size_t rowg0 = (size_t)u.pm * 256 + rl0;
        const int gq0 = row0 + (int)rowg0;
        if (ty == 1 || ty == 2) {
            const bool isq = (ty == 1) ? (pn < 2) : (pn < 8);
            const float* g = gtab + ((ty == 1 ? 0 : 2) + (isq ? 0 : 1)) * 128 + 8 * fq;
            const float qs = isq ? 0.125f * LOG2E : 1.f;
            bf16_t* pb = P + rowg0 * NIN + pn * 256 + 64 * wc + 8 * fq;
            if (ty == 1) head64<true>(acc, g, qs, pb, gq0, fq); else head64<false>(acc, g, qs, pb, gq0, fq);
        } else if (ty == 3) {
            const bool isq = pn < 18;
            const float qs = isq ? 0.08838834764831845f * LOG2E : 1.f;
            const int hh = wc >> 1, w0 = wc & 1;
#pragma unroll
            for (int ai = 0; ai < 2; ++ai)
#pragma unroll
                for (int m = 0; m < 4; ++m) {
                    float ss = dot4(acc[ai][0][m][0]) + dot4(acc[ai][0][m][1]) + dot4(acc[ai][1][m][0]) + dot4(acc[ai][1][m][1]);
                    ss += __shfl_xor(ss, 16); ss += __shfl_xor(ss, 32);
                    if (fq == 0) xch[(ai * 128 + m * 16 + rl0) * 4 + wc] = ss;
                }
            __syncthreads();
            const int dlo = 32 * w0 + 8 * fq;
            const float* g = gtab + (isq ? 4 : 5) * 128 + dlo;
            bf16_t* pb = P + rowg0 * NIN + pn * 256 + 128 * hh + dlo;
#pragma unroll
            for (int ai = 0; ai < 2; ++ai)
#pragma unroll
                for (int m = 0; m < 4; ++m) {
                    const int roff = ai * 128 + m * 16;
                    const f32x2 t2 = *(LAS const f32x2*)(xch + (roff + rl0) * 4 + 2 * hh);
                    const float rs = rsqrtf((t2[0] + t2[1]) * (1.f / 128.f) + EPS) * qs;
                    const int gq = gq0 + roff; const int pos = gq & (seq_len_of(gq) - 1);
                    const float* cp = cosC + pos * 64 + dlo; const float* sp = sinC + pos * 64 + dlo;
                    u32x2 pa0, pb0, pa1, pb1;
                    piece<true>(acc[ai][0][m][0], acc[ai][1][m][0], rs, g, g + 64, cp, sp, pa0, pb0);
                    piece<true>(acc[ai][0][m][1], acc[ai][1][m][1], rs, g + 4, g + 68, cp + 4, sp + 4, pa1, pb1);
                    *(u32x4*)(pb + (size_t)roff * NIN) = (u32x4){pa0.x, pa0.y, pa1.x, pa1.y};
                    *(u32x4*)(pb + (size_t)roff * NIN + 64) = (u32x4){pb0.x, pb0.y, pb1.x, pb1.y};
                }
        } else {
            bf16_t* pb = P + rowg0 * NIN + pn * 256 + 32 * wc + 8 * fq;
            if (ty == 4) plain<4>(acc, pb); else if (ty == 5) plain<5>(acc, pb); else plain<0>(acc, pb);
        }
    }
};

struct BrOrder {
    int G, c, ntile;
    __device__ __forceinline__ bool next(int i, pg8::Unit& u) const {
        const int tk = i / 3, br = i - 3 * tk, tile = c + tk * G; if (tile >= ntile) return false;
        u.pm = (tile >> 2) + br * (TCMAX / 256); u.pn = (tile & 3) + br * 4; return true;
    }
    __device__ __forceinline__ void a_ready(const pg8::Unit&) const {}
    __device__ __forceinline__ void done(const pg8::Unit&) const {}
};

struct EpiBr {
    static constexpr bool PERM = true, AFTER_DRAIN = false;
    bf16_t* P;
    __device__ __forceinline__ bool keep(const pg8::Unit& u) const { return (u.pm >> 7) < 2; }
    __device__ __forceinline__ void operator()(f32x4 (&acc)[2][2][4][2], const pg8::Unit& u, int wr, int wc, int fr, int fq) const {
        const int br = u.pm >> 7, pm = u.pm & 127, pn = u.pn & 3;
        const size_t row0 = (size_t)pm * 256 + wr * 64 + fr; const int col0 = pn * 256 + 32 * wc + 8 * fq;
        const bf16_t* gp = P + row0 * NIN + COL_G + br * 1024 + col0;
        if (br < 2) {
#pragma unroll
            for (int ai = 0; ai < 2; ++ai)
#pragma unroll
                for (int m = 0; m < 4; ++m)
#pragma unroll
                    for (int bj = 0; bj < 2; ++bj) {
                        const bf16_t* q = gp + (size_t)(ai * 128 + m * 16) * NIN + bj * 128;
                        const u32x4 sg = *(const u32x4*)q, sn = *(const u32x4*)(q + 1024);
                        f32x4 f0 = {bflo(sg.x), bfhi(sg.x), bflo(sg.y), bfhi(sg.y)}, f1 = {bflo(sg.z), bfhi(sg.z), bflo(sg.w), bfhi(sg.w)};
                        f0[0] *= __builtin_amdgcn_rcpf(bflo(sn.x)); f0[1] *= __builtin_amdgcn_rcpf(bfhi(sn.x)); f0[2] *= __builtin_amdgcn_rcpf(bflo(sn.y)); f0[3] *= __builtin_amdgcn_rcpf(bfhi(sn.y));
                        f1[0] *= __builtin_amdgcn_rcpf(bflo(sn.z)); f1[1] *= __builtin_amdgcn_rcpf(bfhi(sn.z)); f1[2] *= __builtin_amdgcn_rcpf(bflo(sn.w)); f1[3] *= __builtin_amdgcn_rcpf(bfhi(sn.w));
                        acc[ai][bj][m][0] *= f0; acc[ai][bj][m][1] *= f1;
                    }
        } else {
            bf16_t* op = P + row0 * NIN + col0;
#pragma unroll
            for (int ai = 0; ai < 2; ++ai)
#pragma unroll
                for (int m = 0; m < 4; ++m)
#pragma unroll
                    for (int bj = 0; bj < 2; ++bj) {
                        const size_t o = (size_t)(ai * 128 + m * 16) * NIN + bj * 128;
                        const u32x4 sg = *(const u32x4*)(gp + o);
                        const f32x4 f0 = {bflo(sg.x), bfhi(sg.x), bflo(sg.y), bfhi(sg.y)}, f1 = {bflo(sg.z), bfhi(sg.z), bflo(sg.w), bfhi(sg.w)};
                        *(u32x4*)(op + o) = pack8(acc[ai][bj][m][0] * f0, acc[ai][bj][m][1] * f1);
                    }
        }
    }
};

struct EpiOut {
    static constexpr bool PERM = true, AFTER_DRAIN = false;
    const float* xp; const float* xs; float* out; const float* mod_l; int row0, layer;
    __device__ __forceinline__ bool keep(const pg8::Unit&) const { return false; }
    __device__ __forceinline__ void operator()(const f32x4 (&acc)[2][2][4][2], const pg8::Unit& u, int wr, int wc, int fr, int fq) const {
        const int g0 = row0 + u.pm * 256 + wr * 64 + fr; const int col0 = u.pn * 256 + 32 * wc + 8 * fq;
#pragma unroll
        for (int ai = 0; ai < 2; ++ai)
#pragma unroll
            for (int m = 0; m < 4; ++m) {
                const int g = g0 + ai * 128 + m * 16;
                const float* gt = mod_l + (size_t)seq_of(g) * 3072 + 2048;
                const float* xr = (layer == 0) ? ((g < NPROMPT) ? xp + (size_t)g * DM : xs + (size_t)(g - NPROMPT) * DM) : out + (size_t)g * DM;
                float* orow = out + (size_t)g * DM;
#pragma unroll
                for (int bj = 0; bj < 2; ++bj) {
                    const int col = col0 + bj * 128;
                    const f32x4 g0v = *(const f32x4*)(gt + col), g1v = *(const f32x4*)(gt + col + 4);
                    const f32x4 x0 = *(const f32x4*)(xr + col), x1 = *(const f32x4*)(xr + col + 4);
                    *(f32x4*)(orow + col) = x0 + g0v * acc[ai][bj][m][0];
                    *(f32x4*)(orow + col + 4) = x1 + g1v * acc[ai][bj][m][1];
                }
            }
    }
};

struct AttnCtx { const bf16_t* P; bf16_t* T; bf16_t* OC; float* LSE; const float* subln; const float* rpb; const float* lamp; int layer; int row0, n; };

__device__ __forceinline__ int crow(int i, int h) { return (i & 3) + 8 * (i >> 2) + 4 * h; }
__device__ __forceinline__ s16x4 vtr(LAS const unsigned char* p) { return __builtin_bit_cast(s16x4, __builtin_amdgcn_ds_read_tr16_b64_v4i16((LAS v4i16_t*)p)); }
#define MFMA32(a, b, c) __builtin_amdgcn_mfma_f32_32x32x16_bf16((a), (b), (c), 0, 0, 0)
#define DS_TR16(dst, addr, off) asm volatile("ds_read_b64_tr_b16 %0, %1 offset:%c2" : "=&v"(dst) : "v"(addr), "i"(off) : "memory")
#define DS_RD128(dst, addr, off) asm volatile("ds_read_b128 %0, %1 offset:%c2" : "=&v"(dst) : "v"(addr), "i"(off) : "memory")
#define LGKM0() asm volatile("s_waitcnt lgkmcnt(0)" ::: "memory")
#define SBAR() __builtin_amdgcn_sched_barrier(0)
__device__ __forceinline__ float max3f(float a, float b, float c) { float r; asm("v_max3_f32 %0, %1, %2, %3" : "=v"(r) : "v"(a), "v"(b), "v"(c)); return r; }
__device__ __forceinline__ void wait_vm(int n) {
    switch (n) {
#define WV(k) case k: asm volatile("s_waitcnt vmcnt(" #k ")" ::: "memory"); break;
        WV(1) WV(2) WV(3) WV(4) WV(5) WV(6) WV(7) WV(8) WV(9) WV(10) WV(12) WV(14) WV(15) WV(16) WV(18) WV(20)
#undef WV
        default: asm volatile("s_waitcnt vmcnt(0)" ::: "memory"); break;
    }
}

template <int DQK, int DV, int MODE>
__device__ __forceinline__ void attn_item(LAS unsigned char* lds, int item, const AttnCtx& cx) {
    constexpr int KP = DQK * 2 + 16, VP = DV * 2 + 64, KBY = 64 * KP, VBY = 64 * VP, HB = KBY + VBY;
    constexpr int NQF = DQK / 16, NDV = DV / 32, NKP = DQK / 32, NVP = DV / 32, KPR = DQK / 8, VPR = DV / 8;
    const int tid = otid(), lane = tid & 63, wave = __builtin_amdgcn_readfirstlane(tid >> 6), hf = wave >> 2, wq = wave & 3, r = lane & 31, h = lane >> 5, th = tid & 255;
    const bf16_t* __restrict__ P = cx.P;
    int head, tok0, seqbase, qcol, kcol, vcol, ntiles, qtok, S;
    int na_rows = 0, na_rs0 = 0, na_rq = 0, na_cq = 0, na_rsq = 0, na_csq = 0;
    int c_dlog = 0, c_rho = 0, c_l0 = 0, c_L = 0, c_lq = 0;
    if (MODE == 0) {
        head = item & 3; tok0 = (item >> 2) * 128; S = seq_len_of(cx.row0 + tok0); seqbase = ((cx.row0 + tok0) & ~(S - 1)) - cx.row0;
        qcol = COL_A_Q + head * 128 + hf * 64; kcol = COL_A_K + head * 128 + hf * 64; vcol = COL_A_V + head * 128; ntiles = S >> 6;
        qtok = tok0 + 32 * wq + r;
    } else if (MODE == 1) {
        const int unit = item * 2 + hf, nbk = cx.n >> 7; head = unit / nbk; tok0 = (unit - head * nbk) * 128; S = seq_len_of(cx.row0 + tok0); seqbase = ((cx.row0 + tok0) & ~(S - 1)) - cx.row0;
        qcol = COL_B_Q + head * 64; kcol = COL_B_K + head * 64; vcol = COL_B_V + head * 64; ntiles = 9;
        qtok = tok0 + 32 * wq + r;
        na_rows = S >> 6; const int r0 = (tok0 - seqbase) >> 6; na_rs0 = min(max(r0 - 4, 0), na_rows - 8);
        na_rq = r0 + (wq >> 1); na_cq = 32 * (wq & 1) + r; na_rsq = min(max(na_rq - 4, 0), na_rows - 8); na_csq = min(max(na_cq - 8, 0), 48);
    } else {
        const int unit = item * 2 + hf, nbk = cx.n >> 7; head = unit / nbk; const int blk = unit - head * nbk; tok0 = blk * 128; S = seq_len_of(cx.row0 + tok0); seqbase = ((cx.row0 + tok0) & ~(S - 1)) - cx.row0;
        qcol = COL_C_Q + head * 128; kcol = COL_C_K + head * 128; vcol = COL_C_V + head * 128; ntiles = 4;
        c_dlog = 2 * (head >> 2); const int b = (tok0 - seqbase) >> 7; c_rho = b & ((1 << c_dlog) - 1); c_l0 = (b >> c_dlog) * 128; c_L = S >> c_dlog;
        c_lq = c_l0 + 32 * wq + r; qtok = seqbase + (c_lq << c_dlog) + c_rho;
    }
    auto ktok = [&](int j, int kr) -> int {
        if (MODE == 0) return seqbase + 64 * j + kr;
        if (MODE == 1) return seqbase + min(na_rs0 + j, na_rows - 1) * 64 + kr;
        const int lk = min(max(c_l0 - 64 + 64 * j + kr, 0), c_L - 1); return seqbase + (lk << c_dlog) + c_rho;
    };
    const bool loadV = !(MODE == 0 && hf == 1);
#ifndef DMA_MODES
#define DMA_MODES 1
#endif
    constexpr bool DMA = ((DMA_MODES >> MODE) & 1) != 0;
    constexpr int NST = !DMA ? 2 : ((MODE == 0) ? 4 : ((MODE == 1) ? 3 : 2));
    constexpr bool ROT = DMA && (MODE == 0);
    constexpr int DIST = NST - 1, WAHEAD = ROT ? 1 : 0;
    const bool rot = ROT && (hf == 1);
    constexpr int SB = (MODE == 0) ? (2 * KBY + VBY) : (2 * HB);
    constexpr int KCH = KBY / 1024, VCH = VBY / 1024, LPWMAX = (KCH + VCH + 3) / 4;
    static_assert(KBY % 1024 == 0 && VBY % 1024 == 0 && NST * SB + (MODE == 1 ? 4096 : 0) <= LDS_BYTES - 16, "attention LDS ring");
    const int koff = (MODE == 0) ? hf * KBY : hf * HB, voff = (MODE == 0) ? 2 * KBY : hf * HB + KBY;
    const int nchh = KCH + (loadV ? VCH : 0);
    const int n_w = (nchh - wq + 3) >> 2;
    auto issue = [&](int j) {
        const int sbase = (j % NST) * SB;
#pragma unroll
        for (int i = 0; i < LPWMAX; ++i) {
            const int cid = wq + 4 * i;
            if (cid < nchh) {
                const bool isv = cid >= KCH; const int lc = isv ? cid - KCH : cid;
                const int pc = lc * 64 + lane, ppr = isv ? VP / 16 : KP / 16, row = pc / ppr, cp = pc - row * ppr;
                if (cp < (isv ? DV / 8 : DQK / 8)) {
                    const bf16_t* src = P + (size_t)ktok(j, row) * NIN + (isv ? vcol : kcol) + cp * 8;
                    __builtin_amdgcn_global_load_lds((const unsigned*)src, (LAS unsigned*)(lds + sbase + (isv ? voff : koff) + lc * 1024), 16, 0, 0);
                }
            }
        }
    };
    u32x4 kreg[DMA ? 1 : NKP], vreg[DMA ? 1 : NVP];
    auto gload = [&](int j) {
#pragma unroll
        for (int i = 0; i < NKP; ++i) { const int pid = th + 256 * i, row = pid / KPR, cp = pid % KPR; kreg[DMA ? 0 : i] = *(const u32x4*)(P + (size_t)ktok(j, row) * NIN + kcol + cp * 8); }
        if (loadV) {
#pragma unroll
            for (int i = 0; i < NVP; ++i) { const int pid = th + 256 * i, row = pid / VPR, cp = pid % VPR; vreg[DMA ? 0 : i] = *(const u32x4*)(P + (size_t)ktok(j, row) * NIN + vcol + cp * 8); }
        }
    };
    auto lstore = [&](int b) {
        LAS unsigned char* base = lds + b * SB;
#pragma unroll
        for (int i = 0; i < NKP; ++i) { const int pid = th + 256 * i, row = pid / KPR, cp = pid % KPR; *(LAS u32x4*)(base + koff + row * KP + cp * 16) = kreg[DMA ? 0 : i]; }
        if (loadV) {
#pragma unroll
            for (int i = 0; i < NVP; ++i) { const int pid = th + 256 * i, row = pid / VPR, cp = pid % VPR; *(LAS u32x4*)(base + voff + row * VP + cp * 16) = vreg[DMA ? 0 : i]; }
        }
    };
    LAS float* biasL = (LAS float*)(lds + NST * SB) + hf * 512;
    if (DMA) {
#pragma unroll
        for (int j0 = 0; j0 < DIST; ++j0) if (j0 < ntiles) issue(j0);
    } else gload(0);
    bf16x8 qf[NQF];
#pragma unroll
    for (int ks = 0; ks < NQF; ++ks) qf[ks] = *(const bf16x8*)(P + (size_t)qtok * NIN + qcol + 16 * ks + 8 * h);
    if (MODE == 1) { for (int i = th; i < 465; i += 256) biasL[i] = cx.rpb[head * 465 + i] * LOG2E; }
    f32x16 O[NDV];
#pragma unroll
    for (int d = 0; d < NDV; ++d)
#pragma unroll
        for (int i = 0; i < 16; ++i) O[d][i] = 0.f;
    float mhat = 0.f; bool first = true;
    f32x16 negm, Lacc;
#pragma unroll
    for (int i = 0; i < 16; ++i) { negm[i] = 0.f; Lacc[i] = 0.f; }
    const bf16x8 ones8 = {(short)0x3F80, (short)0x3F80, (short)0x3F80, (short)0x3F80, (short)0x3F80, (short)0x3F80, (short)0x3F80, (short)0x3F80};
    constexpr float THR = 6.f;
#pragma unroll
    for (int ks = 0; ks < NQF; ++ks) asm volatile("" : "+v"(qf[ks]));
    if (!DMA) { lstore(0); __syncthreads(); }
    else if (MODE == 1) __syncthreads();
    const int q4 = (lane & 15) >> 2, p4 = lane & 3, rblk = (lane >> 4) & 1;
    bf16x8 pa[2][2];
    s16x4 vlo[2][4], vhi[2][4];
    f32x16 s0, s1;
#define V_ISSUE(va, b, d) do { _Pragma("unroll") for (int k4 = 0; k4 < 4; ++k4) { DS_TR16(vlo[b][k4], va, (16 * k4) * VP + (d) * 64); DS_TR16(vhi[b][k4], va, (16 * k4 + 8) * VP + (d) * 64); } } while (0)
#define K_ISSUE(b, kb) do { DS_RD128(kfr[b][0], kaddr, (2 * (kb)) * 32); DS_RD128(kfr[b][1], kaddr, 32 * KP + (2 * (kb)) * 32); \
                            DS_RD128(kfr[b][2], kaddr, (2 * (kb) + 1) * 32); DS_RD128(kfr[b][3], kaddr, 32 * KP + (2 * (kb) + 1) * 32); } while (0)
    auto vaddr_of = [&](int j) -> unsigned { return (unsigned)(size_t)(lds + (j % NST) * SB + voff) + (4 * h + q4) * VP + (16 * rblk + 4 * p4) * 2; };
    auto do_qk = [&](int j, bool vpre) {
        const unsigned kaddr = (unsigned)(size_t)(lds + (j % NST) * SB + koff) + r * KP + 16 * h;
        const unsigned va = vaddr_of(j);
        bf16x8 kfr[1][4];
        K_ISSUE(0, 0);
#pragma unroll
        for (int kb = 0; kb < NQF / 2; ++kb) {
            LGKM0(); SBAR();
            if (kb == 0) { s0 = MFMA32(kfr[0][0], qf[0], negm); s1 = MFMA32(kfr[0][1], qf[0], negm); }
            else { s0 = MFMA32(kfr[0][0], qf[2 * kb], s0); s1 = MFMA32(kfr[0][1], qf[2 * kb], s1); }
            s0 = MFMA32(kfr[0][2], qf[2 * kb + 1], s0); s1 = MFMA32(kfr[0][3], qf[2 * kb + 1], s1);
            SBAR();
            if (kb + 1 < NQF / 2) K_ISSUE(0, kb + 1); else if (vpre) V_ISSUE(va, 0, 0);
        }
    };
    auto do_soft = [&](int j) {
        if (MODE == 1) {
            const int rk = na_rs0 + j; const int bbase = (rk - na_rq + 7) * 31 + 15 - na_cq;
#pragma unroll
            for (int i = 0; i < 16; ++i) {
                const int ck0 = crow(i, h), ck1 = ck0 + 32;
                const bool v0 = (ck0 >= na_csq) && (ck0 < na_csq + 16), v1 = (ck1 >= na_csq) && (ck1 < na_csq + 16);
                const float b0 = biasL[v0 ? bbase + ck0 : 0], b1 = biasL[v1 ? bbase + ck1 : 0];
                s0[i] = v0 ? s0[i] + b0 : NEGBIG; s1[i] = v1 ? s1[i] + b1 : NEGBIG;
            }
        }
        if (MODE == 2) {
            const int lk0 = c_l0 - 64 + 64 * j;
#pragma unroll
            for (int i = 0; i < 16; ++i) {
                const int lka = lk0 + crow(i, h), lkb = lka + 32;
                const bool v0 = (lka >= 0) && (lka < c_L) && (abs(lka - c_lq) <= 64), v1 = (lkb >= 0) && (lkb < c_L) && (abs(lkb - c_lq) <= 64);
                s0[i] = v0 ? s0[i] : NEGBIG; s1[i] = v1 ? s1[i] : NEGBIG;
            }
        }
        float mx = max3f(s0[0], s1[0], s0[1]);
        mx = max3f(mx, s1[1], s0[2]);
#pragma unroll
        for (int i = 2; i < 15; ++i) mx = max3f(mx, s1[i], s0[i + 1]);
        mx = fmaxf(mx, s1[15]);
        { auto rr = __builtin_amdgcn_permlane32_swap(__float_as_uint(mx), __float_as_uint(mx), false, false); mx = max3f(__uint_as_float(rr[0]), __uint_as_float(rr[1]), __uint_as_float(rr[0])); }
        if (first || __builtin_amdgcn_ballot_w64(mx > THR) != 0ull) {
            const float delta = first ? mx : fmaxf(mx, 0.f), alpha = fast_exp2(-delta);
#pragma unroll
            for (int i = 0; i < 16; ++i) { s0[i] -= delta; s1[i] -= delta; }
            if (!first) {
#pragma unroll
                for (int d = 0; d < NDV; ++d)
#pragma unroll
                    for (int i = 0; i < 16; ++i) O[d][i] *= alpha;
#pragma unroll
                for (int i = 0; i < 16; ++i) Lacc[i] *= alpha;
            }
            mhat += delta;
#pragma unroll
            for (int i = 0; i < 16; ++i) negm[i] = -mhat;
            first = false;
        }
#pragma unroll
        for (int i = 0; i < 16; ++i) { s0[i] = fast_exp2(s0[i]); s1[i] = fast_exp2(s1[i]); }
        u32x4 w;
        w.x = pk2(s0[0], s0[1]); w.y = pk2(s0[2], s0[3]); w.z = pk2(s0[4], s0[5]); w.w = pk2(s0[6], s0[7]); pa[0][0] = __builtin_bit_cast(bf16x8, w);
        w.x = pk2(s0[8], s0[9]); w.y = pk2(s0[10], s0[11]); w.z = pk2(s0[12], s0[13]); w.w = pk2(s0[14], s0[15]); pa[0][1] = __builtin_bit_cast(bf16x8, w);
        w.x = pk2(s1[0], s1[1]); w.y = pk2(s1[2], s1[3]); w.z = pk2(s1[4], s1[5]); w.w = pk2(s1[6], s1[7]); pa[1][0] = __builtin_bit_cast(bf16x8, w);
        w.x = pk2(s1[8], s1[9]); w.y = pk2(s1[10], s1[11]); w.z = pk2(s1[12], s1[13]); w.w = pk2(s1[14], s1[15]); pa[1][1] = __builtin_bit_cast(bf16x8, w);
    };
    auto do_pv = [&](unsigned va) {
#pragma unroll
        for (int k4 = 0; k4 < 4; ++k4) Lacc = MFMA32(ones8, pa[k4 >> 1][k4 & 1], Lacc);
#pragma unroll
        for (int d = 0; d < NDV; ++d) {
            LGKM0(); SBAR();
#pragma unroll
            for (int k4 = 0; k4 < 4; ++k4) {
                const bf16x8 vf = __builtin_shufflevector(vlo[d & 1][k4], vhi[d & 1][k4], 0, 1, 2, 3, 4, 5, 6, 7);
                O[d] = MFMA32(vf, pa[k4 >> 1][k4 & 1], O[d]);
            }
            SBAR();
            if (d + 1 < NDV) V_ISSUE(va, (d + 1) & 1, d + 1);
        }
    };
    for (int j = 0; j < ntiles; ++j) {
        if (DMA) {
            wait_vm(n_w * max(min(DIST - 1 - WAHEAD, ntiles - 1 - j - WAHEAD), 0));
            __builtin_amdgcn_s_barrier();
            SBAR();
            if (j + DIST < ntiles) issue(j + DIST);
        } else if (j + 1 < ntiles) gload(j + 1);
        bool active = true;
        if (MODE == 1) { const int rk = na_rs0 + j; active = (rk >= na_rsq) && (rk < na_rsq + 8); }
        if (MODE == 2) { const int lk0 = c_l0 - 64 + 64 * j; active = ((wq < 2) ? (j <= 2) : (j >= 1)) && (lk0 + 63 >= 0) && (lk0 < c_L); }
        if (active) {
            if (!rot || j == 0) do_qk(j, !rot);
            if (rot) V_ISSUE(vaddr_of(j), 0, 0);
            do_soft(j);
            do_pv(vaddr_of(j));
            if (rot && j + 1 < ntiles) do_qk(j + 1, false);
        }
        if (!DMA) { if (j + 1 < ntiles) lstore((j + 1) & 1); __syncthreads(); }
    }
#undef K_ISSUE
#undef V_ISSUE
    const float lt = Lacc[0];
    const float inv = 1.f / lt;
    __syncthreads();
    if (MODE == 0) {
        LAS float* X = (LAS float*)lds;
        if (hf == 1) {
#pragma unroll
            for (int d = 0; d < NDV; ++d)
#pragma unroll
                for (int g4 = 0; g4 < 4; ++g4) {
                    f32x4 v = {O[d][4 * g4] * inv, O[d][4 * g4 + 1] * inv, O[d][4 * g4 + 2] * inv, O[d][4 * g4 + 3] * inv};
                    *(LAS f32x4*)(X + (32 * wq + r) * 132 + 32 * d + 8 * g4 + 4 * h) = v;
                }
        }
        __syncthreads();
        if (hf == 0) {
            float ss = 0.f;
            const float lam = cx.lamp[cx.layer], oml = cx.lamp[2 + cx.layer];
#pragma unroll
            for (int d = 0; d < NDV; ++d)
#pragma unroll
                for (int g4 = 0; g4 < 4; ++g4) {
                    const f32x4 o2 = *(LAS const f32x4*)(X + (32 * wq + r) * 132 + 32 * d + 8 * g4 + 4 * h);
#pragma unroll
                    for (int e = 0; e < 4; ++e) { const float o = O[d][4 * g4 + e] * inv - lam * o2[e]; O[d][4 * g4 + e] = o; ss += o * o; }
                }
            ss += __shfl_xor(ss, 32);
            const float rstd = rsqrtf(ss * (1.f / 128.f) + EPS) * oml;
#pragma unroll
            for (int d = 0; d < NDV; ++d)
#pragma unroll
                for (int g4 = 0; g4 < 4; ++g4) {
                    const int dv = 32 * d + 8 * g4 + 4 * h;
                    const f32x4 gn = *(const f32x4*)(cx.subln + dv);
                    const u32x2 sz = *(const u32x2*)(P + (size_t)qtok * NIN + COL_Z + head * 128 + dv);
                    u32x2 o;
                    o.x = pk2(O[d][4 * g4] * rstd * gn[0] * bflo(sz.x), O[d][4 * g4 + 1] * rstd * gn[1] * bfhi(sz.x));
                    o.y = pk2(O[d][4 * g4 + 2] * rstd * gn[2] * bflo(sz.y), O[d][4 * g4 + 3] * rstd * gn[3] * bfhi(sz.y));
                    *(u32x2*)(cx.T + (size_t)qtok * 512 + head * 128 + dv) = o;
                }
        }
        __syncthreads();
    } else if (MODE == 1) {
#pragma unroll
        for (int d = 0; d < NDV; ++d)
#pragma unroll
            for (int g4 = 0; g4 < 4; ++g4) {
                const int dv = 32 * d + 8 * g4 + 4 * h;
                const u32x2 sz = *(const u32x2*)(P + (size_t)qtok * NIN + COL_Z + 512 + head * 64 + dv);
                u32x2 o;
                o.x = pk2(O[d][4 * g4] * inv * bflo(sz.x), O[d][4 * g4 + 1] * inv * bfhi(sz.x));
                o.y = pk2(O[d][4 * g4 + 2] * inv * bflo(sz.y), O[d][4 * g4 + 3] * inv * bfhi(sz.y));
                *(u32x2*)(cx.T + (size_t)TCMAX * 512 + (size_t)qtok * 512 + head * 64 + dv) = o;
            }
    } else {
#pragma unroll
        for (int d = 0; d < NDV; ++d)
#pragma unroll
            for (int g4 = 0; g4 < 4; ++g4) {
                const int dv = 32 * d + 8 * g4 + 4 * h;
                u32x2 o; o.x = pk2(O[d][4 * g4] * inv, O[d][4 * g4 + 1] * inv); o.y = pk2(O[d][4 * g4 + 2] * inv, O[d][4 * g4 + 3] * inv);
                *(u32x2*)(cx.OC + (size_t)qtok * 1536 + head * 128 + dv) = o;
            }
        if (h == 0) cx.LSE[(size_t)qtok * 12 + head] = mhat + __log2f(lt);
    }
}

__device__ __forceinline__ void phase_attn(LAS unsigned char* lds, const AttnCtx& cx) {
    const int G = gridDim.x, nb = cx.n >> 7;
    const int c = (G % 8 == 0) ? (int)(blockIdx.x & 7) * (G >> 3) + (int)(blockIdx.x >> 3) : (int)blockIdx.x;
    const int npb = (cx.row0 < NPROMPT) ? (NPROMPT - cx.row0) >> 7 : 0;
    for (int rep = 0; rep < (DUP_PH == 20 ? 2 : 1); ++rep)
    for (int it = c; it < nb * 4; it += G) {
        int tb, head;
        if (it < npb * 4) { const int sq = it >> 7, rem = it & 127; head = rem >> 5; tb = sq * 32 + (rem & 31); }
        else { const int i2 = it - npb * 4, sq = i2 >> 6, rem = i2 & 63; head = rem >> 4; tb = npb + sq * 16 + (rem & 15); }
        attn_item<64, 128, 0>(lds, tb * 4 + head, cx);
    }
    for (int rep = 0; rep < (DUP_PH == 21 ? 2 : 1); ++rep)
    for (int it = c; it < nb * 6; it += G) attn_item<128, 128, 2>(lds, it, cx);
    for (int rep = 0; rep < (DUP_PH == 22 ? 2 : 1); ++rep)
    for (int it = c; it < nb * 4; it += G) attn_item<64, 64, 1>(lds, it, cx);
}

__device__ __forceinline__ void phase_cmix(const bf16_t* __restrict__ P, const bf16_t* __restrict__ OC, const float* __restrict__ LSE, bf16_t* T2, int n) {
#pragma unroll 4
    for (int idx = blockIdx.x * NTHR + otid(); idx < n * 64; idx += gridDim.x * NTHR) {
        const int tok = idx >> 6, c8 = idx & 63, hh = c8 >> 4, dv = (c8 & 15) * 8;
        const float l0 = LSE[(size_t)tok * 12 + hh], l1 = LSE[(size_t)tok * 12 + 4 + hh], l2 = LSE[(size_t)tok * 12 + 8 + hh];
        const float mx = fmaxf(l0, fmaxf(l1, l2));
        float w0 = fast_exp2(l0 - mx), w1 = fast_exp2(l1 - mx), w2 = fast_exp2(l2 - mx);
        const float iw = 1.f / (w0 + w1 + w2); w0 *= iw; w1 *= iw; w2 *= iw;
        const u32x4 a = *(const u32x4*)(OC + (size_t)tok * 1536 + hh * 128 + dv), b = *(const u32x4*)(OC + (size_t)tok * 1536 + (4 + hh) * 128 + dv),
                    c = *(const u32x4*)(OC + (size_t)tok * 1536 + (8 + hh) * 128 + dv), z = *(const u32x4*)(P + (size_t)tok * NIN + COL_Z + 1024 + hh * 128 + dv);
        u32x4 o;
        o.x = pk2((w0 * bflo(a.x) + w1 * bflo(b.x) + w2 * bflo(c.x)) * bflo(z.x), (w0 * bfhi(a.x) + w1 * bfhi(b.x) + w2 * bfhi(c.x)) * bfhi(z.x));
        o.y = pk2((w0 * bflo(a.y) + w1 * bflo(b.y) + w2 * bflo(c.y)) * bflo(z.y), (w0 * bfhi(a.y) + w1 * bfhi(b.y) + w2 * bfhi(c.y)) * bfhi(z.y));
        o.z = pk2((w0 * bflo(a.z) + w1 * bflo(b.z) + w2 * bflo(c.z)) * bflo(z.z), (w0 * bfhi(a.z) + w1 * bfhi(b.z) + w2 * bfhi(c.z)) * bfhi(z.z));
        o.w = pk2((w0 * bflo(a.w) + w1 * bflo(b.w) + w2 * bflo(c.w)) * bflo(z.w), (w0 * bfhi(a.w) + w1 * bfhi(b.w) + w2 * bfhi(c.w)) * bfhi(z.w));
        *(u32x4*)(T2 + (size_t)tok * 512 + hh * 128 + dv) = o;
    }
}

#define XB_TMO      128
#define XB_XCNT(j)  (256  + 64 * (j))
#define XB_XSUB(j)  (1280 + 64 * (j))
#define XB_XGEN(j)  (2304 + 64 * (j))
#define XB_TOP      3328
#define XB_TOPGEN   3392
#define XCD_BAR_WORDS 3456
#define XB_SPIN_CAP (1u << 18)

__device__ __forceinline__ unsigned xb_ld(unsigned* p)              { return __hip_atomic_load(p, __ATOMIC_RELAXED, __HIP_MEMORY_SCOPE_AGENT); }
__device__ __forceinline__ unsigned xb_add(unsigned* p, unsigned v) { return __hip_atomic_fetch_add(p, v, __ATOMIC_RELAXED, __HIP_MEMORY_SCOPE_AGENT); }
__device__ __forceinline__ unsigned xb_xcc_id() { return (unsigned)__builtin_amdgcn_s_getreg((3 << 11) | 20) & 0xFu; }
#define XB_SPIN(cond, bar) do { unsigned _sp = 0; while (cond) { __builtin_amdgcn_s_sleep(1); \
    if ((++_sp & 255u) == 0u) { if (xb_ld(&(bar)[XB_TMO])) break; if (_sp > XB_SPIN_CAP) { atomicAdd(&(bar)[XB_TMO], 1u); break; } } } } while (0)

struct XcdBarrier {
    unsigned* bar; unsigned x;
    volatile LAS unsigned* st;
};

__device__ __forceinline__ XcdBarrier xcd_barrier_post(unsigned* bar, volatile LAS unsigned* st) {
    XcdBarrier b; b.bar = bar; b.x = xb_xcc_id(); b.st = st;
    if (threadIdx.x == 0) (void)xb_add(&bar[XB_XCNT(b.x)], 1u);
    return b;
}
__device__ __forceinline__ void xcd_barrier_complete(unsigned* bar, unsigned x, unsigned& nloc, unsigned& nx) {
    const unsigned G = gridDim.x * gridDim.y * gridDim.z;
    unsigned sum, cnt, mine, sp = 0u;
    for (;;) {
        sum = 0u; cnt = 0u; mine = 0u;
#pragma unroll
        for (unsigned j = 0; j < 16; ++j) { const unsigned c = xb_ld(&bar[XB_XCNT(j)]); sum += c; cnt += (c > 0u) ? 1u : 0u; mine = (j == x) ? c : mine; }
        if (sum == G) break;
        __builtin_amdgcn_s_sleep(1);
        if ((++sp & 255u) == 0u) { if (xb_ld(&bar[XB_TMO])) break; if (sp > XB_SPIN_CAP) { atomicAdd(&bar[XB_TMO], 1u); break; } }
    }
    nloc = mine > 0u ? mine : 1u; nx = cnt > 0u ? cnt : 1u;
}

__device__ __forceinline__ void xcd_barrier(const XcdBarrier& b) {
    asm volatile("s_waitcnt vmcnt(0)" ::: "memory");
    __syncthreads();
    if (threadIdx.x == 0) {
        unsigned* bar = b.bar;
        __builtin_amdgcn_s_waitcnt(0);
        unsigned nloc = b.st[0], nx = b.st[1];
        if (nloc == 0u) { xcd_barrier_complete(bar, b.x, nloc, nx); b.st[0] = nloc; b.st[1] = nx; }
        const unsigned old = xb_add(&bar[XB_XSUB(b.x)], 1u);
        const unsigned gen = old / nloc;
        if (old + 1u == (gen + 1u) * nloc) {
            __builtin_amdgcn_fence(__ATOMIC_RELEASE, "agent");
            asm volatile("s_waitcnt vmcnt(0)" ::: "memory");
            const unsigned og = xb_add(&bar[XB_TOP], 1u);
            const unsigned tg = og / nx;
            if (og + 1u == (tg + 1u) * nx) xb_add(&bar[XB_TOPGEN], 1u);
            else XB_SPIN(xb_ld(&bar[XB_TOPGEN]) == tg, bar);
            __builtin_amdgcn_fence(__ATOMIC_ACQUIRE, "agent");
            xb_add(&bar[XB_XGEN(b.x)], 1u);
            asm volatile("s_waitcnt vmcnt(0)" ::: "memory");
        } else {
            XB_SPIN(xb_ld(&bar[XB_XGEN(b.x)]) == gen, bar);
            __builtin_amdgcn_fence(__ATOMIC_ACQUIRE, "agent");
            asm volatile("s_waitcnt vmcnt(0)" ::: "memory");
        }
    }
    __syncthreads();
}

#ifndef ONE_LAUNCH
#define ONE_LAUNCH 1
#endif

__global__ void __launch_bounds__(NTHR, 2) mega(Params p) {
    extern __shared__ __attribute__((aligned(16))) unsigned char lds_raw[];
    LAS unsigned char* lds = (LAS unsigned char*)lds_raw;
    unsigned char* ws = p.ws;
    volatile LAS unsigned* bst = (volatile LAS unsigned*)(lds + LDS_BYTES - 16);
    if (threadIdx.x < 2) bst[threadIdx.x] = 0u;
    __syncthreads();
    XcdBarrier bar; bar.bar = (unsigned*)(ws + WS_BAR); bar.x = 0; bar.st = bst;
    if (p.ph_hi - p.ph_lo > 1) bar = xcd_barrier_post((unsigned*)(ws + WS_BAR), bst);
    bf16_t* P = (bf16_t*)(ws + WS_P); bf16_t* T = (bf16_t*)(ws + WS_T); bf16_t* H = T; bf16_t* OC = (bf16_t*)(ws + WS_OC); float* LSE = (float*)(ws + WS_LSE);
    for (int ph = p.ph_lo; ph < p.ph_hi; ++ph) {
        if (ph > p.ph_lo) { if (ph == 1) cg::this_grid().sync(); else xcd_barrier(bar); }
        if (ph == 0) { phase_pre(p, lds); phase_prew(p, lds, 0); continue; }
        if (ph == 1) { phase_h(p, 0, 0, H); continue; }
        if (ph == 17) { phase_prew(p, lds, 1); phase_h(p, 0, 1, H); continue; }
        const int l = (ph > 17) ? 1 : 0, q = ph - (l ? 18 : 2), c = q / 5, k = q - c * 5;
        const int row0 = chunk_row0(c), n = chunk_rows(c);
        const float* mod_l = (const float*)(ws + WS_MOD) + (size_t)l * NSEQ * 3072;
        if (k == 0) {
            pg8::Gemm g{H, (const bf16_t*)(ws + WS_WIN), n, NIN, DM, DM};
            pg8::StaticOrder So; So.init(n, NIN, (int)gridDim.x, (int)blockIdx.x);
            EpiIn E{P, (const float*)(ws + WS_COSA), (const float*)(ws + WS_SINA), (const float*)(ws + WS_COSC), (const float*)(ws + WS_SINC),
                    (const float*)(ws + WS_GAIN) + l * 6 * 128, row0, (LAS float*)(lds + XCH_OFF)};
            pg8::gemm_phase<EpiIn, pg8::StaticOrder, true, true>(lds, g, So, E);
        } else if (k == 1) {
            const float* L = (const float*)(ws + WS_LAM);
            AttnCtx cx{P, T, OC, LSE, p.in[14] + l * 128, p.in[17] + (size_t)l * 8 * 465, L, l, row0, n};
            phase_attn(lds, cx);
        } else if (k == 2) {
            phase_cmix(P, OC, LSE, T + (size_t)2 * TCMAX * 512, n);
        } else if (k == 3) {
            pg8::Gemm g{T, (const bf16_t*)(ws + WS_WBR), 3 * TCMAX, 3072, 512, 512};
            BrOrder So{(int)gridDim.x, (int)blockIdx.x, (n >> 8) * 4};
            EpiBr E{P};
            pg8::gemm_phase<EpiBr, BrOrder, true, true>(lds, g, So, E);
        } else {
            pg8::Gemm g{P, (const bf16_t*)(ws + WS_WOUT), n, DM, DM, NIN};
            pg8::StaticOrder So; So.init(n, DM, (int)gridDim.x, (int)blockIdx.x);
            EpiOut E{p.in[0], p.in[1], p.out, mod_l, row0, l};
            pg8::gemm_phase<EpiOut, pg8::StaticOrder, true, true>(lds, g, So, E);
            if (c < 2) phase_h(p, c + 1, l, H);
        }
    }
}

extern "C" void kernel_launch(void* const* d_in, const int* in_sizes, int n_in, void* d_out, int out_size, void* d_ws, size_t ws_size, hipStream_t stream) {
    static int grid = 0;
    if (grid == 0) {
        if (n_in != 22 || ws_size < WS_END) { fprintf(stderr, "kernel_launch: unexpected n_in %d / ws_size %zu (need %zu)\n", n_in, ws_size, (size_t)WS_END); grid = -1; return; }
        int dev = 0, cus = 0, per_cu = 0;
        (void)hipGetDevice(&dev); (void)hipDeviceGetAttribute(&cus, hipDeviceAttributeMultiprocessorCount, dev);
        if (hipFuncSetAttribute((const void*)mega, hipFuncAttributeMaxDynamicSharedMemorySize, LDS_BYTES) != hipSuccess) { fprintf(stderr, "kernel_launch: hipFuncSetAttribute failed\n"); grid = -1; return; }
        (void)hipOccupancyMaxActiveBlocksPerMultiprocessor(&per_cu, (const void*)mega, NTHR, LDS_BYTES);
        if (per_cu < 1) { fprintf(stderr, "kernel_launch: occupancy query says %d blocks per CU\n", per_cu); per_cu = 1; }
        (void)hipGetLastError();
        grid = cus;
    }
    if (grid < 0) return;
    Params p{};
    for (int i = 0; i < 22; ++i) p.in[i] = (const float*)d_in[i];
    p.out = (float*)d_out; p.ws = (unsigned char*)d_ws;
#if ONE_LAUNCH
    if (hipMemsetAsync((char*)d_ws + WS_BAR, 0, 16384, stream) != hipSuccess) { fprintf(stderr, "kernel_launch: memset failed\n"); return; }
    p.ph_lo = 0; p.ph_hi = NPHASE;
    void* args[] = {&p};
    hipError_t e = hipLaunchCooperativeKernel((const void*)mega, dim3(grid), dim3(NTHR), args, LDS_BYTES, stream);
    if (e != hipSuccess) fprintf(stderr, "cooperative launch failed: %s (grid %d)\n", hipGetErrorString(e), grid);
#else
    for (int ph = 0; ph < NPHASE; ++ph) {
        p.ph_lo = ph; p.ph_hi = ph + 1;
        hipLaunchKernelGGL(mega, dim3(grid), dim3(NTHR), LDS_BYTES, stream, p);
    }
#endif
}
```

```cpp
#include <hip/hip_runtime.h>
#include <hip/hip_cooperative_groups.h>
#include <cstdio>
#include <cstdint>
namespace cg = cooperative_groups;
__device__ __forceinline__ int otid() { int t = threadIdx.x; asm volatile("" : "+v"(t)); return t; }
namespace pg8 {
#define PG8_LAS __attribute__((address_space(3)))
typedef unsigned short bf16_t;
typedef short bf16x8 __attribute__((ext_vector_type(8)));
typedef float f32x4 __attribute__((ext_vector_type(4)));
typedef unsigned u32x4 __attribute__((ext_vector_type(4)));
constexpr int BM = 256, BK = 64, HALF = 128, HTB = HALF * BK * 2  , STAGE_BYTES = 8 * HTB, NXCD = 8, WGM = 4;

__host__ __device__ __forceinline__ int lds_byte(int r, int c) { const int st = (r >> 4) * 2 + (c >> 5), rr = r & 15, cc = c & 31, ob = rr * 64 + cc * 2; return st * 1024 + (ob ^ (((ob >> 9) & 1) << 5)); }
__host__ __device__ __forceinline__ void stage_rc(int b, int& R, int& C) { const int st = b / 1024, sb = b % 1024, swz = sb ^ (((sb >> 9) & 1) << 5); R = (st >> 1) * 16 + swz / 64; C = (st & 1) * 32 + (swz % 64) / 2; }
__host__ __device__ __forceinline__ int perm32(int rho) { const int n = rho >> 4, i = rho & 15; return 8 * (i >> 2) + 4 * n + (i & 3); }

struct Unit { int pm, pn; };
struct Gemm { const bf16_t* A; const bf16_t* Bt; int M, N, K, lda; };

struct StaticOrder {
    int nM, nN, nwg, G, c;
    __host__ __device__ void init(int M, int N, int G_, int c_) { nM = M / BM; nN = N / BM; nwg = nM * nN; G = G_; c = c_; }
    __host__ __device__ bool next(int i, Unit& u) const {
        const long L = (long)i * G + c; if (L >= nwg) return false;
        int wgid = (int)L; { const int q = nwg / NXCD, r = nwg % NXCD, xcd = wgid % NXCD, off = wgid / NXCD; wgid = (xcd < r ? xcd * (q + 1) : r * (q + 1) + (xcd - r) * q) + off; }
        const int nig = WGM * nN, gid = wgid / nig, fm = gid * WGM, gsz = (nM - fm) < WGM ? (nM - fm) : WGM;
        u.pm = fm + ((wgid % nig) % gsz); u.pn = (wgid % nig) / gsz; return true;
    }
    __device__ __forceinline__ void a_ready(const Unit&) const {}
    __device__ __forceinline__ void done(const Unit&) const {}
};

__device__ __forceinline__ unsigned cvt_pk_bf16(float lo, float hi) { unsigned r; asm volatile("v_cvt_pk_bf16_f32 %0, %1, %2" : "=v"(r) : "v"(lo), "v"(hi)); return r; }

template <class Epi, class Sched, bool ALIGN_EPI = false, bool SP2 = false>
__device__ __forceinline__ void gemm_phase(PG8_LAS unsigned char* lds, const Gemm g, const Sched& S, const Epi& E) {
    const int tid = otid(), wid = __builtin_amdgcn_readfirstlane(tid >> 6), lane = tid & 63, wr = wid >> 2, wc = wid & 3, fr = lane & 15, fq = lane >> 4;
    const int K = g.K, nt = K / BK;
    unsigned voffA[2], voffB[2];
#pragma unroll
    for (int i = 0; i < 2; ++i) { int R, C; stage_rc(tid * 16 + i * 8192, R, C); const int Rb = Epi::PERM ? ((R & ~31) + perm32(R & 31)) : R;
        voffA[i] = (unsigned)(R * g.lda + C) * 2u; voffB[i] = (unsigned)(Rb * K + C) * 2u; }
    const size_t kstep = (size_t)(BK * 2);
    const size_t hstep = (size_t)HALF * K * 2;
    const size_t tstep = 2 * hstep;
    const size_t hstepA = (size_t)HALF * g.lda * 2, tstepA = 2 * hstepA;
    const unsigned ldsw = (unsigned)wid * 1024u;
    const int aoff = lds_byte(wr * 64 + fr, fq * 8), boff = lds_byte(wc * 32 + fr, fq * 8);
#define PG8_SA(b, h) (((b) * 2 + (h)) * HTB)
#define PG8_SB(b, h) ((4 + (b) * 2 + (h)) * HTB)
#define PG8_STAGE(bufoff, gbase, voff) do { _Pragma("unroll") for (int _i = 0; _i < 2; ++_i) \
        __builtin_amdgcn_global_load_lds((const unsigned*)((const char*)(gbase) + (voff)[_i]), (PG8_LAS unsigned*)(lds + (bufoff) + ldsw + _i * 8192), 16, 0, 0); } while (0)
#define PG8_LDA(dst, b, h) do { _Pragma("unroll") for (int m = 0; m < 4; ++m) _Pragma("unroll") for (int k = 0; k < 2; ++k) dst[m][k] = *(const PG8_LAS bf16x8*)(lds + PG8_SA(b, h) + aoff + m * 2048 + k * 1024); } while (0)
#define PG8_LDB(dst, b, h) do { _Pragma("unroll") for (int n = 0; n < 2; ++n) _Pragma("unroll") for (int k = 0; k < 2; ++k) dst[n][k] = *(const PG8_LAS bf16x8*)(lds + PG8_SB(b, h) + boff + n * 2048 + k * 1024); } while (0)
#define PG8_MMA(ai, bj, At, Bt) do { __builtin_amdgcn_s_setprio(1); _Pragma("unroll") for (int m = 0; m < 4; ++m) _Pragma("unroll") for (int n = 0; n < 2; ++n) _Pragma("unroll") for (int k = 0; k < 2; ++k) \
        acc[ai][bj][m][n] = __builtin_amdgcn_mfma_f32_16x16x32_bf16(Bt[n][k], At[m][k], acc[ai][bj][m][n], 0, 0, 0); __builtin_amdgcn_s_setprio(0); } while (0)
#define PG8_WAIT_V(n) asm volatile("s_waitcnt vmcnt(" #n ")" ::: "memory")
#define PG8_WAIT_L(n) asm volatile("s_waitcnt lgkmcnt(" #n ")" ::: "memory")
#define PG8_BAR __builtin_amdgcn_s_barrier()
#define PG8_SCHED __builtin_amdgcn_sched_barrier(0)
    Unit cur, nxt; int ui = 0;
    if (!S.next(0, cur)) return;
    f32x4 acc[2][2][4][2];
#pragma unroll
    for (int a = 0; a < 2; ++a)
#pragma unroll
        for (int b = 0; b < 2; ++b)
#pragma unroll
            for (int m = 0; m < 4; ++m)
#pragma unroll
                for (int n = 0; n < 2; ++n) acc[a][b][m][n] = (f32x4){0.f, 0.f, 0.f, 0.f};
    bf16x8 At[4][2], B0[2][2], B1[2][2];
    const char* cA = (const char*)g.A + (size_t)cur.pm * tstepA; const char* cB = (const char*)g.Bt + (size_t)cur.pn * tstep;
    S.a_ready(cur);
    if constexpr (SP2) {
        PG8_STAGE(PG8_SB(0, 0), cB, voffB); PG8_STAGE(PG8_SB(0, 1), cB + hstep, voffB); PG8_STAGE(PG8_SA(0, 0), cA, voffA); PG8_STAGE(PG8_SA(0, 1), cA + hstepA, voffA);
        if (wr == 1) PG8_BAR;
        PG8_WAIT_V(2); PG8_BAR;
        PG8_STAGE(PG8_SB(1, 0), cB + kstep, voffB); PG8_STAGE(PG8_SA(1, 0), cA + kstep, voffA); PG8_STAGE(PG8_SB(1, 1), cB + hstep + kstep, voffB);
        PG8_WAIT_V(6); PG8_BAR;
    } else {
        PG8_STAGE(PG8_SB(0, 0), cB, voffB); PG8_STAGE(PG8_SA(0, 0), cA, voffA); PG8_STAGE(PG8_SB(0, 1), cB + hstep, voffB); PG8_STAGE(PG8_SA(0, 1), cA + hstepA, voffA);
        if (wr == 1) PG8_BAR;
        PG8_WAIT_V(4); PG8_BAR;
        PG8_STAGE(PG8_SB(1, 0), cB + kstep, voffB); PG8_STAGE(PG8_SA(1, 0), cA + kstep, voffA); PG8_STAGE(PG8_SB(1, 1), cB + hstep + kstep, voffB);
        PG8_WAIT_V(6); PG8_BAR;
    }
    for (;;) {
        const bool has_next = S.next(ui + 1, nxt);
        const char* nA = has_next ? (const char*)g.A + (size_t)nxt.pm * tstepA : cA; const char* nB = has_next ? (const char*)g.Bt + (size_t)nxt.pn * tstep : cB;
        for (int t = 0; t < nt; t += 2) {
            const bool last = (t == nt - 2);
            const char* a1 = cA + (size_t)(t + 1) * kstep;
            const char* a2 = last ? nA : cA + (size_t)(t + 2) * kstep; const char* b2 = last ? nB : cB + (size_t)(t + 2) * kstep;
            const char* a3 = a2 + kstep; const char* b3 = b2 + kstep;
            if (last && has_next) S.a_ready(nxt);
            if constexpr (SP2) {
            PG8_LDB(B0, 0, 0); PG8_LDB(B1, 0, 1); PG8_SCHED; PG8_LDA(At, 0, 0); PG8_STAGE(PG8_SA(1, 1), a1 + hstepA, voffA);
            PG8_WAIT_V(8); PG8_WAIT_L(0); PG8_BAR; PG8_MMA(0, 0, At, B0); PG8_MMA(0, 1, At, B1); PG8_BAR; PG8_SCHED;
            PG8_LDA(At, 0, 1); PG8_STAGE(PG8_SB(0, 0), b2, voffB); PG8_STAGE(PG8_SB(0, 1), b2 + hstep, voffB); PG8_STAGE(PG8_SA(0, 0), a2, voffA);
            PG8_WAIT_V(8); PG8_WAIT_L(0); PG8_BAR; PG8_MMA(1, 0, At, B0); PG8_MMA(1, 1, At, B1); PG8_BAR; PG8_SCHED;
            PG8_LDB(B0, 1, 0); PG8_LDB(B1, 1, 1); PG8_SCHED; PG8_LDA(At, 1, 0); PG8_STAGE(PG8_SA(0, 1), a2 + hstepA, voffA);
            PG8_WAIT_V(8); PG8_WAIT_L(0); PG8_BAR; PG8_MMA(0, 0, At, B0); PG8_MMA(0, 1, At, B1); PG8_BAR; PG8_SCHED;
            PG8_LDA(At, 1, 1); PG8_STAGE(PG8_SB(1, 0), b3, voffB); PG8_STAGE(PG8_SB(1, 1), b3 + hstep, voffB); PG8_STAGE(PG8_SA(1, 0), a3, voffA);
            PG8_WAIT_V(8); PG8_WAIT_L(0); PG8_BAR; PG8_MMA(1, 0, At, B0); PG8_MMA(1, 1, At, B1); PG8_BAR; PG8_SCHED;
            } else {
            PG8_LDB(B0, 0, 0); PG8_SCHED; PG8_LDA(At, 0, 0); PG8_STAGE(PG8_SA(1, 1), a1 + hstepA, voffA);
            PG8_WAIT_L(8); PG8_BAR; PG8_WAIT_L(0); PG8_MMA(0, 0, At, B0); PG8_BAR; PG8_SCHED;
            PG8_LDB(B1, 0, 1); PG8_STAGE(PG8_SB(0, 0), b2, voffB);
            PG8_BAR; PG8_WAIT_L(0); PG8_MMA(0, 1, At, B1); PG8_BAR;
            PG8_LDA(At, 0, 1); PG8_STAGE(PG8_SA(0, 0), a2, voffA);
            PG8_BAR; PG8_WAIT_L(0); PG8_MMA(1, 0, At, B0); PG8_BAR; PG8_SCHED;
            PG8_STAGE(PG8_SB(0, 1), b2 + hstep, voffB);
            PG8_WAIT_V(6); PG8_BAR; PG8_MMA(1, 1, At, B1); PG8_BAR;
            PG8_LDB(B0, 1, 0); PG8_SCHED; PG8_LDA(At, 1, 0); PG8_STAGE(PG8_SA(0, 1), a2 + hstepA, voffA);
            PG8_WAIT_L(8); PG8_BAR; PG8_WAIT_L(0); PG8_MMA(0, 0, At, B0); PG8_BAR; PG8_SCHED;
            PG8_LDB(B1, 1, 1); PG8_STAGE(PG8_SB(1, 0), b3, voffB);
            PG8_BAR; PG8_WAIT_L(0); PG8_MMA(0, 1, At, B1); PG8_BAR;
            PG8_LDA(At, 1, 1); PG8_STAGE(PG8_SA(1, 0), a3, voffA);
            PG8_BAR; PG8_WAIT_L(0); PG8_MMA(1, 0, At, B0); PG8_BAR; PG8_SCHED;
            PG8_STAGE(PG8_SB(1, 1), b3 + hstep, voffB);
            PG8_WAIT_V(6); PG8_BAR; PG8_MMA(1, 1, At, B1); PG8_BAR;
            }
        }
        if constexpr (ALIGN_EPI) { if (wr == 0) PG8_BAR; }
        if constexpr (!Epi::AFTER_DRAIN) { E(acc, cur, wr, wc, fr, fq); S.done(cur); }
        if (!has_next) break;
        if (!E.keep(cur)) {
#pragma unroll
        for (int a = 0; a < 2; ++a)
#pragma unroll
            for (int b = 0; b < 2; ++b)
#pragma unroll
                for (int m = 0; m < 4; ++m)
#pragma unroll
                    for (int n = 0; n < 2; ++n) acc[a][b][m][n] = (f32x4){0.f, 0.f, 0.f, 0.f};
        }
        cur = nxt; cA = nA; cB = nB; ++ui;
        if constexpr (ALIGN_EPI) { if (wr == 1) PG8_BAR; }
    }
    PG8_WAIT_V(0);
    if constexpr (!ALIGN_EPI) { if (wr == 0) PG8_BAR; }
    PG8_BAR;
    if constexpr (Epi::AFTER_DRAIN) { E.fused(acc, cur, wr, wc, fr, fq, lds, wid, lane); S.done(cur); }
#undef PG8_SA
#undef PG8_SB
#undef PG8_STAGE
#undef PG8_LDA
#undef PG8_LDB
#undef PG8_MMA
#undef PG8_WAIT_V
#undef PG8_WAIT_L
#undef PG8_BAR
#undef PG8_SCHED
}
}

#define LAS __attribute__((address_space(3)))
#ifndef PH_MASK
#define PH_MASK 0xFFF
#endif
#ifndef DUP_PH
#define DUP_PH -1
#endif
typedef unsigned short bf16_t;
typedef short bf16x8 __attribute__((ext_vector_type(8)));
typedef short s16x4 __attribute__((ext_vector_type(4)));
typedef short v4i16_t __attribute__((ext_vector_type(4)));
typedef float f32x2 __attribute__((ext_vector_type(2)));
typedef float f32x4 __attribute__((ext_vector_type(4)));
typedef float f32x16 __attribute__((ext_vector_type(16)));
typedef unsigned u32x2 __attribute__((ext_vector_type(2)));
typedef unsigned u32x4 __attribute__((ext_vector_type(4)));
typedef __bf16 bf16x2_t __attribute__((ext_vector_type(2)));

constexpr int DM = 1024, NIN = 12288, TCMAX = 32768, NCHUNK = 3, NSEQ = 36, NTHR = 512, NPROMPT = 16384;
__device__ __forceinline__ int chunk_row0(int c) { return c * 32768; }
__device__ __forceinline__ int chunk_rows(int c) { return c == 2 ? 16384 : 32768; }
__device__ __forceinline__ int seq_len_of(int g) { return g < NPROMPT ? 4096 : 2048; }
__device__ __forceinline__ int seq_of(int g) { return g < NPROMPT ? (g >> 12) : 4 + ((g - NPROMPT) >> 11); }
constexpr int COL_A_Q = 0, COL_A_K = 512, COL_A_V = 1024, COL_B_Q = 1536, COL_B_K = 2048, COL_B_V = 2560, COL_C_Q = 3072, COL_C_K = 4608,
              COL_C_V = 6144, COL_Z = 7680, COL_G = 9216;
constexpr float EPS = 1e-6f, LOG2E = 1.4426950408889634f, NEGBIG = -1e30f;

constexpr size_t WS_WIN = 0;
constexpr size_t WS_WBR = WS_WIN + (size_t)NIN * DM * 2;
constexpr size_t WS_WOUT = WS_WBR + 3072ull * 512 * 2;
constexpr size_t WS_MOD = WS_WOUT + (size_t)DM * DM * 2;
constexpr size_t WS_COSA = WS_MOD + 2ull * NSEQ * 3072 * 4;
constexpr size_t WS_SINA = WS_COSA + 4096ull * 32 * 4;
constexpr size_t WS_COSC = WS_SINA + 4096ull * 32 * 4;
constexpr size_t WS_SINC = WS_COSC + 4096ull * 64 * 4;
constexpr size_t WS_LAM = WS_SINC + 4096ull * 64 * 4;
constexpr size_t WS_GAIN = WS_LAM + 256;
constexpr size_t WS_BAR = WS_GAIN + 2 * 6 * 128 * 4;
constexpr size_t WS_P = WS_BAR + 16384;
constexpr size_t WS_T = WS_P + (size_t)TCMAX * NIN * 2;
constexpr size_t WS_OC = WS_T + 3ull * TCMAX * 512 * 2;
constexpr size_t WS_LSE = WS_OC + (size_t)TCMAX * 1536 * 2;
constexpr size_t WS_END = WS_LSE + (size_t)TCMAX * 12 * 4;

constexpr int LDS_BYTES = 159744;
constexpr int XCH_OFF = 131072;
constexpr int NPHASE = 2 + 15 + 1 + 15;

struct Params { const float* in[22]; float* out; unsigned char* ws; int ph_lo, ph_hi; };

__device__ __forceinline__ unsigned pk2(float lo, float hi) { f32x2 v = {lo, hi}; bf16x2_t b = __builtin_convertvector(v, bf16x2_t); return __builtin_bit_cast(unsigned, b); }
__device__ __forceinline__ float bflo(unsigned u) { return __uint_as_float(u << 16); }
__device__ __forceinline__ float bfhi(unsigned u) { return __uint_as_float(u & 0xffff0000u); }
__device__ __forceinline__ float wave_sum(float v) {
#pragma unroll
    for (int o = 32; o >= 1; o >>= 1) v += __shfl_xor(v, o);
    return v;
}
__device__ __forceinline__ float fast_exp2(float x) { return __builtin_amdgcn_exp2f(x); }
__device__ __forceinline__ float sigmoidf_(float x) { return __builtin_amdgcn_rcpf(1.f + __builtin_amdgcn_exp2f(x * -1.4426950408889634f)); }
__device__ __forceinline__ float siluf_(float x) { return x * sigmoidf_(x); }

__host__ __device__ __forceinline__ int tile_type(int pn) {
    if (pn < 4) return 1; if (pn < 6) return 0; if (pn < 10) return 2; if (pn < 12) return 0; if (pn < 24) return 3; if (pn < 30) return 0; if (pn < 36) return 4; return 5;
}
__device__ __forceinline__ int phys_row(int col) {
    const int pn = col >> 8, lc = col & 255, ty = tile_type(pn);
    if (ty == 1 || ty == 2) { const int wc = (lc >> 6) & 3, bj = (lc >> 5) & 1, rest = lc & 31; return (pn << 8) + 128 * bj + 32 * wc + rest; }
    if (ty == 3) { const int hh = lc >> 7, bj = (lc >> 6) & 1, w0 = (lc >> 5) & 1, rest = lc & 31; return (pn << 8) + 128 * bj + 32 * (2 * hh + w0) + rest; }
    return col;
}

__device__ __forceinline__ void transpose_item(const float* __restrict__ W, int K, int N, bf16_t* Bt, int kt, int nt, bool perm, LAS float* tile) {
    const int t = otid(), k0 = kt * 64, n0 = nt * 64;
#pragma unroll
    for (int i = 0; i < 8; ++i) { const int k = i * 8 + (t >> 6), n = t & 63; tile[k * 65 + n] = W[(size_t)(k0 + k) * N + n0 + n]; }
    __syncthreads();
    const int n = t >> 3, kk = (t & 7) * 8;
    u32x4 w;
    w.x = pk2(tile[(kk + 0) * 65 + n], tile[(kk + 1) * 65 + n]); w.y = pk2(tile[(kk + 2) * 65 + n], tile[(kk + 3) * 65 + n]);
    w.z = pk2(tile[(kk + 4) * 65 + n], tile[(kk + 5) * 65 + n]); w.w = pk2(tile[(kk + 6) * 65 + n], tile[(kk + 7) * 65 + n]);
    const int col = n0 + n, row = perm ? phys_row(col) : col;
    *(u32x4*)(Bt + (size_t)row * K + k0 + kk) = w;
    __syncthreads();
}

__device__ __forceinline__ void mod_item(const Params& p, int item, LAS float* sc) {
    const int l = item / 48, cb = item % 48, t = otid();
    const float* cp = p.in[2]; const float* cs = p.in[3];
    for (int i = t; i < NSEQ * 1024; i += NTHR) { const int s = i >> 10, k = i & 1023; const float c = (s < 4) ? cp[s * 1024 + k] : cs[(s - 4) * 1024 + k]; sc[i] = siluf_(c); }
    __syncthreads();
    const int col = t & 63, ks = t >> 6;
    const float* w = p.in[5] + (size_t)l * 1024 * 3072 + cb * 64 + col;
    float acc[NSEQ];
#pragma unroll
    for (int s = 0; s < NSEQ; ++s) acc[s] = 0.f;
    for (int k = ks * 128; k < ks * 128 + 128; ++k) {
        const float wv = w[(size_t)k * 3072];
#pragma unroll
        for (int s = 0; s < NSEQ; ++s) acc[s] += sc[s * 1024 + k] * wv;
    }
    __syncthreads();
#pragma unroll
    for (int s = 0; s < NSEQ; ++s) sc[(ks * NSEQ + s) * 64 + col] = acc[s];
    __syncthreads();
    float* mod = (float*)(p.ws + WS_MOD) + (size_t)l * NSEQ * 3072;
    const float* b = p.in[6] + (size_t)l * 3072;
    for (int i = t; i < NSEQ * 64; i += NTHR) {
        const int s = i >> 6, c = i & 63; float v = 0.f;
#pragma unroll
        for (int q = 0; q < 8; ++q) v += sc[(q * NSEQ + s) * 64 + c];
        mod[s * 3072 + cb * 64 + c] = v + b[cb * 64 + c];
    }
    __syncthreads();
}

__device__ __forceinline__ void phase_prew(const Params& p, LAS unsigned char* lds, int l) {
    LAS float* scr = (LAS float*)lds;
    const int G = gridDim.x, bid = blockIdx.x;
    constexpr int N_WIN = 16 * 192, N_WBR = 3 * 8 * 16, N_WOUT = 16 * 16, PER_L = N_WIN + N_WBR + N_WOUT;
    for (int item = bid; item < PER_L; item += G) {
        int it = item;
        if (it < N_WIN) { transpose_item(p.in[7] + (size_t)l * DM * NIN, DM, NIN, (bf16_t*)(p.ws + WS_WIN), it & 15, it >> 4, true, scr); }
        else if (it < N_WIN + N_WBR) { it -= N_WIN; const int br = it >> 7, r = it & 127;
            transpose_item(p.in[20] + ((size_t)l * 3 + br) * 512 * 1024, 512, 1024, (bf16_t*)(p.ws + WS_WBR) + (size_t)br * 1024 * 512, r & 7, r >> 3, false, scr); }
        else { it -= N_WIN + N_WBR; transpose_item(p.in[21] + (size_t)l * DM * DM, DM, DM, (bf16_t*)(p.ws + WS_WOUT), it & 15, it >> 4, false, scr); }
    }
}

__device__ __forceinline__ void phase_pre(const Params& p, LAS unsigned char* lds) {
    LAS float* scr = (LAS float*)lds;
    const int G = gridDim.x, bid = blockIdx.x, t = otid();
    for (int item = bid; item < 96; item += G) mod_item(p, item, scr);
    const int gt = bid * NTHR + t, gn = G * NTHR;
    float* cosA = (float*)(p.ws + WS_COSA); float* sinA = (float*)(p.ws + WS_SINA); float* cosC = (float*)(p.ws + WS_COSC); float* sinC = (float*)(p.ws + WS_SINC);
    for (int i = gt; i < 4096 * 96; i += gn) {
        int pos, j; float inv; float* cd; float* sd;
        if (i < 4096 * 32) { pos = i >> 5; j = i & 31; inv = exp2f(-(float)j * (13.287712379549449f / 32.f)); cd = cosA + i; sd = sinA + i; }
        else { const int i2 = i - 4096 * 32; pos = i2 >> 6; j = i2 & 63; inv = exp2f(-(float)j * (13.287712379549449f / 64.f)); cd = cosC + i2; sd = sinC + i2; }
        double x = (double)pos * (double)inv * 0.15915494309189535;
        x -= floor(x);
        const float r = (float)(x * 6.283185307179586);
        *cd = __cosf(r); *sd = __sinf(r);
    }
    if (bid == 1) {
        float* gt = (float*)(p.ws + WS_GAIN);
        for (int i = t; i < 2 * 6 * 128; i += NTHR) {
            const int l = i / 768, w = (i % 768) >> 7, d = i & 127; float v = 0.f;
            if (w == 0) { if (d < 64) v = p.in[8][l * 64 + d]; } else if (w == 1) { if (d < 64) v = p.in[9][l * 64 + d]; }
            else if (w == 2) { if (d < 64) v = p.in[15][l * 64 + d]; } else if (w == 3) { if (d < 64) v = p.in[16][l * 64 + d]; }
            else if (w == 4) v = p.in[18][l * 128 + d]; else v = p.in[19][l * 128 + d];
            gt[i] = v;
        }
    }
    if (bid == 0 && t < 2) {
        const int l = t; float a = 0.f, b = 0.f;
        for (int i = 0; i < 64; ++i) { a += p.in[10][l * 64 + i] * p.in[11][l * 64 + i]; b += p.in[12][l * 64 + i] * p.in[13][l * 64 + i]; }
        const float lam_init = 0.8f - 0.6f * expf(-0.3f * (float)l);
        float* L = (float*)(p.ws + WS_LAM);
        L[l] = expf(a) - expf(b) + lam_init; L[2 + l] = 1.f - lam_init;
    }
}

__device__ __forceinline__ void phase_h(const Params& p, int c, int l, bf16_t* H) {
    const int wave = otid() >> 6, lane = otid() & 63;
    const int row0 = chunk_row0(c), n = chunk_rows(c);
    const float* lng = p.in[4] + l * DM;
    const float* mod_l = (const float*)(p.ws + WS_MOD) + (size_t)l * NSEQ * 3072;
    for (int row = blockIdx.x * 8 + wave; row < n; row += gridDim.x * 8) {
        const int g = row0 + row;
        const float* xr = (l == 0) ? ((g < NPROMPT) ? p.in[0] + (size_t)g * DM : p.in[1] + (size_t)(g - NPROMPT) * DM) : p.out + (size_t)g * DM;
        f32x4 v[4]; float ss = 0.f;
#pragma unroll
        for (int j = 0; j < 4; ++j) { v[j] = *(const f32x4*)(xr + j * 256 + lane * 4); ss += v[j][0] * v[j][0] + v[j][1] * v[j][1] + v[j][2] * v[j][2] + v[j][3] * v[j][3]; }
        ss = wave_sum(ss);
        const float rstd = rsqrtf(ss * (1.f / 1024.f) + EPS);
        const float* md = mod_l + (size_t)seq_of(g) * 3072;
#pragma unroll
        for (int j = 0; j < 4; ++j) {
            const int col = j * 256 + lane * 4;
            const f32x4 gg = *(const f32x4*)(lng + col), sh = *(const f32x4*)(md + col), sc = *(const f32x4*)(md + 1024 + col);
            const f32x4 h = v[j] * rstd * gg * (sc + 1.0f) + sh;
            u32x2 o; o.x = pk2(h[0], h[1]); o.y = pk2(h[2], h[3]);
            *(u32x2*)(H + (size_t)row * DM + col) = o;
        }
    }
}

__device__ __forceinline__ u32x4 pack8(const f32x4& a, const f32x4& b) { u32x4 w; w.x = pk2(a[0], a[1]); w.y = pk2(a[2], a[3]); w.z = pk2(b[0], b[1]); w.w = pk2(b[2], b[3]); return w; }
__device__ __forceinline__ float dot4(const f32x4& a) { return a[0] * a[0] + a[1] * a[1] + a[2] * a[2] + a[3] * a[3]; }

struct EpiIn {
    static constexpr bool PERM = true, AFTER_DRAIN = false;
    bf16_t* P; const float* cosA; const float* sinA; const float* cosC; const float* sinC;
    const float* gtab; int row0; LAS float* xch;
    __device__ __forceinline__ bool keep(const pg8::Unit&) const { return false; }
    template <bool ROPE>
    __device__ __forceinline__ static void piece(f32x4 a, f32x4 b, float rs, const float* glo, const float* ghi, const float* cp, const float* sp, u32x2& pa, u32x2& pb) {
        a = a * rs * *(const f32x4*)glo; b = b * rs * *(const f32x4*)ghi;
        if (ROPE) { const f32x4 c = *(const f32x4*)cp, sn = *(const f32x4*)sp; const f32x4 na = a * c - b * sn, nb = b * c + a * sn; a = na; b = nb; }
        pa.x = pk2(a[0], a[1]); pa.y = pk2(a[2], a[3]); pb.x = pk2(b[0], b[1]); pb.y = pk2(b[2], b[3]);
    }
    template <bool ROPE>
    __device__ __forceinline__ void head64(const f32x4 (&acc)[2][2][4][2], const float* g, float qs, bf16_t* pb, int gq0, int fq) const {
#pragma unroll
        for (int ai = 0; ai < 2; ++ai)
#pragma unroll
            for (int m = 0; m < 4; ++m) {
                float ss = dot4(acc[ai][0][m][0]) + dot4(acc[ai][0][m][1]) + dot4(acc[ai][1][m][0]) + dot4(acc[ai][1][m][1]);
                ss += __shfl_xor(ss, 16); ss += __shfl_xor(ss, 32);
                const float rs = rsqrtf(ss * (1.f / 64.f) + EPS) * qs;
                const int roff = ai * 128 + m * 16;
                const int gq = gq0 + roff; const int pos = gq & (seq_len_of(gq) - 1);
                const float* cp = cosA + pos * 32 + 8 * fq; const float* sp = sinA + pos * 32 + 8 * fq;
                u32x2 pa0, pb0, pa1, pb1;
                piece<ROPE>(acc[ai][0][m][0], acc[ai][1][m][0], rs, g, g + 32, cp, sp, pa0, pb0);
                piece<ROPE>(acc[ai][0][m][1], acc[ai][1][m][1], rs, g + 4, g + 36, cp + 4, sp + 4, pa1, pb1);
                *(u32x4*)(pb + (size_t)roff * NIN) = (u32x4){pa0.x, pa0.y, pa1.x, pa1.y};
                *(u32x4*)(pb + (size_t)roff * NIN + 32) = (u32x4){pb0.x, pb0.y, pb1.x, pb1.y};
            }
    }
    template <int ACT>
    __device__ __forceinline__ void plain(const f32x4 (&acc)[2][2][4][2], bf16_t* pb) const {
#pragma unroll
        for (int ai = 0; ai < 2; ++ai)
#pragma unroll
            for (int m = 0; m < 4; ++m)
#pragma unroll
                for (int bj = 0; bj < 2; ++bj) {
                    f32x4 v0 = acc[ai][bj][m][0], v1 = acc[ai][bj][m][1];
                    if (ACT == 4) {
#pragma unroll
                        for (int e = 0; e < 4; ++e) { v0[e] = siluf_(v0[e]); v1[e] = siluf_(v1[e]); }
                    } else if (ACT == 5) {
#pragma unroll
                        for (int e = 0; e < 4; ++e) { v0[e] = sigmoidf_(v0[e]); v1[e] = sigmoidf_(v1[e]); }
                    }
                    *(u32x4*)(pb + (size_t)(ai * 128 + m * 16) * NIN + bj * 128) = pack8(v0, v1);
                }
    }
    __device__ __forceinline__ void operator()(const f32x4 (&acc)[2][2][4][2], const pg8::Unit& u, int wr, int wc, int fr, int fq) const {
        const int pn = u.pn, ty = tile_type(pn);
        const int rl0 = wr * 64 + fr;
        const size_t rowg0 = (size_t)u.pm * 256 + rl0;
        const int gq0 = row0 + (int)rowg0;
        if (ty == 1 || ty == 2) {
            const bool isq = (ty == 1) ? (pn < 2) : (pn < 8);
            const float* g = gtab + ((ty == 1 ? 0 : 2) + (isq ? 0 : 1)) * 128 + 8 * fq;
            const float qs = isq ? 0.125f * LOG2E : 1.f;
            bf16_t* pb = P + rowg0 * NIN + pn * 256 + 64 * wc + 8 * fq;
            if (ty == 1) head64<true>(acc, g, qs, pb, gq0, fq); else head64<false>(acc, g, qs, pb, gq0, fq);
        } else if (ty == 3) {
            const bool isq = pn < 18;
            const float qs = isq ? 0.08838834764831845f * LOG2E : 1.f;
            const int hh = wc >> 1, w0 = wc & 1;
#pragma unroll
            for (int ai = 0; ai < 2; ++ai)
#pragma unroll
                for (int m = 0; m < 4; ++m) {
                    float ss = dot4(acc[ai][0][m][0]) + dot4(acc[ai][0][m][1]) + dot4(acc[ai][1][m][0]) + dot4(acc[ai][1][m][1]);
                    ss += __shfl_xor(ss, 16); ss += __shfl_xor(ss, 32);
                    if (fq == 0) xch[(ai * 128 + m * 16 + rl0) * 4 + wc] = ss;
                }
            __syncthreads();
            const int dlo = 32 * w0 + 8 * fq;
            const float* g = gtab + (isq ? 4 : 5) * 128 + dlo;
            bf16_t* pb = P + rowg0 * NIN + pn * 256 + 128 * hh + dlo;
#pragma unroll
            for (int ai = 0; ai < 2; ++ai)
#pragma unroll
                for (int m = 0; m < 4; ++m) {
                    const int roff = ai * 128 + m * 16;
                    const f32x2 t2 = *(LAS const f32x2*)(xch + (roff + rl0) * 4 + 2 * hh);
                    const float rs = rsqrtf((t2[0] + t2[1]) * (1.f / 128.f) + EPS) * qs;
                    const int gq = gq0 + roff; const int pos = gq & (seq_len_of(gq) - 1);
                    const float* cp = cosC + pos * 64 + dlo; const float* sp = sinC + pos * 64 + dlo;
                    u32x2 pa0, pb0, pa1, pb1;
                    piece<true>(acc[ai][0][m][0], acc[ai][1][m][0], rs, g, g + 64, cp, sp, pa0, pb0);
                    piece<true>(acc[ai][0][m][1], acc[ai][1][m][1], rs, g + 4, g + 68, cp + 4, sp + 4, pa1, pb1);
                    *(u32x4*)(pb + (size_t)roff * NIN) = (u32x4){pa0.x, pa0.y, pa1.x, pa1.y};
                    *(u32x4*)(pb + (size_t)roff * NIN + 64) = (u32x4){pb0.x, pb0.y, pb1.x, pb1.y};
                }
        } else {
            bf16_t* pb = P + rowg0 * NIN + pn * 256 + 32 * wc + 8 * fq;
            if (ty == 4) plain<4>(acc, pb); else if (ty == 5) plain<5>(acc, pb); else plain<0>(acc, pb);
        }
    }
};

struct BrOrder {
    int G, c, ntile;
    __device__ __forceinline__ bool next(int i, pg8::Unit& u) const {
        const int tk = i / 3, br = i - 3 * tk, tile = c + tk * G; if (tile >= ntile) return false;
        u.pm = (tile >> 2) + br * (TCMAX / 256); u.pn = (tile & 3) + br * 4; return true;
    }
    __device__ __forceinline__ void a_ready(const pg8::Unit&) const {}
    __device__ __forceinline__ void done(const pg8::Unit&) const {}
};

struct EpiBr {
    static constexpr bool PERM = true, AFTER_DRAIN = false;
    bf16_t* P;
    __device__ __forceinline__ bool keep(const pg8::Unit& u) const { return (u.pm >> 7) < 2; }
    __device__ __forceinline__ void operator()(f32x4 (&acc)[2][2][4][2], const pg8::Unit& u, int wr, int wc, int fr, int fq) const {
        const int br = u.pm >> 7, pm = u.pm & 127, pn = u.pn & 3;
        const size_t row0 = (size_t)pm * 256 + wr * 64 + fr; const int col0 = pn * 256 + 32 * wc + 8 * fq;
        const bf16_t* gp = P + row0 * NIN + COL_G + br * 1024 + col0;
        if (br < 2) {
#pragma unroll
            for (int ai = 0; ai < 2; ++ai)
#pragma unroll
                for (int m = 0; m < 4; ++m)
#pragma unroll
                    for (int bj = 0; bj < 2; ++bj) {
                        const bf16_t* q = gp + (size_t)(ai * 128 + m * 16) * NIN + bj * 128;
                        const u32x4 sg = *(const u32x4*)q, sn = *(const u32x4*)(q + 1024);
                        f32x4 f0 = {bflo(sg.x), bfhi(sg.x), bflo(sg.y), bfhi(sg.y)}, f1 = {bflo(sg.z), bfhi(sg.z), bflo(sg.w), bfhi(sg.w)};
                        f0[0] *= __builtin_amdgcn_rcpf(bflo(sn.x)); f0[1] *= __builtin_amdgcn_rcpf(bfhi(sn.x)); f0[2] *= __builtin_amdgcn_rcpf(bflo(sn.y)); f0[3] *= __builtin_amdgcn_rcpf(bfhi(sn.y));
                        f1[0] *= __builtin_amdgcn_rcpf(bflo(sn.z)); f1[1] *= __builtin_amdgcn_rcpf(bfhi(sn.z)); f1[2] *= __builtin_amdgcn_rcpf(bflo(sn.w)); f1[3] *= __builtin_amdgcn_rcpf(bfhi(sn.w));
                        acc[ai][bj][m][0] *= f0; acc[ai][bj][m][1] *= f1;
                    }
        } else {
            bf16_t* op = P + row0 * NIN + col0;
#pragma unroll
            for (int ai = 0; ai < 2; ++ai)
#pragma unroll
                for (int m = 0; m < 4; ++m)
#pragma unroll
                    for (int bj = 0; bj < 2; ++bj) {
                        const size_t o = (size_t)(ai * 128 + m * 16) * NIN + bj * 128;
                        const u32x4 sg = *(const u32x4*)(gp + o);
                        const f32x4 f0 = {bflo(sg.x), bfhi(sg.x), bflo(sg.y), bfhi(sg.y)}, f1 = {bflo(sg.z), bfhi(sg.z), bflo(sg.w), bfhi(sg.w)};
                        *(u32x4*)(op + o) = pack8(acc[ai][bj][m][0] * f0, acc[ai][bj][m][1] * f1);
                    }
        }
    }
};

struct EpiOut {
    static constexpr bool PERM = true, AFTER_DRAIN = false;
    const float* xp; const float* xs; float* out; const float* mod_l; int row0, layer;
    __device__ __forceinline__ bool keep(const pg8::Unit&) const { return false; }
    __device__ __forceinline__ void operator()(const f32x4 (&acc)[2][2][4][2], const pg8::Unit& u, int wr, int wc, int fr, int fq) const {
        const int g0 = row0 + u.pm * 256 + wr * 64 + fr; const int col0 = u.pn * 256 + 32 * wc + 8 * fq;
#pragma unroll
        for (int ai = 0; ai < 2; ++ai)
#pragma unroll
            for (int m = 0; m < 4; ++m) {
                const int g = g0 + ai * 128 + m * 16;
                const float* gt = mod_l + (size_t)seq_of(g) * 3072 + 2048;
                const float* xr = (layer == 0) ? ((g < NPROMPT) ? xp + (size_t)g * DM : xs + (size_t)(g - NPROMPT) * DM) : out + (size_t)g * DM;
                float* orow = out + (size_t)g * DM;
#pragma unroll
                for (int bj = 0; bj < 2; ++bj) {
                    const int col = col0 + bj * 128;
                    const f32x4 g0v = *(const f32x4*)(gt + col), g1v = *(const f32x4*)(gt + col + 4);
                    const f32x4 x0 = *(const f32x4*)(xr + col), x1 = *(const f32x4*)(xr + col + 4);
                    *(f32x4*)(orow + col) = x0 + g0v * acc[ai][bj][m][0];
                    *(f32x4*)(orow + col + 4) = x1 + g1v * acc[ai][bj][m][1];
                }
            }
    }
};

struct AttnCtx { const bf16_t* P; bf16_t* T; bf16_t* OC; float* LSE; const float* subln; const float* rpb; const float* lamp; int layer; int row0, n; };

__device__ __forceinline__ int crow(int i, int h) { return (i & 3) + 8 * (i >> 2) + 4 * h; }
__device__ __forceinline__ s16x4 vtr(LAS const unsigned char* p) { return __builtin_bit_cast(s16x4, __builtin_amdgcn_ds_read_tr16_b64_v4i16((LAS v4i16_t*)p)); }
#define MFMA32(a, b, c) __builtin_amdgcn_mfma_f32_32x32x16_bf16((a), (b), (c), 0, 0, 0)
#define DS_TR16(dst, addr, off) asm volatile("ds_read_b64_tr_b16 %0, %1 offset:%c2" : "=&v"(dst) : "v"(addr), "i"(off) : "memory")
#define DS_RD128(dst, addr, off) asm volatile("ds_read_b128 %0, %1 offset:%c2" : "=&v"(dst) : "v"(addr), "i"(off) : "memory")
#define LGKM0() asm volatile("s_waitcnt lgkmcnt(0)" ::: "memory")
#define SBAR() __builtin_amdgcn_sched_barrier(0)
__device__ __forceinline__ float max3f(float a, float b, float c) { float r; asm("v_max3_f32 %0, %1, %2, %3" : "=v"(r) : "v"(a), "v"(b), "v"(c)); return r; }
__device__ __forceinline__ void wait_vm(int n) {
    switch (n) {
#define WV(k) case k: asm volatile("s_waitcnt vmcnt(" #k ")" ::: "memory"); break;
        WV(1) WV(2) WV(3) WV(4) WV(5) WV(6) WV(7) WV(8) WV(9) WV(10) WV(12) WV(14) WV(15) WV(16) WV(18) WV(20)
#undef WV
        default: asm volatile("s_waitcnt vmcnt(0)" ::: "memory"); break;
    }
}

template <int DQK, int DV, int MODE>
__device__ __forceinline__ void attn_item(LAS unsigned char* lds, int item, const AttnCtx& cx) {
    constexpr int KP = DQK * 2 + 16, VP = DV * 2 + 64, KBY = 64 * KP, VBY = 64 * VP, HB = KBY + VBY;
    constexpr int NQF = DQK / 16, NDV = DV / 32, NKP = DQK / 32, NVP = DV / 32, KPR = DQK / 8, VPR = DV / 8;
    const int tid = otid(), lane = tid & 63, wave = __builtin_amdgcn_readfirstlane(tid >> 6), hf = wave >> 2, wq = wave & 3, r = lane & 31, h = lane >> 5, th = tid & 255;
    const bf16_t* __restrict__ P = cx.P;
    int head, tok0, seqbase, qcol, kcol, vcol, ntiles, qtok, S;
    int na_rows = 0, na_rs0 = 0, na_rq = 0, na_cq = 0, na_rsq = 0, na_csq = 0;
    int c_dlog = 0, c_rho = 0, c_l0 = 0, c_L = 0, c_lq = 0;
    if (MODE == 0) {
        head = item & 3; tok0 = (item >> 2) * 128; S = seq_len_of(cx.row0 + tok0); seqbase = ((cx.row0 + tok0) & ~(S - 1)) - cx.row0;
        qcol = COL_A_Q + head * 128 + hf * 64; kcol = COL_A_K + head * 128 + hf * 64; vcol = COL_A_V + head * 128; ntiles = S >> 6;
        qtok = tok0 + 32 * wq + r;
    } else if (MODE == 1) {
        const int unit = item * 2 + hf, nbk = cx.n >> 7; head = unit / nbk; tok0 = (unit - head * nbk) * 128; S = seq_len_of(cx.row0 + tok0); seqbase = ((cx.row0 + tok0) & ~(S - 1)) - cx.row0;
        qcol = COL_B_Q + head * 64; kcol = COL_B_K + head * 64; vcol = COL_B_V + head * 64; ntiles = 9;
        qtok = tok0 + 32 * wq + r;
        na_rows = S >> 6; const int r0 = (tok0 - seqbase) >> 6; na_rs0 = min(max(r0 - 4, 0), na_rows - 8);
        na_rq = r0 + (wq >> 1); na_cq = 32 * (wq & 1) + r; na_rsq = min(max(na_rq - 4, 0), na_rows - 8); na_csq = min(max(na_cq - 8, 0), 48);
    } else {
        const int unit = item * 2 + hf, nbk = cx.n >> 7; head = unit / nbk; const int blk = unit - head * nbk; tok0 = blk * 128; S = seq_len_of(cx.row0 + tok0); seqbase = ((cx.row0 + tok0) & ~(S - 1)) - cx.row0;
        qcol = COL_C_Q + head * 128; kcol = COL_C_K + head * 128; vcol = COL_C_V + head * 128; ntiles = 4;
        c_dlog = 2 * (head >> 2); const int b = (tok0 - seqbase) >> 7; c_rho = b & ((1 << c_dlog) - 1); c_l0 = (b >> c_dlog) * 128; c_L = S >> c_dlog;
        c_lq = c_l0 + 32 * wq + r; qtok = seqbase + (c_lq << c_dlog) + c_rho;
    }
    auto ktok = [&](int j, int kr) -> int {
        if (MODE == 0) return seqbase + 64 * j + kr;
        if (MODE == 1) return seqbase + min(na_rs0 + j, na_rows - 1) * 64 + kr;
        const int lk = min(max(c_l0 - 64 + 64 * j + kr, 0), c_L - 1); return seqbase + (lk << c_dlog) + c_rho;
    };
    const bool loadV = !(MODE == 0 && hf == 1);
#ifndef DMA_MODES
#define DMA_MODES 1
#endif
    constexpr bool DMA = ((DMA_MODES >> MODE) & 1) != 0;
    constexpr int NST = !DMA ? 2 : ((MODE == 0) ? 4 : ((MODE == 1) ? 3 : 2));
    constexpr bool ROT = DMA && (MODE == 0);
    constexpr int DIST = NST - 1, WAHEAD = ROT ? 1 : 0;
    const bool rot = ROT && (hf == 1);
    constexpr int SB = (MODE == 0) ? (2 * KBY + VBY) : (2 * HB);
    constexpr int KCH = KBY / 1024, VCH = VBY / 1024, LPWMAX = (KCH + VCH + 3) / 4;
    static_assert(KBY % 1024 == 0 && VBY % 1024 == 0 && NST * SB + (MODE == 1 ? 4096 : 0) <= LDS_BYTES - 16, "attention LDS ring");
    const int koff = (MODE == 0) ? hf * KBY : hf * HB, voff = (MODE == 0) ? 2 * KBY : hf * HB + KBY;
    const int nchh = KCH + (loadV ? VCH : 0);
    const int n_w = (nchh - wq + 3) >> 2;
    auto issue = [&](int j) {
        const int sbase = (j % NST) * SB;
#pragma unroll
        for (int i = 0; i < LPWMAX; ++i) {
            const int cid = wq + 4 * i;
            if (cid < nchh) {
                const bool isv = cid >= KCH; const int lc = isv ? cid - KCH : cid;
                const int pc = lc * 64 + lane, ppr = isv ? VP / 16 : KP / 16, row = pc / ppr, cp = pc - row * ppr;
                if (cp < (isv ? DV / 8 : DQK / 8)) {
                    const bf16_t* src = P + (size_t)ktok(j, row) * NIN + (isv ? vcol : kcol) + cp * 8;
                    __builtin_amdgcn_global_load_lds((const unsigned*)src, (LAS unsigned*)(lds + sbase + (isv ? voff : koff) + lc * 1024), 16, 0, 0);
                }
            }
        }
    };
    u32x4 kreg[DMA ? 1 : NKP], vreg[DMA ? 1 : NVP];
    auto gload = [&](int j) {
#pragma unroll
        for (int i = 0; i < NKP; ++i) { const int pid = th + 256 * i, row = pid / KPR, cp = pid % KPR; kreg[DMA ? 0 : i] = *(const u32x4*)(P + (size_t)ktok(j, row) * NIN + kcol + cp * 8); }
        if (loadV) {
#pragma unroll
            for (int i = 0; i < NVP; ++i) { const int pid = th + 256 * i, row = pid / VPR, cp = pid % VPR; vreg[DMA ? 0 : i] = *(const u32x4*)(P + (size_t)ktok(j, row) * NIN + vcol + cp * 8); }
        }
    };
    auto lstore = [&](int b) {
        LAS unsigned char* base = lds + b * SB;
#pragma unroll
        for (int i = 0; i < NKP; ++i) { const int pid = th + 256 * i, row = pid / KPR, cp = pid % KPR; *(LAS u32x4*)(base + koff + row * KP + cp * 16) = kreg[DMA ? 0 : i]; }
        if (loadV) {
#pragma unroll
            for (int i = 0; i < NVP; ++i) { const int pid = th + 256 * i, row = pid / VPR, cp = pid % VPR; *(LAS u32x4*)(base + voff + row * VP + cp * 16) = vreg[DMA ? 0 : i]; }
        }
    };
    LAS float* biasL = (LAS float*)(lds + NST * SB) + hf * 512;
    if (DMA) {
#pragma unroll
        for (int j0 = 0; j0 < DIST; ++j0) if (j0 < ntiles) issue(j0);
    } else gload(0);
    bf16x8 qf[NQF];
#pragma unroll
    for (int ks = 0; ks < NQF; ++ks) qf[ks] = *(const bf16x8*)(P + (size_t)qtok * NIN + qcol + 16 * ks + 8 * h);
    if (MODE == 1) { for (int i = th; i < 465; i += 256) biasL[i] = cx.rpb[head * 465 + i] * LOG2E; }
    f32x16 O[NDV];
#pragma unroll
    for (int d = 0; d < NDV; ++d)
#pragma unroll
        for (int i = 0; i < 16; ++i) O[d][i] = 0.f;
    float mhat = 0.f; bool first = true;
    f32x16 negm, Lacc;
#pragma unroll
    for (int i = 0; i < 16; ++i) { negm[i] = 0.f; Lacc[i] = 0.f; }
    const bf16x8 ones8 = {(short)0x3F80, (short)0x3F80, (short)0x3F80, (short)0x3F80, (short)0x3F80, (short)0x3F80, (short)0x3F80, (short)0x3F80};
    constexpr float THR = 6.f;
#pragma unroll
    for (int ks = 0; ks < NQF; ++ks) asm volatile("" : "+v"(qf[ks]));
    if (!DMA) { lstore(0); __syncthreads(); }
    else if (MODE == 1) __syncthreads();
    const int q4 = (lane & 15) >> 2, p4 = lane & 3, rblk = (lane >> 4) & 1;
    bf16x8 pa[2][2];
    s16x4 vlo[2][4], vhi[2][4];
    f32x16 s0, s1;
#define V_ISSUE(va, b, d) do { _Pragma("unroll") for (int k4 = 0; k4 < 4; ++k4) { DS_TR16(vlo[b][k4], va, (16 * k4) * VP + (d) * 64); DS_TR16(vhi[b][k4], va, (16 * k4 + 8) * VP + (d) * 64); } } while (0)
#define K_ISSUE(b, kb) do { DS_RD128(kfr[b][0], kaddr, (2 * (kb)) * 32); DS_RD128(kfr[b][1], kaddr, 32 * KP + (2 * (kb)) * 32); \
                            DS_RD128(kfr[b][2], kaddr, (2 * (kb) + 1) * 32); DS_RD128(kfr[b][3], kaddr, 32 * KP + (2 * (kb) + 1) * 32); } while (0)
    auto vaddr_of = [&](int j) -> unsigned { return (unsigned)(size_t)(lds + (j % NST) * SB + voff) + (4 * h + q4) * VP + (16 * rblk + 4 * p4) * 2; };
    auto do_qk = [&](int j, bool vpre) {
        const unsigned kaddr = (unsigned)(size_t)(lds + (j % NST) * SB + koff) + r * KP + 16 * h;
        const unsigned va = vaddr_of(j);
        bf16x8 kfr[1][4];
        K_ISSUE(0, 0);
#pragma unroll
        for (int kb = 0; kb < NQF / 2; ++kb) {
            LGKM0(); SBAR();
            if (kb == 0) { s0 = MFMA32(kfr[0][0], qf[0], negm); s1 = MFMA32(kfr[0][1], qf[0], negm); }
            else { s0 = MFMA32(kfr[0][0], qf[2 * kb], s0); s1 = MFMA32(kfr[0][1], qf[2 * kb], s1); }
            s0 = MFMA32(kfr[0][2], qf[2 * kb + 1], s0); s1 = MFMA32(kfr[0][3], qf[2 * kb + 1], s1);
            SBAR();
            if (kb + 1 < NQF / 2) K_ISSUE(0, kb + 1); else if (vpre) V_ISSUE(va, 0, 0);
        }
    };
    auto do_soft = [&](int j) {
        if (MODE == 1) {
            const int rk = na_rs0 + j; const int bbase = (rk - na_rq + 7) * 31 + 15 - na_cq;
#pragma unroll
            for (int i = 0; i < 16; ++i) {
                const int ck0 = crow(i, h), ck1 = ck0 + 32;
                const bool v0 = (ck0 >= na_csq) && (ck0 < na_csq + 16), v1 = (ck1 >= na_csq) && (ck1 < na_csq + 16);
                const float b0 = biasL[v0 ? bbase + ck0 : 0], b1 = biasL[v1 ? bbase + ck1 : 0];
                s0[i] = v0 ? s0[i] + b0 : NEGBIG; s1[i] = v1 ? s1[i] + b1 : NEGBIG;
            }
        }
        if (MODE == 2) {
            const int lk0 = c_l0 - 64 + 64 * j;
#pragma unroll
            for (int i = 0; i < 16; ++i) {
                const int lka = lk0 + crow(i, h), lkb = lka + 32;
                const bool v0 = (lka >= 0) && (lka < c_L) && (abs(lka - c_lq) <= 64), v1 = (lkb >= 0) && (lkb < c_L) && (abs(lkb - c_lq) <= 64);
                s0[i] = v0 ? s0[i] : NEGBIG; s1[i] = v1 ? s1[i] : NEGBIG;
            }
        }
        float mx = max3f(s0[0], s1[0], s0[1]);
        mx = max3f(mx, s1[1], s0[2]);
#pragma unroll
        for (int i = 2; i < 15; ++i) mx = max3f(mx, s1[i], s0[i + 1]);
        mx = fmaxf(mx, s1[15]);
        { auto rr = __builtin_amdgcn_permlane32_swap(__float_as_uint(mx), __float_as_uint(mx), false, false); mx = max3f(__uint_as_float(rr[0]), __uint_as_float(rr[1]), __uint_as_float(rr[0])); }
        if (first || __builtin_amdgcn_ballot_w64(mx > THR) != 0ull) {
            const float delta = first ? mx : fmaxf(mx, 0.f), alpha = fast_exp2(-delta);
#pragma unroll
            for (int i = 0; i < 16; ++i) { s0[i] -= delta; s1[i] -= delta; }
            if (!first) {
#pragma unroll
                for (int d = 0; d < NDV; ++d)
#pragma unroll
                    for (int i = 0; i < 16; ++i) O[d][i] *= alpha;
#pragma unroll
                for (int i = 0; i < 16; ++i) Lacc[i] *= alpha;
            }
            mhat += delta;
#pragma unroll
            for (int i = 0; i < 16; ++i) negm[i] = -mhat;
            first = false;
        }
#pragma unroll
        for (int i = 0; i < 16; ++i) { s0[i] = fast_exp2(s0[i]); s1[i] = fast_exp2(s1[i]); }
        u32x4 w;
        w.x = pk2(s0[0], s0[1]); w.y = pk2(s0[2], s0[3]); w.z = pk2(s0[4], s0[5]); w.w = pk2(s0[6], s0[7]); pa[0][0] = __builtin_bit_cast(bf16x8, w);
        w.x = pk2(s0[8], s0[9]); w.y = pk2(s0[10], s0[11]); w.z = pk2(s0[12], s0[13]); w.w = pk2(s0[14], s0[15]); pa[0][1] = __builtin_bit_cast(bf16x8, w);
        w.x = pk2(s1[0], s1[1]); w.y = pk2(s1[2], s1[3]); w.z = pk2(s1[4], s1[5]); w.w = pk2(s1[6], s1[7]); pa[1][0] = __builtin_bit_cast(bf16x8, w);
        w.x = pk2(s1[8], s1[9]); w.y = pk2(s1[10], s1[11]); w.z = pk2(s1[12], s1[13]); w.w = pk2(s1[14], s1[15]); pa[1][1] = __builtin_bit_cast(bf16x8, w);
    };
    auto do_pv = [&](unsigned va) {
#pragma unroll
        for (int k4 = 0; k4 < 4; ++k4) Lacc = MFMA32(ones8, pa[k4 >> 1][k4 & 1], Lacc);
#pragma unroll
        for (int d = 0; d < NDV; ++d) {
            LGKM0(); SBAR();
#pragma unroll
            for (int k4 = 0; k4 < 4; ++k4) {
                const bf16x8 vf = __builtin_shufflevector(vlo[d & 1][k4], vhi[d & 1][k4], 0, 1, 2, 3, 4, 5, 6, 7);
                O[d] = MFMA32(vf, pa[k4 >> 1][k4 & 1], O[d]);
            }
            SBAR();
            if (d + 1 < NDV) V_ISSUE(va, (d + 1) & 1, d + 1);
        }
    };
    for (int j = 0; j < ntiles; ++j) {
        if (DMA) {
            wait_vm(n_w * max(min(DIST - 1 - WAHEAD, ntiles - 1 - j - WAHEAD), 0));
            __builtin_amdgcn_s_barrier();
            SBAR();
            if (j + DIST < ntiles) issue(j + DIST);
        } else if (j + 1 < ntiles) gload(j + 1);
        bool active = true;
        if (MODE == 1) { const int rk = na_rs0 + j; active = (rk >= na_rsq) && (rk < na_rsq + 8); }
        if (MODE == 2) { const int lk0 = c_l0 - 64 + 64 * j; active = ((wq < 2) ? (j <= 2) : (j >= 1)) && (lk0 + 63 >= 0) && (lk0 < c_L); }
        if (active) {
            if (!rot || j == 0) do_qk(j, !rot);
            if (rot) V_ISSUE(vaddr_of(j), 0, 0);
            do_soft(j);
            do_pv(vaddr_of(j));
            if (rot && j + 1 < ntiles) do_qk(j + 1, false);
        }
        if (!DMA) { if (j + 1 < ntiles) lstore((j + 1) & 1); __syncthreads(); }
    }
#undef K_ISSUE
#undef V_ISSUE
    const float lt = Lacc[0];
    const float inv = 1.f / lt;
    __syncthreads();
    if (MODE == 0) {
        LAS float* X = (LAS float*)lds;
        if (hf == 1) {
#pragma unroll
            for (int d = 0; d < NDV; ++d)
#pragma unroll
                for (int g4 = 0; g4 < 4; ++g4) {
                    f32x4 v = {O[d][4 * g4] * inv, O[d][4 * g4 + 1] * inv, O[d][4 * g4 + 2] * inv, O[d][4 * g4 + 3] * inv};
                    *(LAS f32x4*)(X + (32 * wq + r) * 132 + 32 * d + 8 * g4 + 4 * h) = v;
                }
        }
        __syncthreads();
        if (hf == 0) {
            float ss = 0.f;
            const float lam = cx.lamp[cx.layer], oml = cx.lamp[2 + cx.layer];
#pragma unroll
            for (int d = 0; d < NDV; ++d)
#pragma unroll
                for (int g4 = 0; g4 < 4; ++g4) {
                    const f32x4 o2 = *(LAS const f32x4*)(X + (32 * wq + r) * 132 + 32 * d + 8 * g4 + 4 * h);
#pragma unroll
                    for (int e = 0; e < 4; ++e) { const float o = O[d][4 * g4 + e] * inv - lam * o2[e]; O[d][4 * g4 + e] = o; ss += o * o; }
                }
            ss += __shfl_xor(ss, 32);
            const float rstd = rsqrtf(ss * (1.f / 128.f) + EPS) * oml;
#pragma unroll
            for (int d = 0; d < NDV; ++d)
#pragma unroll
                for (int g4 = 0; g4 < 4; ++g4) {
                    const int dv = 32 * d + 8 * g4 + 4 * h;
                    const f32x4 gn = *(const f32x4*)(cx.subln + dv);
                    const u32x2 sz = *(const u32x2*)(P + (size_t)qtok * NIN + COL_Z + head * 128 + dv);
                    u32x2 o;
                    o.x = pk2(O[d][4 * g4] * rstd * gn[0] * bflo(sz.x), O[d][4 * g4 + 1] * rstd * gn[1] * bfhi(sz.x));
                    o.y = pk2(O[d][4 * g4 + 2] * rstd * gn[2] * bflo(sz.y), O[d][4 * g4 + 3] * rstd * gn[3] * bfhi(sz.y));
                    *(u32x2*)(cx.T + (size_t)qtok * 512 + head * 128 + dv) = o;
                }
        }
        __syncthreads();
    } else {
        constexpr int XS = DV + 4, PPRO = DV / 8;
        LAS float* Xw = (LAS float*)lds + wave * (32 * XS);
#pragma unroll
        for (int d = 0; d < NDV; ++d)
#pragma unroll
            for (int g4 = 0; g4 < 4; ++g4) {
                const f32x4 v = {O[d][4 * g4] * inv, O[d][4 * g4 + 1] * inv, O[d][4 * g4 + 2] * inv, O[d][4 * g4 + 3] * inv};
                *(LAS f32x4*)(Xw + r * XS + 32 * d + 8 * g4 + 4 * h) = v;
            }
        if (MODE == 2 && h == 0) cx.LSE[(size_t)qtok * 12 + head] = mhat + __log2f(lt);
#pragma unroll
        for (int it = 0; it < (32 * PPRO) / 64; ++it) {
            const int piece = it * 64 + lane, row = piece / PPRO, c8 = piece % PPRO;
            const f32x4 a = *(LAS const f32x4*)(Xw + row * XS + c8 * 8), b = *(LAS const f32x4*)(Xw + row * XS + c8 * 8 + 4);
            if (MODE == 1) {
                const int tok = tok0 + 32 * wq + row;
                const u32x4 sz = *(const u32x4*)(P + (size_t)tok * NIN + COL_Z + 512 + head * 64 + c8 * 8);
                u32x4 o;
                o.x = pk2(a[0] * bflo(sz.x), a[1] * bfhi(sz.x)); o.y = pk2(a[2] * bflo(sz.y), a[3] * bfhi(sz.y));
                o.z = pk2(b[0] * bflo(sz.z), b[1] * bfhi(sz.z)); o.w = pk2(b[2] * bflo(sz.w), b[3] * bfhi(sz.w));
                *(u32x4*)(cx.T + (size_t)TCMAX * 512 + (size_t)tok * 512 + head * 64 + c8 * 8) = o;
            } else {
                const int tok = seqbase + ((c_l0 + 32 * wq + row) << c_dlog) + c_rho;
                *(u32x4*)(cx.OC + (size_t)tok * 1536 + head * 128 + c8 * 8) = pack8(a, b);
            }
        }
        __syncthreads();
    }
}

__device__ __forceinline__ void phase_attn(LAS unsigned char* lds, const AttnCtx& cx) {
    const int G = gridDim.x, nb = cx.n >> 7;
    const int c = (G % 8 == 0) ? (int)(blockIdx.x & 7) * (G >> 3) + (int)(blockIdx.x >> 3) : (int)blockIdx.x;
    const int npb = (cx.row0 < NPROMPT) ? (NPROMPT - cx.row0) >> 7 : 0;
    for (int rep = 0; rep < (DUP_PH == 20 ? 2 : 1); ++rep)
    for (int it = c; it < nb * 4; it += G) {
        int tb, head;
        if (it < npb * 4) { const int sq = it >> 7, rem = it & 127; head = rem >> 5; tb = sq * 32 + (rem & 31); }
        else { const int i2 = it - npb * 4, sq = i2 >> 6, rem = i2 & 63; head = rem >> 4; tb = npb + sq * 16 + (rem & 15); }
        attn_item<64, 128, 0>(lds, tb * 4 + head, cx);
    }
    for (int rep = 0; rep < (DUP_PH == 21 ? 2 : 1); ++rep)
    for (int it = c; it < nb * 6; it += G) attn_item<128, 128, 2>(lds, it, cx);
    for (int rep = 0; rep < (DUP_PH == 22 ? 2 : 1); ++rep)
    for (int it = c; it < nb * 4; it += G) attn_item<64, 64, 1>(lds, it, cx);
}

__device__ __forceinline__ void phase_cmix(const bf16_t* __restrict__ P, const bf16_t* __restrict__ OC, const float* __restrict__ LSE, bf16_t* T2, int n) {
#pragma unroll 4
    for (int idx = blockIdx.x * NTHR + otid(); idx < n * 64; idx += gridDim.x * NTHR) {
        const int tok = idx >> 6, c8 = idx & 63, hh = c8 >> 4, dv = (c8 & 15) * 8;
        const float l0 = LSE[(size_t)tok * 12 + hh], l1 = LSE[(size_t)tok * 12 + 4 + hh], l2 = LSE[(size_t)tok * 12 + 8 + hh];
        const float mx = fmaxf(l0, fmaxf(l1, l2));
        float w0 = fast_exp2(l0 - mx), w1 = fast_exp2(l1 - mx), w2 = fast_exp2(l2 - mx);
        const float iw = 1.f / (w0 + w1 + w2); w0 *= iw; w1 *= iw; w2 *= iw;
        const u32x4 a = *(const u32x4*)(OC + (size_t)tok * 1536 + hh * 128 + dv), b = *(const u32x4*)(OC + (size_t)tok * 1536 + (4 + hh) * 128 + dv),
                    c = *(const u32x4*)(OC + (size_t)tok * 1536 + (8 + hh) * 128 + dv), z = *(const u32x4*)(P + (size_t)tok * NIN + COL_Z + 1024 + hh * 128 + dv);
        u32x4 o;
        o.x = pk2((w0 * bflo(a.x) + w1 * bflo(b.x) + w2 * bflo(c.x)) * bflo(z.x), (w0 * bfhi(a.x) + w1 * bfhi(b.x) + w2 * bfhi(c.x)) * bfhi(z.x));
        o.y = pk2((w0 * bflo(a.y) + w1 * bflo(b.y) + w2 * bflo(c.y)) * bflo(z.y), (w0 * bfhi(a.y) + w1 * bfhi(b.y) + w2 * bfhi(c.y)) * bfhi(z.y));
        o.z = pk2((w0 * bflo(a.z) + w1 * bflo(b.z) + w2 * bflo(c.z)) * bflo(z.z), (w0 * bfhi(a.z) + w1 * bfhi(b.z) + w2 * bfhi(c.z)) * bfhi(z.z));
        o.w = pk2((w0 * bflo(a.w) + w1 * bflo(b.w) + w2 * bflo(c.w)) * bflo(z.w), (w0 * bfhi(a.w) + w1 * bfhi(b.w) + w2 * bfhi(c.w)) * bfhi(z.w));
        *(u32x4*)(T2 + (size_t)tok * 512 + hh * 128 + dv) = o;
    }
}

#define XB_TMO      128
#define XB_XCNT(j)  (256  + 64 * (j))
#define XB_XSUB(j)  (1280 + 64 * (j))
#define XB_XGEN(j)  (2304 + 64 * (j))
#define XB_TOP      3328
#define XB_TOPGEN   3392
#define XCD_BAR_WORDS 3456
#define XB_SPIN_CAP (1u << 18)

__device__ __forceinline__ unsigned xb_ld(unsigned* p)              { return __hip_atomic_load(p, __ATOMIC_RELAXED, __HIP_MEMORY_SCOPE_AGENT); }
__device__ __forceinline__ unsigned xb_add(unsigned* p, unsigned v) { return __hip_atomic_fetch_add(p, v, __ATOMIC_RELAXED, __HIP_MEMORY_SCOPE_AGENT); }
__device__ __forceinline__ unsigned xb_xcc_id() { return (unsigned)__builtin_amdgcn_s_getreg((3 << 11) | 20) & 0xFu; }
#define XB_SPIN(cond, bar) do { unsigned _sp = 0; while (cond) { __builtin_amdgcn_s_sleep(1); \
    if ((++_sp & 255u) == 0u) { if (xb_ld(&(bar)[XB_TMO])) break; if (_sp > XB_SPIN_CAP) { atomicAdd(&(bar)[XB_TMO], 1u); break; } } } } while (0)

struct XcdBarrier {
    unsigned* bar; unsigned x;
    volatile LAS unsigned* st;
};

__device__ __forceinline__ XcdBarrier xcd_barrier_post(unsigned* bar, volatile LAS unsigned* st) {
    XcdBarrier b; b.bar = bar; b.x = xb_xcc_id(); b.st = st;
    if (threadIdx.x == 0) (void)xb_add(&bar[XB_XCNT(b.x)], 1u);
    return b;
}
__device__ __forceinline__ void xcd_barrier_complete(unsigned* bar, unsigned x, unsigned& nloc, unsigned& nx) {
    const unsigned G = gridDim.x * gridDim.y * gridDim.z;
    unsigned sum, cnt, mine, sp = 0u;
    for (;;) {
        sum = 0u; cnt = 0u; mine = 0u;
#pragma unroll
        for (unsigned j = 0; j < 16; ++j) { const unsigned c = xb_ld(&bar[XB_XCNT(j)]); sum += c; cnt += (c > 0u) ? 1u : 0u; mine = (j == x) ? c : mine; }
        if (sum == G) break;
        __builtin_amdgcn_s_sleep(1);
        if ((++sp & 255u) == 0u) { if (xb_ld(&bar[XB_TMO])) break; if (sp > XB_SPIN_CAP) { atomicAdd(&bar[XB_TMO], 1u); break; } }
    }
    nloc = mine > 0u ? mine : 1u; nx = cnt > 0u ? cnt : 1u;
}

__device__ __forceinline__ void xcd_barrier(const XcdBarrier& b) {
    asm volatile("s_waitcnt vmcnt(0)" ::: "memory");
    __syncthreads();
    if (threadIdx.x == 0) {
        unsigned* bar = b.bar;
        __builtin_amdgcn_s_waitcnt(0);
        unsigned nloc = b.st[0], nx = b.st[1];
        if (nloc == 0u) { xcd_barrier_complete(bar, b.x, nloc, nx); b.st[0] = nloc; b.st[1] = nx; }
        const unsigned old = xb_add(&bar[XB_XSUB(b.x)], 1u);
        const unsigned gen = old / nloc;
        if (old + 1u == (gen + 1u) * nloc) {
            __builtin_amdgcn_fence(__ATOMIC_RELEASE, "agent");
            asm volatile("s_waitcnt vmcnt(0)" ::: "memory");
            const unsigned og = xb_add(&bar[XB_TOP], 1u);
            const unsigned tg = og / nx;
            if (og + 1u == (tg + 1u) * nx) xb_add(&bar[XB_TOPGEN], 1u);
            else XB_SPIN(xb_ld(&bar[XB_TOPGEN]) == tg, bar);
            __builtin_amdgcn_fence(__ATOMIC_ACQUIRE, "agent");
            xb_add(&bar[XB_XGEN(b.x)], 1u);
            asm volatile("s_waitcnt vmcnt(0)" ::: "memory");
        } else {
            XB_SPIN(xb_ld(&bar[XB_XGEN(b.x)]) == gen, bar);
            __builtin_amdgcn_fence(__ATOMIC_ACQUIRE, "agent");
            asm volatile("s_waitcnt vmcnt(0)" ::: "memory");
        }
    }
    __syncthreads();
}

#ifndef ONE_LAUNCH
#define ONE_LAUNCH 1
#endif

__global__ void __launch_bounds__(NTHR, 2) mega(Params p) {
    extern __shared__ __attribute__((aligned(16))) unsigned char lds_raw[];
    LAS unsigned char* lds = (LAS unsigned char*)lds_raw;
    unsigned char* ws = p.ws;
    volatile LAS unsigned* bst = (volatile LAS unsigned*)(lds + LDS_BYTES - 16);
    if (threadIdx.x < 2) bst[threadIdx.x] = 0u;
    __syncthreads();
    XcdBarrier bar; bar.bar = (unsigned*)(ws + WS_BAR); bar.x = 0; bar.st = bst;
    if (p.ph_hi - p.ph_lo > 1) bar = xcd_barrier_post((unsigned*)(ws + WS_BAR), bst);
    bf16_t* P = (bf16_t*)(ws + WS_P); bf16_t* T = (bf16_t*)(ws + WS_T); bf16_t* H = T; bf16_t* OC = (bf16_t*)(ws + WS_OC); float* LSE = (float*)(ws + WS_LSE);
    for (int ph = p.ph_lo; ph < p.ph_hi; ++ph) {
        if (ph > p.ph_lo) { if (ph == 1) cg::this_grid().sync(); else xcd_barrier(bar); }
        if (ph == 0) { phase_pre(p, lds); phase_prew(p, lds, 0); continue; }
        if (ph == 1) { phase_h(p, 0, 0, H); continue; }
        if (ph == 17) { phase_prew(p, lds, 1); phase_h(p, 0, 1, H); continue; }
        const int l = (ph > 17) ? 1 : 0, q = ph - (l ? 18 : 2), c = q / 5, k = q - c * 5;
        const int row0 = chunk_row0(c), n = chunk_rows(c);
        const float* mod_l = (const float*)(ws + WS_MOD) + (size_t)l * NSEQ * 3072;
        if (k == 0) {
            pg8::Gemm g{H, (const bf16_t*)(ws + WS_WIN), n, NIN, DM, DM};
            pg8::StaticOrder So; So.init(n, NIN, (int)gridDim.x, (int)blockIdx.x);
            EpiIn E{P, (const float*)(ws + WS_COSA), (const float*)(ws + WS_SINA), (const float*)(ws + WS_COSC), (const float*)(ws + WS_SINC),
                    (const float*)(ws + WS_GAIN) + l * 6 * 128, row0, (LAS float*)(lds + XCH_OFF)};
            pg8::gemm_phase<EpiIn, pg8::StaticOrder, true, true>(lds, g, So, E);
        } else if (k == 1) {
            const float* L = (const float*)(ws + WS_LAM);
            AttnCtx cx{P, T, OC, LSE, p.in[14] + l * 128, p.in[17] + (size_t)l * 8 * 465, L, l, row0, n};
            phase_attn(lds, cx);
        } else if (k == 2) {
            phase_cmix(P, OC, LSE, T + (size_t)2 * TCMAX * 512, n);
        } else if (k == 3) {
            pg8::Gemm g{T, (const bf16_t*)(ws + WS_WBR), 3 * TCMAX, 3072, 512, 512};
            BrOrder So{(int)gridDim.x, (int)blockIdx.x, (n >> 8) * 4};
            EpiBr E{P};
            pg8::gemm_phase<EpiBr, BrOrder, true, true>(lds, g, So, E);
        } else {
            pg8::Gemm g{P, (const bf16_t*)(ws + WS_WOUT), n, DM, DM, NIN};
            pg8::StaticOrder So; So.init(n, DM, (int)gridDim.x, (int)blockIdx.x);
            EpiOut E{p.in[0], p.in[1], p.out, mod_l, row0, l};
            pg8::gemm_phase<EpiOut, pg8::StaticOrder, true, true>(lds, g, So, E);
            if (c < 2) phase_h(p, c + 1, l, H);
        }
    }
}

extern "C" void kernel_launch(void* const* d_in, const int* in_sizes, int n_in, void* d_out, int out_size, void* d_ws, size_t ws_size, hipStream_t stream) {
    static int grid = 0;
    if (grid == 0) {
        if (n_in != 22 || ws_size < WS_END) { fprintf(stderr, "kernel_launch: unexpected n_in %d / ws_size %zu (need %zu)\n", n_in, ws_size, (size_t)WS_END); grid = -1; return; }
        int dev = 0, cus = 0, per_cu = 0;
        (void)hipGetDevice(&dev); (void)hipDeviceGetAttribute(&cus, hipDeviceAttributeMultiprocessorCount, dev);
        if (hipFuncSetAttribute((const void*)mega, hipFuncAttributeMaxDynamicSharedMemorySize, LDS_BYTES) != hipSuccess) { fprintf(stderr, "kernel_launch: hipFuncSetAttribute failed\n"); grid = -1; return; }
        (void)hipOccupancyMaxActiveBlocksPerMultiprocessor(&per_cu, (const void*)mega, NTHR, LDS_BYTES);
        if (per_cu < 1) { fprintf(stderr, "kernel_launch: occupancy query says %d blocks per CU\n", per_cu); per_cu = 1; }
        (void)hipGetLastError();
        grid = cus;
    }
    if (grid < 0) return;
    Params p{};
    for (int i = 0; i < 22; ++i) p.in[i] = (const float*)d_in[i];
    p.out = (float*)d_out; p.ws = (unsigned char*)d_ws;
#if ONE_LAUNCH
    if (hipMemsetAsync((char*)d_ws + WS_BAR, 0, 16384, stream) != hipSuccess) { fprintf(stderr, "kernel_launch: memset failed\n"); return; }
    p.ph_lo = 0; p.ph_hi = NPHASE;
    void* args[] = {&p};
    hipError_t e = hipLaunchCooperativeKernel((const void*)mega, dim3(grid), dim3(NTHR), args, LDS_BYTES, stream);
    if (e != hipSuccess) fprintf(stderr, "cooperative launch failed: %s (grid %d)\n", hipGetErrorString(e), grid);
#else
    for (int ph = 0; ph < NPHASE; ++ph) {
        p.ph_lo = ph; p.ph_hi = ph + 1;
        hipLaunchKernelGGL(mega, dim3(grid), dim3(NTHR), LDS_BYTES, stream, p);
    }
#endif
}
```

```cpp
#include <hip/hip_runtime.h>
#include <hip/hip_cooperative_groups.h>
#include <cstdio>
#include <cstdint>
namespace cg = cooperative_groups;
__device__ __forceinline__ int otid() { int t = threadIdx.x; asm volatile("" : "+v"(t)); return t; }
namespace pg8 {
#define PG8_LAS __attribute__((address_space(3)))
typedef unsigned short bf16_t;
typedef short bf16x8 __attribute__((ext_vector_type(8)));
typedef float f32x4 __attribute__((ext_vector_type(4)));
typedef unsigned u32x4 __attribute__((ext_vector_type(4)));
constexpr int BM = 256, BK = 64, HALF = 128, HTB = HALF * BK * 2  , STAGE_BYTES = 8 * HTB, NXCD = 8, WGM = 4;

__host__ __device__ __forceinline__ int lds_byte(int r, int c) { const int st = (r >> 4) * 2 + (c >> 5), rr = r & 15, cc = c & 31, ob = rr * 64 + cc * 2; return st * 1024 + (ob ^ (((ob >> 9) & 1) << 5)); }
__host__ __device__ __forceinline__ void stage_rc(int b, int& R, int& C) { const int st = b / 1024, sb = b % 1024, swz = sb ^ (((sb >> 9) & 1) << 5); R = (st >> 1) * 16 + swz / 64; C = (st & 1) * 32 + (swz % 64) / 2; }
__host__ __device__ __forceinline__ int perm32(int rho) { const int n = rho >> 4, i = rho & 15; return 8 * (i >> 2) + 4 * n + (i & 3); }

struct Unit { int pm, pn; };
struct Gemm { const bf16_t* A; const bf16_t* Bt; int M, N, K, lda; };

struct StaticOrder {
    int nM, nN, nwg, G, c;
    __host__ __device__ void init(int M, int N, int G_, int c_) { nM = M / BM; nN = N / BM; nwg = nM * nN; G = G_; c = c_; }
    __host__ __device__ bool next(int i, Unit& u) const {
        const long L = (long)i * G + c; if (L >= nwg) return false;
        int wgid = (int)L; { const int q = nwg / NXCD, r = nwg % NXCD, xcd = wgid % NXCD, off = wgid / NXCD; wgid = (xcd < r ? xcd * (q + 1) : r * (q + 1) + (xcd - r) * q) + off; }
        const int nig = WGM * nN, gid = wgid / nig, fm = gid * WGM, gsz = (nM - fm) < WGM ? (nM - fm) : WGM;
        u.pm = fm + ((wgid % nig) % gsz); u.pn = (wgid % nig) / gsz; return true;
    }
    __device__ __forceinline__ void a_ready(const Unit&) const {}
    __device__ __forceinline__ void done(const Unit&) const {}
};

__device__ __forceinline__ unsigned cvt_pk_bf16(float lo, float hi) { unsigned r; asm volatile("v_cvt_pk_bf16_f32 %0, %1, %2" : "=v"(r) : "v"(lo), "v"(hi)); return r; }

template <class Epi, class Sched, bool ALIGN_EPI = false, bool SP2 = false>
__device__ __forceinline__ void gemm_phase(PG8_LAS unsigned char* lds, const Gemm g, const Sched& S, const Epi& E) {
    const int tid = otid(), wid = __builtin_amdgcn_readfirstlane(tid >> 6), lane = tid & 63, wr = wid >> 2, wc = wid & 3, fr = lane & 15, fq = lane >> 4;
    const int K = g.K, nt = K / BK;
    unsigned voffA[2], voffB[2];
#pragma unroll
    for (int i = 0; i < 2; ++i) { int R, C; stage_rc(tid * 16 + i * 8192, R, C); const int Rb = Epi::PERM ? ((R & ~31) + perm32(R & 31)) : R;
        voffA[i] = (unsigned)(R * g.lda + C) * 2u; voffB[i] = (unsigned)(Rb * K + C) * 2u; }
    const size_t kstep = (size_t)(BK * 2);
    const size_t hstep = (size_t)HALF * K * 2;
    const size_t tstep = 2 * hstep;
    const size_t hstepA = (size_t)HALF * g.lda * 2, tstepA = 2 * hstepA;
    const unsigned ldsw = (unsigned)wid * 1024u;
    const int aoff = lds_byte(wr * 64 + fr, fq * 8), boff = lds_byte(wc * 32 + fr, fq * 8);
#define PG8_SA(b, h) (((b) * 2 + (h)) * HTB)
#define PG8_SB(b, h) ((4 + (b) * 2 + (h)) * HTB)
#define PG8_STAGE(bufoff, gbase, voff) do { _Pragma("unroll") for (int _i = 0; _i < 2; ++_i) \
        __builtin_amdgcn_global_load_lds((const unsigned*)((const char*)(gbase) + (voff)[_i]), (PG8_LAS unsigned*)(lds + (bufoff) + ldsw + _i * 8192), 16, 0, 0); } while (0)
#define PG8_LDA(dst, b, h) do { _Pragma("unroll") for (int m = 0; m < 4; ++m) _Pragma("unroll") for (int k = 0; k < 2; ++k) dst[m][k] = *(const PG8_LAS bf16x8*)(lds + PG8_SA(b, h) + aoff + m * 2048 + k * 1024); } while (0)
#define PG8_LDB(dst, b, h) do { _Pragma("unroll") for (int n = 0; n < 2; ++n) _Pragma("unroll") for (int k = 0; k < 2; ++k) dst[n][k] = *(const PG8_LAS bf16x8*)(lds + PG8_SB(b, h) + boff + n * 2048 + k * 1024); } while (0)
#define PG8_MMA(ai, bj, At, Bt) do { __builtin_amdgcn_s_setprio(1); _Pragma("unroll") for (int m = 0; m < 4; ++m) _Pragma("unroll") for (int n = 0; n < 2; ++n) _Pragma("unroll") for (int k = 0; k < 2; ++k) \
        acc[ai][bj][m][n] = __builtin_amdgcn_mfma_f32_16x16x32_bf16(Bt[n][k], At[m][k], acc[ai][bj][m][n], 0, 0, 0); __builtin_amdgcn_s_setprio(0); } while (0)
#define PG8_WAIT_V(n) asm volatile("s_waitcnt vmcnt(" #n ")" ::: "memory")
#define PG8_WAIT_L(n) asm volatile("s_waitcnt lgkmcnt(" #n ")" ::: "memory")
#define PG8_BAR __builtin_amdgcn_s_barrier()
#define PG8_SCHED __builtin_amdgcn_sched_barrier(0)
    Unit cur, nxt; int ui = 0;
    if (!S.next(0, cur)) return;
    f32x4 acc[2][2][4][2];
#pragma unroll
    for (int a = 0; a < 2; ++a)
#pragma unroll
        for (int b = 0; b < 2; ++b)
#pragma unroll
            for (int m = 0; m < 4; ++m)
#pragma unroll
                for (int n = 0; n < 2; ++n) acc[a][b][m][n] = (f32x4){0.f, 0.f, 0.f, 0.f};
    bf16x8 At[4][2], B0[2][2], B1[2][2];
    const char* cA = (const char*)g.A + (size_t)cur.pm * tstepA; const char* cB = (const char*)g.Bt + (size_t)cur.pn * tstep;
    S.a_ready(cur);
    if constexpr (SP2) {
        PG8_STAGE(PG8_SB(0, 0), cB, voffB); PG8_STAGE(PG8_SB(0, 1), cB + hstep, voffB); PG8_STAGE(PG8_SA(0, 0), cA, voffA); PG8_STAGE(PG8_SA(0, 1), cA + hstepA, voffA);
        if (wr == 1) PG8_BAR;
        PG8_WAIT_V(2); PG8_BAR;
        PG8_STAGE(PG8_SB(1, 0), cB + kstep, voffB); PG8_STAGE(PG8_SA(1, 0), cA + kstep, voffA); PG8_STAGE(PG8_SB(1, 1), cB + hstep + kstep, voffB);
        PG8_WAIT_V(6); PG8_BAR;
    } else {
        PG8_STAGE(PG8_SB(0, 0), cB, voffB); PG8_STAGE(PG8_SA(0, 0), cA, voffA); PG8_STAGE(PG8_SB(0, 1), cB + hstep, voffB); PG8_STAGE(PG8_SA(0, 1), cA + hstepA, voffA);
        if (wr == 1) PG8_BAR;
        PG8_WAIT_V(4); PG8_BAR;
        PG8_STAGE(PG8_SB(1, 0), cB + kstep, voffB); PG8_STAGE(PG8_SA(1, 0), cA + kstep, voffA); PG8_STAGE(PG8_SB(1, 1), cB + hstep + kstep, voffB);
        PG8_WAIT_V(6); PG8_BAR;
    }
    for (;;) {
        const bool has_next = S.next(ui + 1, nxt);
        const char* nA = has_next ? (const char*)g.A + (size_t)nxt.pm * tstepA : cA; const char* nB = has_next ? (const char*)g.Bt + (size_t)nxt.pn * tstep : cB;
        for (int t = 0; t < nt; t += 2) {
            const bool last = (t == nt - 2);
            const char* a1 = cA + (size_t)(t + 1) * kstep;
            const char* a2 = last ? nA : cA + (size_t)(t + 2) * kstep; const char* b2 = last ? nB : cB + (size_t)(t + 2) * kstep;
            const char* a3 = a2 + kstep; const char* b3 = b2 + kstep;
            if (last && has_next) S.a_ready(nxt);
            if constexpr (SP2) {
            PG8_LDB(B0, 0, 0); PG8_LDB(B1, 0, 1); PG8_SCHED; PG8_LDA(At, 0, 0); PG8_STAGE(PG8_SA(1, 1), a1 + hstepA, voffA);
            PG8_WAIT_V(8); PG8_WAIT_L(0); PG8_BAR; PG8_MMA(0, 0, At, B0); PG8_MMA(0, 1, At, B1); PG8_BAR; PG8_SCHED;
            PG8_LDA(At, 0, 1); PG8_STAGE(PG8_SB(0, 0), b2, voffB); PG8_STAGE(PG8_SB(0, 1), b2 + hstep, voffB); PG8_STAGE(PG8_SA(0, 0), a2, voffA);
            PG8_WAIT_V(8); PG8_WAIT_L(0); PG8_BAR; PG8_MMA(1, 0, At, B0); PG8_MMA(1, 1, At, B1); PG8_BAR; PG8_SCHED;
            PG8_LDB(B0, 1, 0); PG8_LDB(B1, 1, 1); PG8_SCHED; PG8_LDA(At, 1, 0); PG8_STAGE(PG8_SA(0, 1), a2 + hstepA, voffA);
            PG8_WAIT_V(8); PG8_WAIT_L(0); PG8_BAR; PG8_MMA(0, 0, At, B0); PG8_MMA(0, 1, At, B1); PG8_BAR; PG8_SCHED;
            PG8_LDA(At, 1, 1); PG8_STAGE(PG8_SB(1, 0), b3, voffB); PG8_STAGE(PG8_SB(1, 1), b3 + hstep, voffB); PG8_STAGE(PG8_SA(1, 0), a3, voffA);
            PG8_WAIT_V(8); PG8_WAIT_L(0); PG8_BAR; PG8_MMA(1, 0, At, B0); PG8_MMA(1, 1, At, B1); PG8_BAR; PG8_SCHED;
            } else {
            PG8_LDB(B0, 0, 0); PG8_SCHED; PG8_LDA(At, 0, 0); PG8_STAGE(PG8_SA(1, 1), a1 + hstepA, voffA);
            PG8_WAIT_L(8); PG8_BAR; PG8_WAIT_L(0); PG8_MMA(0, 0, At, B0); PG8_BAR; PG8_SCHED;
            PG8_LDB(B1, 0, 1); PG8_STAGE(PG8_SB(0, 0), b2, voffB);
            PG8_BAR; PG8_WAIT_L(0); PG8_MMA(0, 1, At, B1); PG8_BAR;
            PG8_LDA(At, 0, 1); PG8_STAGE(PG8_SA(0, 0), a2, voffA);
            PG8_BAR; PG8_WAIT_L(0); PG8_MMA(1, 0, At, B0); PG8_BAR; PG8_SCHED;
            PG8_STAGE(PG8_SB(0, 1), b2 + hstep, voffB);
            PG8_WAIT_V(6); PG8_BAR; PG8_MMA(1, 1, At, B1); PG8_BAR;
            PG8_LDB(B0, 1, 0); PG8_SCHED; PG8_LDA(At, 1, 0); PG8_STAGE(PG8_SA(0, 1), a2 + hstepA, voffA);
            PG8_WAIT_L(8); PG8_BAR; PG8_WAIT_L(0); PG8_MMA(0, 0, At, B0); PG8_BAR; PG8_SCHED;
            PG8_LDB(B1, 1, 1); PG8_STAGE(PG8_SB(1, 0), b3, voffB);
            PG8_BAR; PG8_WAIT_L(0); PG8_MMA(0, 1, At, B1); PG8_BAR;
            PG8_LDA(At, 1, 1); PG8_STAGE(PG8_SA(1, 0), a3, voffA);
            PG8_BAR; PG8_WAIT_L(0); PG8_MMA(1, 0, At, B0); PG8_BAR; PG8_SCHED;
            PG8_STAGE(PG8_SB(1, 1), b3 + hstep, voffB);
            PG8_WAIT_V(6); PG8_BAR; PG8_MMA(1, 1, At, B1); PG8_BAR;
            }
        }
        if constexpr (ALIGN_EPI) { if (wr == 0) PG8_BAR; }
        if constexpr (!Epi::AFTER_DRAIN) { E(acc, cur, wr, wc, fr, fq); S.done(cur); }
        if (!has_next) break;
        if (!E.keep(cur)) {
#pragma unroll
        for (int a = 0; a < 2; ++a)
#pragma unroll
            for (int b = 0; b < 2; ++b)
#pragma unroll
                for (int m = 0; m < 4; ++m)
#pragma unroll
                    for (int n = 0; n < 2; ++n) acc[a][b][m][n] = (f32x4){0.f, 0.f, 0.f, 0.f};
        }
        cur = nxt; cA = nA; cB = nB; ++ui;
        if constexpr (ALIGN_EPI) { if (wr == 1) PG8_BAR; }
    }
    PG8_WAIT_V(0);
    if constexpr (!ALIGN_EPI) { if (wr == 0) PG8_BAR; }
    PG8_BAR;
    if constexpr (Epi::AFTER_DRAIN) { E.fused(acc, cur, wr, wc, fr, fq, lds, wid, lane); S.done(cur); }
#undef PG8_SA
#undef PG8_SB
#undef PG8_STAGE
#undef PG8_LDA
#undef PG8_LDB
#undef PG8_MMA
#undef PG8_WAIT_V
#undef PG8_WAIT_L
#undef PG8_BAR
#undef PG8_SCHED
}
}

#define LAS __attribute__((address_space(3)))
#ifndef PH_MASK
#define PH_MASK 0xFFF
#endif
#ifndef DUP_PH
#define DUP_PH -1
#endif
typedef unsigned short bf16_t;
typedef short bf16x8 __attribute__((ext_vector_type(8)));
typedef short s16x4 __attribute__((ext_vector_type(4)));
typedef short v4i16_t __attribute__((ext_vector_type(4)));
typedef float f32x2 __attribute__((ext_vector_type(2)));
typedef float f32x4 __attribute__((ext_vector_type(4)));
typedef float f32x16 __attribute__((ext_vector_type(16)));
typedef unsigned u32x2 __attribute__((ext_vector_type(2)));
typedef unsigned u32x4 __attribute__((ext_vector_type(4)));
typedef __bf16 bf16x2_t __attribute__((ext_vector_type(2)));

constexpr int DM = 1024, NIN = 12288, TCMAX = 32768, NCHUNK = 3, NSEQ = 36, NTHR = 512, NPROMPT = 16384;
__device__ __forceinline__ int chunk_row0(int c) { return c * 32768; }
__device__ __forceinline__ int chunk_rows(int c) { return c == 2 ? 16384 : 32768; }
__device__ __forceinline__ int seq_len_of(int g) { return g < NPROMPT ? 4096 : 2048; }
__device__ __forceinline__ int seq_of(int g) { return g < NPROMPT ? (g >> 12) : 4 + ((g - NPROMPT) >> 11); }
constexpr int COL_A_Q = 0, COL_A_K = 512, COL_A_V = 1024, COL_B_Q = 1536, COL_B_K = 2048, COL_B_V = 2560, COL_C_Q = 3072, COL_C_K = 4608,
              COL_C_V = 6144, COL_Z = 7680, COL_G = 9216;
constexpr float EPS = 1e-6f, LOG2E = 1.4426950408889634f, NEGBIG = -1e30f;

constexpr size_t WS_WIN = 0;
constexpr size_t WS_WBR = WS_WIN + (size_t)NIN * DM * 2;
constexpr size_t WS_WOUT = WS_WBR + 3072ull * 512 * 2;
constexpr size_t WS_MOD = WS_WOUT + (size_t)DM * DM * 2;
constexpr size_t WS_COSA = WS_MOD + 2ull * NSEQ * 3072 * 4;
constexpr size_t WS_SINA = WS_COSA + 4096ull * 32 * 4;
constexpr size_t WS_COSC = WS_SINA + 4096ull * 32 * 4;
constexpr size_t WS_SINC = WS_COSC + 4096ull * 64 * 4;
constexpr size_t WS_LAM = WS_SINC + 4096ull * 64 * 4;
constexpr size_t WS_GAIN = WS_LAM + 256;
constexpr size_t WS_BAR = WS_GAIN + 2 * 6 * 128 * 4;
constexpr size_t WS_P = WS_BAR + 16384;
constexpr size_t WS_T = WS_P + (size_t)TCMAX * NIN * 2;
constexpr size_t WS_OC = WS_T + 3ull * TCMAX * 512 * 2;
constexpr size_t WS_LSE = WS_OC + (size_t)TCMAX * 1536 * 2;
constexpr size_t WS_END = WS_LSE + (size_t)TCMAX * 12 * 4;

constexpr int LDS_BYTES = 159744;
constexpr int XCH_OFF = 131072;
constexpr int NPHASE = 2 + 15 + 1 + 15;

struct Params { const float* in[22]; float* out; unsigned char* ws; int ph_lo, ph_hi; };

__device__ __forceinline__ unsigned pk2(float lo, float hi) { f32x2 v = {lo, hi}; bf16x2_t b = __builtin_convertvector(v, bf16x2_t); return __builtin_bit_cast(unsigned, b); }
__device__ __forceinline__ float bflo(unsigned u) { return __uint_as_float(u << 16); }
__device__ __forceinline__ float bfhi(unsigned u) { return __uint_as_float(u & 0xffff0000u); }
__device__ __forceinline__ float wave_sum(float v) {
#pragma unroll
    for (int o = 32; o >= 1; o >>= 1) v += __shfl_xor(v, o);
    return v;
}
__device__ __forceinline__ float fast_exp2(float x) { return __builtin_amdgcn_exp2f(x); }
__device__ __forceinline__ float sigmoidf_(float x) { return __builtin_amdgcn_rcpf(1.f + __builtin_amdgcn_exp2f(x * -1.4426950408889634f)); }
__device__ __forceinline__ float siluf_(float x) { return x * sigmoidf_(x); }

__host__ __device__ __forceinline__ int tile_type(int pn) {
    if (pn < 4) return 1; if (pn < 6) return 0; if (pn < 10) return 2; if (pn < 12) return 0; if (pn < 24) return 3; if (pn < 30) return 0; if (pn < 36) return 4; return 5;
}
__device__ __forceinline__ int phys_row(int col) {
    const int pn = col >> 8, lc = col & 255, ty = tile_type(pn);
    if (ty == 1 || ty == 2) { const int wc = (lc >> 6) & 3, bj = (lc >> 5) & 1, rest = lc & 31; return (pn << 8) + 128 * bj + 32 * wc + rest; }
    if (ty == 3) { const int hh = lc >> 7, bj = (lc >> 6) & 1, w0 = (lc >> 5) & 1, rest = lc & 31; return (pn << 8) + 128 * bj + 32 * (2 * hh + w0) + rest; }
    return col;
}

__device__ __forceinline__ void transpose_item(const float* __restrict__ W, int K, int N, bf16_t* Bt, int kt, int nt, bool perm, LAS float* tile) {
    const int t = otid(), k0 = kt * 64, n0 = nt * 64;
#pragma unroll
    for (int i = 0; i < 8; ++i) { const int k = i * 8 + (t >> 6), n = t & 63; tile[k * 65 + n] = W[(size_t)(k0 + k) * N + n0 + n]; }
    __syncthreads();
    const int n = t >> 3, kk = (t & 7) * 8;
    u32x4 w;
    w.x = pk2(tile[(kk + 0) * 65 + n], tile[(kk + 1) * 65 + n]); w.y = pk2(tile[(kk + 2) * 65 + n], tile[(kk + 3) * 65 + n]);
    w.z = pk2(tile[(kk + 4) * 65 + n], tile[(kk + 5) * 65 + n]); w.w = pk2(tile[(kk + 6) * 65 + n], tile[(kk + 7) * 65 + n]);
    const int col = n0 + n, row = perm ? phys_row(col) : col;
    *(u32x4*)(Bt + (size_t)row * K + k0 + kk) = w;
    __syncthreads();
}

__device__ __forceinline__ void mod_item(const Params& p, int item, LAS float* sc) {
    const int l = item / 48, cb = item % 48, t = otid();
    const float* cp = p.in[2]; const float* cs = p.in[3];
    for (int i = t; i < NSEQ * 1024; i += NTHR) { const int s = i >> 10, k = i & 1023; const float c = (s < 4) ? cp[s * 1024 + k] : cs[(s - 4) * 1024 + k]; sc[i] = siluf_(c); }
    __syncthreads();
    const int col = t & 63, ks = t >> 6;
    const float* w = p.in[5] + (size_t)l * 1024 * 3072 + cb * 64 + col;
    float acc[NSEQ];
#pragma unroll
    for (int s = 0; s < NSEQ; ++s) acc[s] = 0.f;
    for (int k = ks * 128; k < ks * 128 + 128; ++k) {
        const float wv = w[(size_t)k * 3072];
#pragma unroll
        for (int s = 0; s < NSEQ; ++s) acc[s] += sc[s * 1024 + k] * wv;
    }
    __syncthreads();
#pragma unroll
    for (int s = 0; s < NSEQ; ++s) sc[(ks * NSEQ + s) * 64 + col] = acc[s];
    __syncthreads();
    float* mod = (float*)(p.ws + WS_MOD) + (size_t)l * NSEQ * 3072;
    const float* b = p.in[6] + (size_t)l * 3072;
    for (int i = t; i < NSEQ * 64; i += NTHR) {
        const int s = i >> 6, c = i & 63; float v = 0.f;
#pragma unroll
        for (int q = 0; q < 8; ++q) v += sc[(q * NSEQ + s) * 64 + c];
        mod[s * 3072 + cb * 64 + c] = v + b[cb * 64 + c];
    }
    __syncthreads();
}

__device__ __forceinline__ void phase_prew(const Params& p, LAS unsigned char* lds, int l) {
    LAS float* scr = (LAS float*)lds;
    const int G = gridDim.x, bid = blockIdx.x;
    constexpr int N_WIN = 16 * 192, N_WBR = 3 * 8 * 16, N_WOUT = 16 * 16, PER_L = N_WIN + N_WBR + N_WOUT;
    for (int item = bid; item < PER_L; item += G) {
        int it = item;
        if (it < N_WIN) { transpose_item(p.in[7] + (size_t)l * DM * NIN, DM, NIN, (bf16_t*)(p.ws + WS_WIN), it & 15, it >> 4, true, scr); }
        else if (it < N_WIN + N_WBR) { it -= N_WIN; const int br = it >> 7, r = it & 127;
            transpose_item(p.in[20] + ((size_t)l * 3 + br) * 512 * 1024, 512, 1024, (bf16_t*)(p.ws + WS_WBR) + (size_t)br * 1024 * 512, r & 7, r >> 3, false, scr); }
        else { it -= N_WIN + N_WBR; transpose_item(p.in[21] + (size_t)l * DM * DM, DM, DM, (bf16_t*)(p.ws + WS_WOUT), it & 15, it >> 4, false, scr); }
    }
}

__device__ __forceinline__ void phase_pre(const Params& p, LAS unsigned char* lds) {
    LAS float* scr = (LAS float*)lds;
    const int G = gridDim.x, bid = blockIdx.x, t = otid();
    for (int item = bid; item < 96; item += G) mod_item(p, item, scr);
    const int gt = bid * NTHR + t, gn = G * NTHR;
    float* cosA = (float*)(p.ws + WS_COSA); float* sinA = (float*)(p.ws + WS_SINA); float* cosC = (float*)(p.ws + WS_COSC); float* sinC = (float*)(p.ws + WS_SINC);
    for (int i = gt; i < 4096 * 96; i += gn) {
        int pos, j; float inv; float* cd; float* sd;
        if (i < 4096 * 32) { pos = i >> 5; j = i & 31; inv = exp2f(-(float)j * (13.287712379549449f / 32.f)); cd = cosA + i; sd = sinA + i; }
        else { const int i2 = i - 4096 * 32; pos = i2 >> 6; j = i2 & 63; inv = exp2f(-(float)j * (13.287712379549449f / 64.f)); cd = cosC + i2; sd = sinC + i2; }
        double x = (double)pos * (double)inv * 0.15915494309189535;
        x -= floor(x);
        const float r = (float)(x * 6.283185307179586);
        *cd = __cosf(r); *sd = __sinf(r);
    }
    if (bid == 1) {
        float* gt = (float*)(p.ws + WS_GAIN);
        for (int i = t; i < 2 * 6 * 128; i += NTHR) {
            const int l = i / 768, w = (i % 768) >> 7, d = i & 127; float v = 0.f;
            if (w == 0) { if (d < 64) v = p.in[8][l * 64 + d]; } else if (w == 1) { if (d < 64) v = p.in[9][l * 64 + d]; }
            else if (w == 2) { if (d < 64) v = p.in[15][l * 64 + d]; } else if (w == 3) { if (d < 64) v = p.in[16][l * 64 + d]; }
            else if (w == 4) v = p.in[18][l * 128 + d]; else v = p.in[19][l * 128 + d];
            gt[i] = v;
        }
    }
    if (bid == 0 && t < 2) {
        const int l = t; float a = 0.f, b = 0.f;
        for (int i = 0; i < 64; ++i) { a += p.in[10][l * 64 + i] * p.in[11][l * 64 + i]; b += p.in[12][l * 64 + i] * p.in[13][l * 64 + i]; }
        const float lam_init = 0.8f - 0.6f * expf(-0.3f * (float)l);
        float* L = (float*)(p.ws + WS_LAM);
        L[l] = expf(a) - expf(b) + lam_init; L[2 + l] = 1.f - lam_init;
    }
}

__device__ __forceinline__ void phase_h(const Params& p, int c, int l, bf16_t* H) {
    const int wave = otid() >> 6, lane = otid() & 63;
    const int row0 = chunk_row0(c), n = chunk_rows(c);
    const float* lng = p.in[4] + l * DM;
    const float* mod_l = (const float*)(p.ws + WS_MOD) + (size_t)l * NSEQ * 3072;
    for (int row = blockIdx.x * 8 + wave; row < n; row += gridDim.x * 8) {
        const int g = row0 + row;
        const float* xr = (l == 0) ? ((g < NPROMPT) ? p.in[0] + (size_t)g * DM : p.in[1] + (size_t)(g - NPROMPT) * DM) : p.out + (size_t)g * DM;
        f32x4 v[4]; float ss = 0.f;
#pragma unroll
        for (int j = 0; j < 4; ++j) { v[j] = *(const f32x4*)(xr + j * 256 + lane * 4); ss += v[j][0] * v[j][0] + v[j][1] * v[j][1] + v[j][2] * v[j][2] + v[j][3] * v[j][3]; }
        ss = wave_sum(ss);
        const float rstd = rsqrtf(ss * (1.f / 1024.f) + EPS);
        const float* md = mod_l + (size_t)seq_of(g) * 3072;
#pragma unroll
        for (int j = 0; j < 4; ++j) {
            const int col = j * 256 + lane * 4;
            const f32x4 gg = *(const f32x4*)(lng + col), sh = *(const f32x4*)(md + col), sc = *(const f32x4*)(md + 1024 + col);
            const f32x4 h = v[j] * rstd * gg * (sc + 1.0f) + sh;
            u32x2 o; o.x = pk2(h[0], h[1]); o.y = pk2(h[2], h[3]);
            *(u32x2*)(H + (size_t)row * DM + col) = o;
        }
    }
}

__device__ __forceinline__ u32x4 pack8(const f32x4& a, const f32x4& b) { u32x4 w; w.x = pk2(a[0], a[1]); w.y = pk2(a[2], a[3]); w.z = pk2(b[0], b[1]); w.w = pk2(b[2], b[3]); return w; }
__device__ __forceinline__ float dot4(const f32x4& a) { return a[0] * a[0] + a[1] * a[1] + a[2] * a[2] + a[3] * a[3]; }

struct EpiIn {
    static constexpr bool PERM = true, AFTER_DRAIN = false;
    bf16_t* P; const float* cosA; const float* sinA; const float* cosC; const float* sinC;
    const float* gtab; int row0; LAS float* xch;
    __device__ __forceinline__ bool keep(const pg8::Unit&) const { return false; }
    template <bool ROPE>
    __device__ __forceinline__ static void piece(f32x4 a, f32x4 b, float rs, const float* glo, const float* ghi, const float* cp, const float* sp, u32x2& pa, u32x2& pb) {
        a = a * rs * *(const f32x4*)glo; b = b * rs * *(const f32x4*)ghi;
        if (ROPE) { const f32x4 c = *(const f32x4*)cp, sn = *(const f32x4*)sp; const f32x4 na = a * c - b * sn, nb = b * c + a * sn; a = na; b = nb; }
        pa.x = pk2(a[0], a[1]); pa.y = pk2(a[2], a[3]); pb.x = pk2(b[0], b[1]); pb.y = pk2(b[2], b[3]);
    }
    template <bool ROPE>
    __device__ __forceinline__ void head64(const f32x4 (&acc)[2][2][4][2], const float* g, float qs, bf16_t* pb, int gq0, int fq) const {
#pragma unroll
        for (int ai = 0; ai < 2; ++ai)
#pragma unroll
            for (int m = 0; m < 4; ++m) {
                float ss = dot4(acc[ai][0][m][0]) + dot4(acc[ai][0][m][1]) + dot4(acc[ai][1][m][0]) + dot4(acc[ai][1][m][1]);
                ss += __shfl_xor(ss, 16); ss += __shfl_xor(ss, 32);
                const float rs = rsqrtf(ss * (1.f / 64.f) + EPS) * qs;
                const int roff = ai * 128 + m * 16;
                const int gq = gq0 + roff; const int pos = gq & (seq_len_of(gq) - 1);
                const float* cp = cosA + pos * 32 + 8 * fq; const float* sp = sinA + pos * 32 + 8 * fq;
                u32x2 pa0, pb0, pa1, pb1;
                piece<ROPE>(acc[ai][0][m][0], acc[ai][1][m][0], rs, g, g + 32, cp, sp, pa0, pb0);
                piece<ROPE>(acc[ai][0][m][1], acc[ai][1][m][1], rs, g + 4, g + 36, cp + 4, sp + 4, pa1, pb1);
                *(u32x4*)(pb + (size_t)roff * NIN) = (u32x4){pa0.x, pa0.y, pa1.x, pa1.y};
                *(u32x4*)(pb + (size_t)roff * NIN + 32) = (u32x4){pb0.x, pb0.y, pb1.x, pb1.y};
            }
    }
    template <int ACT>
    __device__ __forceinline__ void plain(const f32x4 (&acc)[2][2][4][2], bf16_t* pb) const {
#pragma unroll
        for (int ai = 0; ai < 2; ++ai)
#pragma unroll
            for (int m = 0; m < 4; ++m)
#pragma unroll
                for (int bj = 0; bj < 2; ++bj) {
                    f32x4 v0 = acc[ai][bj][m][0], v1 = acc[ai][bj][m][1];
                    if (ACT == 4) {
#pragma unroll
                        for (int e = 0; e < 4; ++e) { v0[e] = siluf_(v0[e]); v1[e] = siluf_(v1[e]); }
                    } else if (ACT == 5) {
#pragma unroll
                        for (int e = 0; e < 4; ++e) { v0[e] = sigmoidf_(v0[e]); v1[e] = sigmoidf_(v1[e]); }
                    }
                    *(u32x4*)(pb + (size_t)(ai * 128 + m * 16) * NIN + bj * 128) = pack8(v0, v1);
                }
    }
    __device__ __forceinline__ void operator()(const f32x4 (&acc)[2][2][4][2], const pg8::Unit& u, int wr, int wc, int fr, int fq) const {
        const int pn = u.pn, ty = tile_type(pn);
        const int rl0 = wr * 64 + fr;
        const size_t rowg0 = (size_t)u.pm * 256 + rl0;
        const int gq0 = row0 + (int)rowg0;
        if (ty == 1 || ty == 2) {
            const bool isq = (ty == 1) ? (pn < 2) : (pn < 8);
            const float* g = gtab + ((ty == 1 ? 0 : 2) + (isq ? 0 : 1)) * 128 + 8 * fq;
            const float qs = isq ? 0.125f * LOG2E : 1.f;
            bf16_t* pb = P + rowg0 * NIN + pn * 256 + 64 * wc + 8 * fq;
            if (ty == 1) head64<true>(acc, g, qs, pb, gq0, fq); else head64<false>(acc, g, qs, pb, gq0, fq);
        } else if (ty == 3) {
            const bool isq = pn < 18;
            const float qs = isq ? 0.08838834764831845f * LOG2E : 1.f;
            const int hh = wc >> 1, w0 = wc & 1;
#pragma unroll
            for (int ai = 0; ai < 2; ++ai)
#pragma unroll
                for (int m = 0; m < 4; ++m) {
                    float ss = dot4(acc[ai][0][m][0]) + dot4(acc[ai][0][m][1]) + dot4(acc[ai][1][m][0]) + dot4(acc[ai][1][m][1]);
                    ss += __shfl_xor(ss, 16); ss += __shfl_xor(ss, 32);
                    if (fq == 0) xch[(ai * 128 + m * 16 + rl0) * 4 + wc] = ss;
                }
            __syncthreads();
            const int dlo = 32 * w0 + 8 * fq;
            const float* g = gtab + (isq ? 4 : 5) * 128 + dlo;
            bf16_t* pb = P + rowg0 * NIN + pn * 256 + 128 * hh + dlo;
#pragma unroll
            for (int ai = 0; ai < 2; ++ai)
#pragma unroll
                for (int m = 0; m < 4; ++m) {
                    const int roff = ai * 128 + m * 16;
                    const f32x2 t2 = *(LAS const f32x2*)(xch + (roff + rl0) * 4 + 2 * hh);
                    const float rs = rsqrtf((t2[0] + t2[1]) * (1.f / 128.f) + EPS) * qs;
                    const int gq = gq0 + roff; const int pos = gq & (seq_len_of(gq) - 1);
                    const float* cp = cosC + pos * 64 + dlo; const float* sp = sinC + pos * 64 + dlo;
                    u32x2 pa0, pb0, pa1, pb1;
                    piece<true>(acc[ai][0][m][0], acc[ai][1][m][0], rs, g, g + 64, cp, sp, pa0, pb0);
                    piece<true>(acc[ai][0][m][1], acc[ai][1][m][1], rs, g + 4, g + 68, cp + 4, sp + 4, pa1, pb1);
                    *(u32x4*)(pb + (size_t)roff * NIN) = (u32x4){pa0.x, pa0.y, pa1.x, pa1.y};
                    *(u32x4*)(pb + (size_t)roff * NIN + 64) = (u32x4){pb0.x, pb0.y, pb1.x, pb1.y};
                }
        } else {
            bf16_t* pb = P + rowg0 * NIN + pn * 256 + 32 * wc + 8 * fq;
            if (ty == 4) plain<4>(acc, pb); else if (ty == 5) plain<5>(acc, pb); else plain<0>(acc, pb);
        }
    }
};

struct BrOrder {
    int G, c, ntile;
    __device__ __forceinline__ bool next(int i, pg8::Unit& u) const {
        const int tk = i / 3, br = i - 3 * tk, tile = c + tk * G; if (tile >= ntile) return false;
        u.pm = (tile >> 2) + br * (TCMAX / 256); u.pn = (tile & 3) + br * 4; return true;
    }
    __device__ __forceinline__ void a_ready(const pg8::Unit&) const {}
    __device__ __forceinline__ void done(const pg8::Unit&) const {}
};

struct EpiBr {
    static constexpr bool PERM = true, AFTER_DRAIN = false;
    bf16_t* P;
    __device__ __forceinline__ bool keep(const pg8::Unit& u) const { return (u.pm >> 7) < 2; }
    __device__ __forceinline__ void operator()(f32x4 (&acc)[2][2][4][2], const pg8::Unit& u, int wr, int wc, int fr, int fq) const {
        const int br = u.pm >> 7, pm = u.pm & 127, pn = u.pn & 3;
        const size_t row0 = (size_t)pm * 256 + wr * 64 + fr; const int col0 = pn * 256 + 32 * wc + 8 * fq;
        const bf16_t* gp = P + row0 * NIN + COL_G + br * 1024 + col0;
        if (br < 2) {
#pragma unroll
            for (int ai = 0; ai < 2; ++ai)
#pragma unroll
                for (int m = 0; m < 4; ++m)
#pragma unroll
                    for (int bj = 0; bj < 2; ++bj) {
                        const bf16_t* q = gp + (size_t)(ai * 128 + m * 16) * NIN + bj * 128;
                        const u32x4 sg = *(const u32x4*)q, sn = *(const u32x4*)(q + 1024);
                        f32x4 f0 = {bflo(sg.x), bfhi(sg.x), bflo(sg.y), bfhi(sg.y)}, f1 = {bflo(sg.z), bfhi(sg.z), bflo(sg.w), bfhi(sg.w)};
                        f0[0] *= __builtin_amdgcn_rcpf(bflo(sn.x)); f0[1] *= __builtin_amdgcn_rcpf(bfhi(sn.x)); f0[2] *= __builtin_amdgcn_rcpf(bflo(sn.y)); f0[3] *= __builtin_amdgcn_rcpf(bfhi(sn.y));
                        f1[0] *= __builtin_amdgcn_rcpf(bflo(sn.z)); f1[1] *= __builtin_amdgcn_rcpf(bfhi(sn.z)); f1[2] *= __builtin_amdgcn_rcpf(bflo(sn.w)); f1[3] *= __builtin_amdgcn_rcpf(bfhi(sn.w));
                        acc[ai][bj][m][0] *= f0; acc[ai][bj][m][1] *= f1;
                    }
        } else {
            bf16_t* op = P + row0 * NIN + col0;
#pragma unroll
            for (int ai = 0; ai < 2; ++ai)
#pragma unroll
                for (int m = 0; m < 4; ++m)
#pragma unroll
                    for (int bj = 0; bj < 2; ++bj) {
                        const size_t o = (size_t)(ai * 128 + m * 16) * NIN + bj * 128;
                        const u32x4 sg = *(const u32x4*)(gp + o);
                        const f32x4 f0 = {bflo(sg.x), bfhi(sg.x), bflo(sg.y), bfhi(sg.y)}, f1 = {bflo(sg.z), bfhi(sg.z), bflo(sg.w), bfhi(sg.w)};
                        *(u32x4*)(op + o) = pack8(acc[ai][bj][m][0] * f0, acc[ai][bj][m][1] * f1);
                    }
        }
    }
};

struct EpiOut {
    static constexpr bool PERM = true, AFTER_DRAIN = false;
    const float* xp; const float* xs; float* out; const float* mod_l; int row0, layer;
    __device__ __forceinline__ bool keep(const pg8::Unit&) const { return false; }
    __device__ __forceinline__ void operator()(const f32x4 (&acc)[2][2][4][2], const pg8::Unit& u, int wr, int wc, int fr, int fq) const {
        const int g0 = row0 + u.pm * 256 + wr * 64 + fr; const int col0 = u.pn * 256 + 32 * wc + 8 * fq;
#pragma unroll
        for (int ai = 0; ai < 2; ++ai)
#pragma unroll
            for (int m = 0; m < 4; ++m) {
                const int g = g0 + ai * 128 + m * 16;
                const float* gt = mod_l + (size_t)seq_of(g) * 3072 + 2048;
                const float* xr = (layer == 0) ? ((g < NPROMPT) ? xp + (size_t)g * DM : xs + (size_t)(g - NPROMPT) * DM) : out + (size_t)g * DM;
                float* orow = out + (size_t)g * DM;
#pragma unroll
                for (int bj = 0; bj < 2; ++bj) {
                    const int col = col0 + bj * 128;
                    const f32x4 g0v = *(const f32x4*)(gt + col), g1v = *(const f32x4*)(gt + col + 4);
                    const f32x4 x0 = *(const f32x4*)(xr + col), x1 = *(const f32x4*)(xr + col + 4);
                    *(f32x4*)(orow + col) = x0 + g0v * acc[ai][bj][m][0];
                    *(f32x4*)(orow + col + 4) = x1 + g1v * acc[ai][bj][m][1];
                }
            }
    }
};

struct AttnCtx { const bf16_t* P; bf16_t* T; bf16_t* OC; float* LSE; const float* subln; const float* rpb; const float* lamp; int layer; int row0, n; };

__device__ __forceinline__ int crow(int i, int h) { return (i & 3) + 8 * (i >> 2) + 4 * h; }
__device__ __forceinline__ s16x4 vtr(LAS const unsigned char* p) { return __builtin_bit_cast(s16x4, __builtin_amdgcn_ds_read_tr16_b64_v4i16((LAS v4i16_t*)p)); }
#define MFMA32(a, b, c) __builtin_amdgcn_mfma_f32_32x32x16_bf16((a), (b), (c), 0, 0, 0)
#define DS_TR16(dst, addr, off) asm volatile("ds_read_b64_tr_b16 %0, %1 offset:%c2" : "=&v"(dst) : "v"(addr), "i"(off) : "memory")
#define DS_RD128(dst, addr, off) asm volatile("ds_read_b128 %0, %1 offset:%c2" : "=&v"(dst) : "v"(addr), "i"(off) : "memory")
#define LGKM0() asm volatile("s_waitcnt lgkmcnt(0)" ::: "memory")
#define SBAR() __builtin_amdgcn_sched_barrier(0)
__device__ __forceinline__ float max3f(float a, float b, float c) { float r; asm("v_max3_f32 %0, %1, %2, %3" : "=v"(r) : "v"(a), "v"(b), "v"(c)); return r; }
__device__ __forceinline__ void wait_vm(int n) {
    switch (n) {
#define WV(k) case k: asm volatile("s_waitcnt vmcnt(" #k ")" ::: "memory"); break;
        WV(1) WV(2) WV(3) WV(4) WV(5) WV(6) WV(7) WV(8) WV(9) WV(10) WV(12) WV(14) WV(15) WV(16) WV(18) WV(20)
#undef WV
        default: asm volatile("s_waitcnt vmcnt(0)" ::: "memory"); break;
    }
}

template <int DQK, int DV, int MODE>
__device__ __forceinline__ void attn_item(LAS unsigned char* lds, int item, const AttnCtx& cx) {
    constexpr int KP = DQK * 2 + 16, VP = DV * 2 + 64, KBY = 64 * KP, VBY = 64 * VP, HB = KBY + VBY;
    constexpr int NQF = DQK / 16, NDV = DV / 32, NKP = DQK / 32, NVP = DV / 32, KPR = DQK / 8, VPR = DV / 8;
    const int tid = otid(), lane = tid & 63, wave = __builtin_amdgcn_readfirstlane(tid >> 6), hf = wave >> 2, wq = wave & 3, r = lane & 31, h = lane >> 5, th = tid & 255;
    const bf16_t* __restrict__ P = cx.P;
    int head, tok0, seqbase, qcol, kcol, vcol, ntiles, qtok, S;
    int na_rows = 0, na_rs0 = 0, na_rq = 0, na_cq = 0, na_rsq = 0, na_csq = 0;
    int c_dlog = 0, c_rho = 0, c_l0 = 0, c_L = 0, c_lq = 0;
    if (MODE == 0) {
        head = item & 3; tok0 = (item >> 2) * 128; S = seq_len_of(cx.row0 + tok0); seqbase = ((cx.row0 + tok0) & ~(S - 1)) - cx.row0;
        qcol = COL_A_Q + head * 128 + hf * 64; kcol = COL_A_K + head * 128 + hf * 64; vcol = COL_A_V + head * 128; ntiles = S >> 6;
        qtok = tok0 + 32 * wq + r;
    } else if (MODE == 1) {
        const int unit = item * 2 + hf, nbk = cx.n >> 7; head = unit / nbk; tok0 = (unit - head * nbk) * 128; S = seq_len_of(cx.row0 + tok0); seqbase = ((cx.row0 + tok0) & ~(S - 1)) - cx.row0;
        qcol = COL_B_Q + head * 64; kcol = COL_B_K + head * 64; vcol = COL_B_V + head * 64; ntiles = 9;
        qtok = tok0 + 32 * wq + r;
        na_rows = S >> 6; const int r0 = (tok0 - seqbase) >> 6; na_rs0 = min(max(r0 - 4, 0), na_rows - 8);
        na_rq = r0 + (wq >> 1); na_cq = 32 * (wq & 1) + r; na_rsq = min(max(na_rq - 4, 0), na_rows - 8); na_csq = min(max(na_cq - 8, 0), 48);
    } else {
        const int unit = item * 2 + hf, nbk = cx.n >> 7; head = unit / nbk; const int blk = unit - head * nbk; tok0 = blk * 128; S = seq_len_of(cx.row0 + tok0); seqbase = ((cx.row0 + tok0) & ~(S - 1)) - cx.row0;
        qcol = COL_C_Q + head * 128; kcol = COL_C_K + head * 128; vcol = COL_C_V + head * 128; ntiles = 4;
        c_dlog = 2 * (head >> 2); const int b = (tok0 - seqbase) >> 7; c_rho = b & ((1 << c_dlog) - 1); c_l0 = (b >> c_dlog) * 128; c_L = S >> c_dlog;
        c_lq = c_l0 + 32 * wq + r; qtok = seqbase + (c_lq << c_dlog) + c_rho;
    }
    auto ktok = [&](int j, int kr) -> int {
        if (MODE == 0) return seqbase + 64 * j + kr;
        if (MODE == 1) return seqbase + min(na_rs0 + j, na_rows - 1) * 64 + kr;
        const int lk = min(max(c_l0 - 64 + 64 * j + kr, 0), c_L - 1); return seqbase + (lk << c_dlog) + c_rho;
    };
    const bool loadV = !(MODE == 0 && hf == 1);
#ifndef DMA_MODES
#define DMA_MODES 1
#endif
    constexpr bool DMA = ((DMA_MODES >> MODE) & 1) != 0;
    constexpr int NST = !DMA ? 2 : ((MODE == 0) ? 4 : ((MODE == 1) ? 3 : 2));
    constexpr bool ROT = DMA && (MODE == 0);
    constexpr int DIST = NST - 1, WAHEAD = ROT ? 1 : 0;
    const bool rot = ROT && (hf == 1);
    constexpr int SB = (MODE == 0) ? (2 * KBY + VBY) : (2 * HB);
    constexpr int KCH = KBY / 1024, VCH = VBY / 1024, LPWMAX = (KCH + VCH + 3) / 4;
    static_assert(KBY % 1024 == 0 && VBY % 1024 == 0 && NST * SB + (MODE == 1 ? 5120 : 0) <= LDS_BYTES - 16, "attention LDS ring");
    const int koff = (MODE == 0) ? hf * KBY : hf * HB, voff = (MODE == 0) ? 2 * KBY : hf * HB + KBY;
    const int nchh = KCH + (loadV ? VCH : 0);
    const int n_w = (nchh - wq + 3) >> 2;
    auto issue = [&](int j) {
        const int sbase = (j % NST) * SB;
#pragma unroll
        for (int i = 0; i < LPWMAX; ++i) {
            const int cid = wq + 4 * i;
            if (cid < nchh) {
                const bool isv = cid >= KCH; const int lc = isv ? cid - KCH : cid;
                const int pc = lc * 64 + lane, ppr = isv ? VP / 16 : KP / 16, row = pc / ppr, cp = pc - row * ppr;
                if (cp < (isv ? DV / 8 : DQK / 8)) {
                    const bf16_t* src = P + (size_t)ktok(j, row) * NIN + (isv ? vcol : kcol) + cp * 8;
                    __builtin_amdgcn_global_load_lds((const unsigned*)src, (LAS unsigned*)(lds + sbase + (isv ? voff : koff) + lc * 1024), 16, 0, 0);
                }
            }
        }
    };
    u32x4 kreg[DMA ? 1 : NKP], vreg[DMA ? 1 : NVP];
    auto gload = [&](int j) {
#pragma unroll
        for (int i = 0; i < NKP; ++i) { const int pid = th + 256 * i, row = pid / KPR, cp = pid % KPR; kreg[DMA ? 0 : i] = *(const u32x4*)(P + (size_t)ktok(j, row) * NIN + kcol + cp * 8); }
        if (loadV) {
#pragma unroll
            for (int i = 0; i < NVP; ++i) { const int pid = th + 256 * i, row = pid / VPR, cp = pid % VPR; vreg[DMA ? 0 : i] = *(const u32x4*)(P + (size_t)ktok(j, row) * NIN + vcol + cp * 8); }
        }
    };
    auto lstore = [&](int b) {
        LAS unsigned char* base = lds + b * SB;
#pragma unroll
        for (int i = 0; i < NKP; ++i) { const int pid = th + 256 * i, row = pid / KPR, cp = pid % KPR; *(LAS u32x4*)(base + koff + row * KP + cp * 16) = kreg[DMA ? 0 : i]; }
        if (loadV) {
#pragma unroll
            for (int i = 0; i < NVP; ++i) { const int pid = th + 256 * i, row = pid / VPR, cp = pid % VPR; *(LAS u32x4*)(base + voff + row * VP + cp * 16) = vreg[DMA ? 0 : i]; }
        }
    };
    LAS float* biasL = (LAS float*)(lds + NST * SB) + hf * 640;
    if (DMA) {
#pragma unroll
        for (int j0 = 0; j0 < DIST; ++j0) if (j0 < ntiles) issue(j0);
    } else gload(0);
    bf16x8 qf[NQF];
#pragma unroll
    for (int ks = 0; ks < NQF; ++ks) qf[ks] = *(const bf16x8*)(P + (size_t)qtok * NIN + qcol + 16 * ks + 8 * h);
    if (MODE == 1) { for (int i = th; i < 640; i += 256) { const int k = i - 64; biasL[i] = (k >= 0 && k < 465) ? cx.rpb[head * 465 + k] * LOG2E : 0.f; } }
    f32x16 O[NDV];
#pragma unroll
    for (int d = 0; d < NDV; ++d)
#pragma unroll
        for (int i = 0; i < 16; ++i) O[d][i] = 0.f;
    float mhat = 0.f; bool first = true;
    f32x16 negm, Lacc;
#pragma unroll
    for (int i = 0; i < 16; ++i) { negm[i] = 0.f; Lacc[i] = 0.f; }
    const bf16x8 ones8 = {(short)0x3F80, (short)0x3F80, (short)0x3F80, (short)0x3F80, (short)0x3F80, (short)0x3F80, (short)0x3F80, (short)0x3F80};
    constexpr float THR = 6.f;
    f32x16 cin0, cin1;
    auto set_cin = [&]() {
#pragma unroll
        for (int i = 0; i < 16; ++i) {
            const int ck0 = crow(i, h), ck1 = ck0 + 32;
            cin0[i] = (((ck0 >= na_csq) && (ck0 < na_csq + 16)) ? 0.f : NEGBIG) - mhat;
            cin1[i] = (((ck1 >= na_csq) && (ck1 < na_csq + 16)) ? 0.f : NEGBIG) - mhat;
        }
    };
    if (MODE == 1) set_cin();
#pragma unroll
    for (int ks = 0; ks < NQF; ++ks) asm volatile("" : "+v"(qf[ks]));
    if (!DMA) { lstore(0); __syncthreads(); }
    else if (MODE == 1) __syncthreads();
    const int q4 = (lane & 15) >> 2, p4 = lane & 3, rblk = (lane >> 4) & 1;
    bf16x8 pa[2][2];
    s16x4 vlo[2][4], vhi[2][4];
    f32x16 s0, s1;
#define V_ISSUE(va, b, d) do { _Pragma("unroll") for (int k4 = 0; k4 < 4; ++k4) { DS_TR16(vlo[b][k4], va, (16 * k4) * VP + (d) * 64); DS_TR16(vhi[b][k4], va, (16 * k4 + 8) * VP + (d) * 64); } } while (0)
#define K_ISSUE(b, kb) do { DS_RD128(kfr[b][0], kaddr, (2 * (kb)) * 32); DS_RD128(kfr[b][1], kaddr, 32 * KP + (2 * (kb)) * 32); \
                            DS_RD128(kfr[b][2], kaddr, (2 * (kb) + 1) * 32); DS_RD128(kfr[b][3], kaddr, 32 * KP + (2 * (kb) + 1) * 32); } while (0)
    auto vaddr_of = [&](int j) -> unsigned { return (unsigned)(size_t)(lds + (j % NST) * SB + voff) + (4 * h + q4) * VP + (16 * rblk + 4 * p4) * 2; };
    auto do_qk = [&](int j, bool vpre) {
        const unsigned kaddr = (unsigned)(size_t)(lds + (j % NST) * SB + koff) + r * KP + 16 * h;
        const unsigned va = vaddr_of(j);
        bf16x8 kfr[1][4];
        K_ISSUE(0, 0);
#pragma unroll
        for (int kb = 0; kb < NQF / 2; ++kb) {
            LGKM0(); SBAR();
            if (kb == 0) { if (MODE == 1) { s0 = MFMA32(kfr[0][0], qf[0], cin0); s1 = MFMA32(kfr[0][1], qf[0], cin1); } else { s0 = MFMA32(kfr[0][0], qf[0], negm); s1 = MFMA32(kfr[0][1], qf[0], negm); } }
            else { s0 = MFMA32(kfr[0][0], qf[2 * kb], s0); s1 = MFMA32(kfr[0][1], qf[2 * kb], s1); }
            s0 = MFMA32(kfr[0][2], qf[2 * kb + 1], s0); s1 = MFMA32(kfr[0][3], qf[2 * kb + 1], s1);
            SBAR();
            if (kb + 1 < NQF / 2) K_ISSUE(0, kb + 1); else if (vpre) V_ISSUE(va, 0, 0);
        }
    };
    auto do_soft = [&](int j) {
        if (MODE == 1) {
            const int rk = na_rs0 + j; const int bbase = (rk - na_rq + 7) * 31 + 15 - na_cq + 64;
#pragma unroll
            for (int i = 0; i < 16; ++i) { s0[i] += biasL[bbase + crow(i, h)]; s1[i] += biasL[bbase + crow(i, h) + 32]; }
        }
        if (MODE == 2) {
            const int lk0 = c_l0 - 64 + 64 * j;
#pragma unroll
            for (int i = 0; i < 16; ++i) {
                const int lka = lk0 + crow(i, h), lkb = lka + 32;
                const bool v0 = (lka >= 0) && (lka < c_L) && (abs(lka - c_lq) <= 64), v1 = (lkb >= 0) && (lkb < c_L) && (abs(lkb - c_lq) <= 64);
                s0[i] = v0 ? s0[i] : NEGBIG; s1[i] = v1 ? s1[i] : NEGBIG;
            }
        }
        float mx = max3f(s0[0], s1[0], s0[1]);
        mx = max3f(mx, s1[1], s0[2]);
#pragma unroll
        for (int i = 2; i < 15; ++i) mx = max3f(mx, s1[i], s0[i + 1]);
        mx = fmaxf(mx, s1[15]);
        { auto rr = __builtin_amdgcn_permlane32_swap(__float_as_uint(mx), __float_as_uint(mx), false, false); mx = max3f(__uint_as_float(rr[0]), __uint_as_float(rr[1]), __uint_as_float(rr[0])); }
        if (first || __builtin_amdgcn_ballot_w64(mx > THR) != 0ull) {
            const float delta = first ? mx : fmaxf(mx, 0.f), alpha = fast_exp2(-delta);
#pragma unroll
            for (int i = 0; i < 16; ++i) { s0[i] -= delta; s1[i] -= delta; }
            if (!first) {
#pragma unroll
                for (int d = 0; d < NDV; ++d)
#pragma unroll
                    for (int i = 0; i < 16; ++i) O[d][i] *= alpha;
#pragma unroll
                for (int i = 0; i < 16; ++i) Lacc[i] *= alpha;
            }
            mhat += delta;
#pragma unroll
            for (int i = 0; i < 16; ++i) negm[i] = -mhat;
            if (MODE == 1) set_cin();
            first = false;
        }
#pragma unroll
        for (int i = 0; i < 16; ++i) { s0[i] = fast_exp2(s0[i]); s1[i] = fast_exp2(s1[i]); }
        u32x4 w;
        w.x = pk2(s0[0], s0[1]); w.y = pk2(s0[2], s0[3]); w.z = pk2(s0[4], s0[5]); w.w = pk2(s0[6], s0[7]); pa[0][0] = __builtin_bit_cast(bf16x8, w);
        w.x = pk2(s0[8], s0[9]); w.y = pk2(s0[10], s0[11]); w.z = pk2(s0[12], s0[13]); w.w = pk2(s0[14], s0[15]); pa[0][1] = __builtin_bit_cast(bf16x8, w);
        w.x = pk2(s1[0], s1[1]); w.y = pk2(s1[2], s1[3]); w.z = pk2(s1[4], s1[5]); w.w = pk2(s1[6], s1[7]); pa[1][0] = __builtin_bit_cast(bf16x8, w);
        w.x = pk2(s1[8], s1[9]); w.y = pk2(s1[10], s1[11]); w.z = pk2(s1[12], s1[13]); w.w = pk2(s1[14], s1[15]); pa[1][1] = __builtin_bit_cast(bf16x8, w);
    };
    auto do_pv = [&](unsigned va) {
#pragma unroll
        for (int k4 = 0; k4 < 4; ++k4) Lacc = MFMA32(ones8, pa[k4 >> 1][k4 & 1], Lacc);
#pragma unroll
        for (int d = 0; d < NDV; ++d) {
            LGKM0(); SBAR();
#pragma unroll
            for (int k4 = 0; k4 < 4; ++k4) {
                const bf16x8 vf = __builtin_shufflevector(vlo[d & 1][k4], vhi[d & 1][k4], 0, 1, 2, 3, 4, 5, 6, 7);
                O[d] = MFMA32(vf, pa[k4 >> 1][k4 & 1], O[d]);
            }
            SBAR();
            if (d + 1 < NDV) V_ISSUE(va, (d + 1) & 1, d + 1);
        }
    };
    for (int j = 0; j < ntiles; ++j) {
        if (DMA) {
            wait_vm(n_w * max(min(DIST - 1 - WAHEAD, ntiles - 1 - j - WAHEAD), 0));
            __builtin_amdgcn_s_barrier();
            SBAR();
            if (j + DIST < ntiles) issue(j + DIST);
        } else if (j + 1 < ntiles) gload(j + 1);
        bool active = true;
        if (MODE == 1) { const int rk = na_rs0 + j; active = (rk >= na_rsq) && (rk < na_rsq + 8); }
        if (MODE == 2) { const int lk0 = c_l0 - 64 + 64 * j; active = ((wq < 2) ? (j <= 2) : (j >= 1)) && (lk0 + 63 >= 0) && (lk0 < c_L); }
        if (active) {
            if (!rot || j == 0) do_qk(j, !rot);
            if (rot) V_ISSUE(vaddr_of(j), 0, 0);
            do_soft(j);
            do_pv(vaddr_of(j));
            if (rot && j + 1 < ntiles) do_qk(j + 1, false);
        }
        if (!DMA) { if (j + 1 < ntiles) lstore((j + 1) & 1); __syncthreads(); }
    }
#undef K_ISSUE
#undef V_ISSUE
    const float lt = Lacc[0];
    const float inv = 1.f / lt;
    __syncthreads();
    if (MODE == 0) {
        LAS float* X = (LAS float*)lds;
        if (hf == 1) {
#pragma unroll
            for (int d = 0; d < NDV; ++d)
#pragma unroll
                for (int g4 = 0; g4 < 4; ++g4) {
                    f32x4 v = {O[d][4 * g4] * inv, O[d][4 * g4 + 1] * inv, O[d][4 * g4 + 2] * inv, O[d][4 * g4 + 3] * inv};
                    *(LAS f32x4*)(X + (32 * wq + r) * 132 + 32 * d + 8 * g4 + 4 * h) = v;
                }
        }
        __syncthreads();
        if (hf == 0) {
            float ss = 0.f;
            const float lam = cx.lamp[cx.layer], oml = cx.lamp[2 + cx.layer];
#pragma unroll
            for (int d = 0; d < NDV; ++d)
#pragma unroll
                for (int g4 = 0; g4 < 4; ++g4) {
                    const f32x4 o2 = *(LAS const f32x4*)(X + (32 * wq + r) * 132 + 32 * d + 8 * g4 + 4 * h);
#pragma unroll
                    for (int e = 0; e < 4; ++e) { const float o = O[d][4 * g4 + e] * inv - lam * o2[e]; O[d][4 * g4 + e] = o; ss += o * o; }
                }
            ss += __shfl_xor(ss, 32);
            const float rstd = rsqrtf(ss * (1.f / 128.f) + EPS) * oml;
#pragma unroll
            for (int d = 0; d < NDV; ++d)
#pragma unroll
                for (int g4 = 0; g4 < 4; ++g4) {
                    const int dv = 32 * d + 8 * g4 + 4 * h;
                    const f32x4 gn = *(const f32x4*)(cx.subln + dv);
                    const u32x2 sz = *(const u32x2*)(P + (size_t)qtok * NIN + COL_Z + head * 128 + dv);
                    u32x2 o;
                    o.x = pk2(O[d][4 * g4] * rstd * gn[0] * bflo(sz.x), O[d][4 * g4 + 1] * rstd * gn[1] * bfhi(sz.x));
                    o.y = pk2(O[d][4 * g4 + 2] * rstd * gn[2] * bflo(sz.y), O[d][4 * g4 + 3] * rstd * gn[3] * bfhi(sz.y));
                    *(u32x2*)(cx.T + (size_t)qtok * 512 + head * 128 + dv) = o;
                }
        }
        __syncthreads();
    } else {
        constexpr int XS = DV + 4, PPRO = DV / 8;
        LAS float* Xw = (LAS float*)lds + wave * (32 * XS);
#pragma unroll
        for (int d = 0; d < NDV; ++d)
#pragma unroll
            for (int g4 = 0; g4 < 4; ++g4) {
                const f32x4 v = {O[d][4 * g4] * inv, O[d][4 * g4 + 1] * inv, O[d][4 * g4 + 2] * inv, O[d][4 * g4 + 3] * inv};
                *(LAS f32x4*)(Xw + r * XS + 32 * d + 8 * g4 + 4 * h) = v;
            }
        if (MODE == 2 && h == 0) cx.LSE[(size_t)qtok * 12 + head] = mhat + __log2f(lt);
#pragma unroll
        for (int it = 0; it < (32 * PPRO) / 64; ++it) {
            const int piece = it * 64 + lane, row = piece / PPRO, c8 = piece % PPRO;
            const f32x4 a = *(LAS const f32x4*)(Xw + row * XS + c8 * 8), b = *(LAS const f32x4*)(Xw + row * XS + c8 * 8 + 4);
            if (MODE == 1) {
                const int tok = tok0 + 32 * wq + row;
                const u32x4 sz = *(const u32x4*)(P + (size_t)tok * NIN + COL_Z + 512 + head * 64 + c8 * 8);
                u32x4 o;
                o.x = pk2(a[0] * bflo(sz.x), a[1] * bfhi(sz.x)); o.y = pk2(a[2] * bflo(sz.y), a[3] * bfhi(sz.y));
                o.z = pk2(b[0] * bflo(sz.z), b[1] * bfhi(sz.z)); o.w = pk2(b[2] * bflo(sz.w), b[3] * bfhi(sz.w));
                *(u32x4*)(cx.T + (size_t)TCMAX * 512 + (size_t)tok * 512 + head * 64 + c8 * 8) = o;
            } else {
                const int tok = seqbase + ((c_l0 + 32 * wq + row) << c_dlog) + c_rho;
                *(u32x4*)(cx.OC + (size_t)tok * 1536 + head * 128 + c8 * 8) = pack8(a, b);
            }
        }
        __syncthreads();
    }
}

__device__ __forceinline__ void phase_attn(LAS unsigned char* lds, const AttnCtx& cx) {
    const int G = gridDim.x, nb = cx.n >> 7;
    const int c = (G % 8 == 0) ? (int)(blockIdx.x & 7) * (G >> 3) + (int)(blockIdx.x >> 3) : (int)blockIdx.x;
    const int npb = (cx.row0 < NPROMPT) ? (NPROMPT - cx.row0) >> 7 : 0;
    for (int rep = 0; rep < (DUP_PH == 20 ? 2 : 1); ++rep)
    for (int it = c; it < nb * 4; it += G) {
        int tb, head;
        if (it < npb * 4) { const int sq = it >> 7, rem = it & 127; head = rem >> 5; tb = sq * 32 + (rem & 31); }
        else { const int i2 = it - npb * 4, sq = i2 >> 6, rem = i2 & 63; head = rem >> 4; tb = npb + sq * 16 + (rem & 15); }
        attn_item<64, 128, 0>(lds, tb * 4 + head, cx);
    }
    for (int rep = 0; rep < (DUP_PH == 21 ? 2 : 1); ++rep)
    for (int it = c; it < nb * 6; it += G) attn_item<128, 128, 2>(lds, it, cx);
    for (int rep = 0; rep < (DUP_PH == 22 ? 2 : 1); ++rep)
    for (int it = c; it < nb * 4; it += G) attn_item<64, 64, 1>(lds, it, cx);
}

__device__ __forceinline__ void phase_cmix(const bf16_t* __restrict__ P, const bf16_t* __restrict__ OC, const float* __restrict__ LSE, bf16_t* T2, int n) {
#pragma unroll 4
    for (int idx = blockIdx.x * NTHR + otid(); idx < n * 64; idx += gridDim.x * NTHR) {
        const int tok = idx >> 6, c8 = idx & 63, hh = c8 >> 4, dv = (c8 & 15) * 8;
        const float l0 = LSE[(size_t)tok * 12 + hh], l1 = LSE[(size_t)tok * 12 + 4 + hh], l2 = LSE[(size_t)tok * 12 + 8 + hh];
        const float mx = fmaxf(l0, fmaxf(l1, l2));
        float w0 = fast_exp2(l0 - mx), w1 = fast_exp2(l1 - mx), w2 = fast_exp2(l2 - mx);
        const float iw = 1.f / (w0 + w1 + w2); w0 *= iw; w1 *= iw; w2 *= iw;
        const u32x4 a = *(const u32x4*)(OC + (size_t)tok * 1536 + hh * 128 + dv), b = *(const u32x4*)(OC + (size_t)tok * 1536 + (4 + hh) * 128 + dv),
                    c = *(const u32x4*)(OC + (size_t)tok * 1536 + (8 + hh) * 128 + dv), z = *(const u32x4*)(P + (size_t)tok * NIN + COL_Z + 1024 + hh * 128 + dv);
        u32x4 o;
        o.x = pk2((w0 * bflo(a.x) + w1 * bflo(b.x) + w2 * bflo(c.x)) * bflo(z.x), (w0 * bfhi(a.x) + w1 * bfhi(b.x) + w2 * bfhi(c.x)) * bfhi(z.x));
        o.y = pk2((w0 * bflo(a.y) + w1 * bflo(b.y) + w2 * bflo(c.y)) * bflo(z.y), (w0 * bfhi(a.y) + w1 * bfhi(b.y) + w2 * bfhi(c.y)) * bfhi(z.y));
        o.z = pk2((w0 * bflo(a.z) + w1 * bflo(b.z) + w2 * bflo(c.z)) * bflo(z.z), (w0 * bfhi(a.z) + w1 * bfhi(b.z) + w2 * bfhi(c.z)) * bfhi(z.z));
        o.w = pk2((w0 * bflo(a.w) + w1 * bflo(b.w) + w2 * bflo(c.w)) * bflo(z.w), (w0 * bfhi(a.w) + w1 * bfhi(b.w) + w2 * bfhi(c.w)) * bfhi(z.w));
        *(u32x4*)(T2 + (size_t)tok * 512 + hh * 128 + dv) = o;
    }
}

#define XB_TMO      128
#define XB_XCNT(j)  (256  + 64 * (j))
#define XB_XSUB(j)  (1280 + 64 * (j))
#define XB_XGEN(j)  (2304 + 64 * (j))
#define XB_TOP      3328
#define XB_TOPGEN   3392
#define XCD_BAR_WORDS 3456
#define XB_SPIN_CAP (1u << 18)

__device__ __forceinline__ unsigned xb_ld(unsigned* p)              { return __hip_atomic_load(p, __ATOMIC_RELAXED, __HIP_MEMORY_SCOPE_AGENT); }
__device__ __forceinline__ unsigned xb_add(unsigned* p, unsigned v) { return __hip_atomic_fetch_add(p, v, __ATOMIC_RELAXED, __HIP_MEMORY_SCOPE_AGENT); }
__device__ __forceinline__ unsigned xb_xcc_id() { return (unsigned)__builtin_amdgcn_s_getreg((3 << 11) | 20) & 0xFu; }
#define XB_SPIN(cond, bar) do { unsigned _sp = 0; while (cond) { __builtin_amdgcn_s_sleep(1); \
    if ((++_sp & 255u) == 0u) { if (xb_ld(&(bar)[XB_TMO])) break; if (_sp > XB_SPIN_CAP) { atomicAdd(&(bar)[XB_TMO], 1u); break; } } } } while (0)

struct XcdBarrier {
    unsigned* bar; unsigned x;
    volatile LAS unsigned* st;
};

__device__ __forceinline__ XcdBarrier xcd_barrier_post(unsigned* bar, volatile LAS unsigned* st) {
    XcdBarrier b; b.bar = bar; b.x = xb_xcc_id(); b.st = st;
    if (threadIdx.x == 0) (void)xb_add(&bar[XB_XCNT(b.x)], 1u);
    return b;
}
__device__ __forceinline__ void xcd_barrier_complete(unsigned* bar, unsigned x, unsigned& nloc, unsigned& nx) {
    const unsigned G = gridDim.x * gridDim.y * gridDim.z;
    unsigned sum, cnt, mine, sp = 0u;
    for (;;) {
        sum = 0u; cnt = 0u; mine = 0u;
#pragma unroll
        for (unsigned j = 0; j < 16; ++j) { const unsigned c = xb_ld(&bar[XB_XCNT(j)]); sum += c; cnt += (c > 0u) ? 1u : 0u; mine = (j == x) ? c : mine; }
        if (sum == G) break;
        __builtin_amdgcn_s_sleep(1);
        if ((++sp & 255u) == 0u) { if (xb_ld(&bar[XB_TMO])) break; if (sp > XB_SPIN_CAP) { atomicAdd(&bar[XB_TMO], 1u); break; } }
    }
    nloc = mine > 0u ? mine : 1u; nx = cnt > 0u ? cnt : 1u;
}

__device__ __forceinline__ void xcd_barrier(const XcdBarrier& b) {
    asm volatile("s_waitcnt vmcnt(0)" ::: "memory");
    __syncthreads();
    if (threadIdx.x == 0) {
        unsigned* bar = b.bar;
        __builtin_amdgcn_s_waitcnt(0);
        unsigned nloc = b.st[0], nx = b.st[1];
        if (nloc == 0u) { xcd_barrier_complete(bar, b.x, nloc, nx); b.st[0] = nloc; b.st[1] = nx; }
        const unsigned old = xb_add(&bar[XB_XSUB(b.x)], 1u);
        const unsigned gen = old / nloc;
        if (old + 1u == (gen + 1u) * nloc) {
            __builtin_amdgcn_fence(__ATOMIC_RELEASE, "agent");
            asm volatile("s_waitcnt vmcnt(0)" ::: "memory");
            const unsigned og = xb_add(&bar[XB_TOP], 1u);
            const unsigned tg = og / nx;
            if (og + 1u == (tg + 1u) * nx) xb_add(&bar[XB_TOPGEN], 1u);
            else XB_SPIN(xb_ld(&bar[XB_TOPGEN]) == tg, bar);
            __builtin_amdgcn_fence(__ATOMIC_ACQUIRE, "agent");
            xb_add(&bar[XB_XGEN(b.x)], 1u);
            asm volatile("s_waitcnt vmcnt(0)" ::: "memory");
        } else {
            XB_SPIN(xb_ld(&bar[XB_XGEN(b.x)]) == gen, bar);
            __builtin_amdgcn_fence(__ATOMIC_ACQUIRE, "agent");
            asm volatile("s_waitcnt vmcnt(0)" ::: "memory");
        }
    }
    __syncthreads();
}

#ifndef ONE_LAUNCH
#define ONE_LAUNCH 1
#endif

__global__ void __launch_bounds__(NTHR, 2) mega(Params p) {
    extern __shared__ __attribute__((aligned(16))) unsigned char lds_raw[];
    LAS unsigned char* lds = (LAS unsigned char*)lds_raw;
    unsigned char* ws = p.ws;
    volatile LAS unsigned* bst = (volatile LAS unsigned*)(lds + LDS_BYTES - 16);
    if (threadIdx.x < 2) bst[threadIdx.x] = 0u;
    __syncthreads();
    XcdBarrier bar; bar.bar = (unsigned*)(ws + WS_BAR); bar.x = 0; bar.st = bst;
    if (p.ph_hi - p.ph_lo > 1) bar = xcd_barrier_post((unsigned*)(ws + WS_BAR), bst);
    bf16_t* P = (bf16_t*)(ws + WS_P); bf16_t* T = (bf16_t*)(ws + WS_T); bf16_t* H = T; bf16_t* OC = (bf16_t*)(ws + WS_OC); float* LSE = (float*)(ws + WS_LSE);
    for (int ph = p.ph_lo; ph < p.ph_hi; ++ph) {
        if (ph > p.ph_lo) { if (ph == 1) cg::this_grid().sync(); else xcd_barrier(bar); }
        if (ph == 0) { phase_pre(p, lds); phase_prew(p, lds, 0); continue; }
        if (ph == 1) { phase_h(p, 0, 0, H); continue; }
        if (ph == 17) { phase_prew(p, lds, 1); phase_h(p, 0, 1, H); continue; }
        const int l = (ph > 17) ? 1 : 0, q = ph - (l ? 18 : 2), c = q / 5, k = q - c * 5;
        const int row0 = chunk_row0(c), n = chunk_rows(c);
        const float* mod_l = (const float*)(ws + WS_MOD) + (size_t)l * NSEQ * 3072;
        if (k == 0) {
            pg8::Gemm g{H, (const bf16_t*)(ws + WS_WIN), n, NIN, DM, DM};
            pg8::StaticOrder So; So.init(n, NIN, (int)gridDim.x, (int)blockIdx.x);
            EpiIn E{P, (const float*)(ws + WS_COSA), (const float*)(ws + WS_SINA), (const float*)(ws + WS_COSC), (const float*)(ws + WS_SINC),
                    (const float*)(ws + WS_GAIN) + l * 6 * 128, row0, (LAS float*)(lds + XCH_OFF)};
            pg8::gemm_phase<EpiIn, pg8::StaticOrder, true, true>(lds, g, So, E);
        } else if (k == 1) {
            const float* L = (const float*)(ws + WS_LAM);
            AttnCtx cx{P, T, OC, LSE, p.in[14] + l * 128, p.in[17] + (size_t)l * 8 * 465, L, l, row0, n};
            phase_attn(lds, cx);
        } else if (k == 2) {
            phase_cmix(P, OC, LSE, T + (size_t)2 * TCMAX * 512, n);
        } else if (k == 3) {
            pg8::Gemm g{T, (const bf16_t*)(ws + WS_WBR), 3 * TCMAX, 3072, 512, 512};
            BrOrder So{(int)gridDim.x, (int)blockIdx.x, (n >> 8) * 4};
            EpiBr E{P};
            pg8::gemm_phase<EpiBr, BrOrder, true, true>(lds, g, So, E);
        } else {
            pg8::Gemm g{P, (const bf16_t*)(ws + WS_WOUT), n, DM, DM, NIN};
            pg8::StaticOrder So; So.init(n, DM, (int)gridDim.x, (int)blockIdx.x);
            EpiOut E{p.in[0], p.in[1], p.out, mod_l, row0, l};
            pg8::gemm_phase<EpiOut, pg8::StaticOrder, true, true>(lds, g, So, E);
            if (c < 2) phase_h(p, c + 1, l, H);
        }
    }
}

extern "C" void kernel_launch(void* const* d_in, const int* in_sizes, int n_in, void* d_out, int out_size, void* d_ws, size_t ws_size, hipStream_t stream) {
    static int grid = 0;
    if (grid == 0) {
        if (n_in != 22 || ws_size < WS_END) { fprintf(stderr, "kernel_launch: unexpected n_in %d / ws_size %zu (need %zu)\n", n_in, ws_size, (size_t)WS_END); grid = -1; return; }
        int dev = 0, cus = 0, per_cu = 0;
        (void)hipGetDevice(&dev); (void)hipDeviceGetAttribute(&cus, hipDeviceAttributeMultiprocessorCount, dev);
        if (hipFuncSetAttribute((const void*)mega, hipFuncAttributeMaxDynamicSharedMemorySize, LDS_BYTES) != hipSuccess) { fprintf(stderr, "kernel_launch: hipFuncSetAttribute failed\n"); grid = -1; return; }
        (void)hipOccupancyMaxActiveBlocksPerMultiprocessor(&per_cu, (const void*)mega, NTHR, LDS_BYTES);
        if (per_cu < 1) { fprintf(stderr, "kernel_launch: occupancy query says %d blocks per CU\n", per_cu); per_cu = 1; }
        (void)hipGetLastError();
        grid = cus;
    }
    if (grid < 0) return;
    Params p{};
    for (int i = 0; i < 22; ++i) p.in[i] = (const float*)d_in[i];
    p.out = (float*)d_out; p.ws = (unsigned char*)d_ws;
#if ONE_LAUNCH
    if (hipMemsetAsync((char*)d_ws + WS_BAR, 0, 16384, stream) != hipSuccess) { fprintf(stderr, "kernel_launch: memset failed\n"); return; }
    p.ph_lo = 0; p.ph_hi = NPHASE;
    void* args[] = {&p};
    hipError_t e = hipLaunchCooperativeKernel((const void*)mega, dim3(grid), dim3(NTHR), args, LDS_BYTES, stream);
    if (e != hipSuccess) fprintf(stderr, "cooperative launch failed: %s (grid %d)\n", hipGetErrorString(e), grid);
#else
    for (int ph = 0; ph < NPHASE; ++ph) {
        p.ph_lo = ph; p.ph_hi = ph + 1;
        hipLaunchKernelGGL(mega, dim3(grid), dim3(NTHR), LDS_BYTES, stream, p);
    }
#endif
}
```
